# Optimizing an MI355X kernel written in HIP

```python
import math
import jax, jax.numpy as jnp
from jax import lax
import numpy as np

D_MODEL = 1024
BATCH = 1
SEQ = 16384
DEPTH = 2

GRID_W = 64
CTX_LEN = 256
EPS = 1e-6
F32 = jnp.float32

W_SSM = 256
SSM_GROUP = 16
SSM_GROUPS = W_SSM // SSM_GROUP
SSM_STATE = 64
W_LRU = 256
LRU_BLOCKS = 8
LRU_BLOCK = W_LRU // LRU_BLOCKS
LRU_CONV = 4
LRU_PAD = (2, 1)
LRU_C = 8.0
DA_HEADS = 4
DA_HEAD = 32
DA_VDIM = 2 * DA_HEAD
W_DA = DA_HEADS * DA_VDIM
ROPE_BASE = 10000.0
Q_BLOCK = 128
LAMBDA_INIT_BASE = 0.8
LAMBDA_INIT_AMP = 0.6
LAMBDA_INIT_RATE = 0.3
GLA_HEADS = 4
GLA_DK = 32
GLA_DV = 64
W_GLA = GLA_HEADS * GLA_DV
GLA_RANK = 16
GLA_TAU = 16.0
GLA_CHUNK = 64
N_BRANCH = 4
W_BRANCH = 256
D_FF = 2816
FFN_CONV = 3
FFN_PAD = (1, 1)

IN_LAYOUT = (
    ('ssm_u', W_SSM),
    ('lru_x', W_LRU), ('lru_y', W_LRU),
    ('da_q', DA_HEADS * 2 * DA_HEAD), ('da_k', DA_HEADS * 2 * DA_HEAD), ('da_v', W_DA),
    ('gla_q', GLA_HEADS * GLA_DK), ('gla_k', GLA_HEADS * GLA_DK), ('gla_v', W_GLA), ('gla_g', W_GLA),
    ('gla_a', 2 * GLA_RANK),
    ('gates', N_BRANCH * D_MODEL),
)
IN_TOTAL = sum(s for _, s in IN_LAYOUT)
ALL_PIECES = tuple(n for n, _ in IN_LAYOUT)
CTX_STATE_PIECES = ('ssm_u', 'lru_x', 'da_k', 'da_v', 'gla_k', 'gla_v', 'gla_a')

kernel_name = 'hybrid_gated_s5_rglru_diffattn_gla_dit'


def _rmsnorm(x, g):
    xf = x.astype(F32)
    y = xf * lax.rsqrt(jnp.mean(xf * xf, axis=-1, keepdims=True) + EPS)
    return (y * g.astype(F32)).astype(x.dtype)


def _adaln(cond, w, b, n_chunks):
    m = jax.nn.silu(cond) @ w[:, :n_chunks * D_MODEL] + b[:n_chunks * D_MODEL]
    return [t[:, None, :] for t in jnp.split(m, n_chunks, axis=-1)]


def _modulate(h, shift, scale):
    return h * (1.0 + scale) + shift


def _flip(t, rev):
    return t[:, ::-1] if (rev and t is not None) else t


def _dwconv(x, w, b, pad):
    y = lax.conv_general_dilated(x, w[:, None, :].astype(x.dtype), window_strides=(1,),
                                 padding=[pad], dimension_numbers=('NWC', 'WIO', 'NWC'),
                                 feature_group_count=x.shape[-1])
    return y + b.astype(x.dtype)


def _project(h, w_in, names):
    offs, o = {}, 0
    for n, s in IN_LAYOUT:
        offs[n] = (o, s)
        o += s
    w = w_in if names == ALL_PIECES else jnp.concatenate(
        [w_in[:, offs[n][0]:offs[n][0] + offs[n][1]] for n in names], axis=1)
    z = h @ w
    sizes = [offs[n][1] for n in names]
    parts = jnp.split(z, list(np.cumsum(sizes)[:-1]), axis=-1)
    return dict(zip(names, parts))


def _axial_rope(rows, dim):
    row = jnp.repeat(jnp.arange(rows), GRID_W).astype(F32)
    col = jnp.tile(jnp.arange(GRID_W), rows).astype(F32)
    half = dim // 2
    inv = 1.0 / (ROPE_BASE ** (jnp.arange(0, half, 2, dtype=F32) / half))
    ang = jnp.concatenate([row[:, None] * inv, col[:, None] * inv], axis=-1)
    return jnp.cos(ang), jnp.sin(ang)


def _apply_axial_rope(x, cos, sin):
    q = x.shape[-1] // 4
    xr = x.reshape(x.shape[:-1] + (2, 2, q))
    x1, x2 = xr[..., 0, :], xr[..., 1, :]
    c = cos.reshape(cos.shape[0], 2, q)
    s = sin.reshape(sin.shape[0], 2, q)
    out = jnp.stack([x1 * c - x2 * s, x1 * s + x2 * c], axis=-2)
    return out.reshape(x.shape).astype(x.dtype)


def _s5_discretize(lam_re, lam_im, log_step, b_re, b_im):
    lam_re, lam_im = lam_re.astype(F32), lam_im.astype(F32)
    dt = jnp.exp(log_step.astype(F32))[:, None]
    mag = jnp.exp(lam_re * dt)
    lb_re, lb_im = mag * jnp.cos(lam_im * dt), mag * jnp.sin(lam_im * dt)
    num_re, num_im = lb_re - 1.0, lb_im
    den = lam_re * lam_re + lam_im * lam_im
    k_re = (num_re * lam_re + num_im * lam_im) / den
    k_im = (num_im * lam_re - num_re * lam_im) / den
    b_re, b_im = b_re.astype(F32), b_im.astype(F32)
    bb_re = k_re[..., None] * b_re - k_im[..., None] * b_im
    bb_im = k_re[..., None] * b_im + k_im[..., None] * b_re
    return lb_re, lb_im, bb_re, bb_im


def _complex_affine_combine(e1, e2):
    a1r, a1i, b1r, b1i = e1
    a2r, a2i, b2r, b2i = e2
    return (a2r * a1r - a2i * a1i, a2r * a1i + a2i * a1r,
            a2r * b1r - a2i * b1i + b2r, a2r * b1i + a2i * b1r + b2i)


def _s5_scan(u, lb_re, lb_im, bb_re, bb_im, h0_re, h0_im):
    bu_re = jnp.einsum('blgc,gpc->blgp', u, bb_re)
    bu_im = jnp.einsum('blgc,gpc->blgp', u, bb_im)
    bu_re = bu_re.at[:, 0].add(lb_re * h0_re - lb_im * h0_im)
    bu_im = bu_im.at[:, 0].add(lb_re * h0_im + lb_im * h0_re)
    a_re = jnp.broadcast_to(lb_re, bu_re.shape)
    a_im = jnp.broadcast_to(lb_im, bu_im.shape)
    _, _, h_re, h_im = lax.associative_scan(_complex_affine_combine, (a_re, a_im, bu_re, bu_im), axis=1)
    return h_re, h_im


def _s5_readout(h_re, h_im, c_re, c_im):
    y = (jnp.einsum('blgp,gcp->blgc', h_re, c_re.astype(F32))
         - jnp.einsum('blgp,gcp->blgc', h_im, c_im.astype(F32)))
    return y.reshape(y.shape[0], y.shape[1], W_SSM)


def _s5_mixer(u_c, u_l, lam_re, lam_im, log_step, b_re, b_im, c_re, c_im, d_skip, w_glu, with_ctx):
    bn, dt = u_l.shape[0], u_l.dtype
    grp = lambda u: u.astype(F32).reshape(bn, u.shape[1], SSM_GROUPS, SSM_GROUP)
    g_c, g_l = grp(u_c), grp(u_l)
    d32 = d_skip.astype(F32)
    y_l = u_l.astype(F32) * d32
    y_c = u_c.astype(F32) * d32 if with_ctx else None
    zero = jnp.zeros((bn, SSM_GROUPS, SSM_STATE), F32)
    for di in range(2):
        rev = di == 1
        lb_re, lb_im, bb_re, bb_im = _s5_discretize(lam_re[di], lam_im[di], log_step[di], b_re[di], b_im[di])
        hc_re, hc_im = _s5_scan(_flip(g_c, rev), lb_re, lb_im, bb_re, bb_im, zero, zero)
        hl_re, hl_im = _s5_scan(_flip(g_l, rev), lb_re, lb_im, bb_re, bb_im, hc_re[:, -1], hc_im[:, -1])
        y_l = y_l + _flip(_s5_readout(hl_re, hl_im, c_re[di], c_im[di]), rev)
        if with_ctx:
            y_c = y_c + _flip(_s5_readout(hc_re, hc_im, c_re[di], c_im[di]), rev)

    def glu(y):
        z = jax.nn.gelu(y)
        return (z * jax.nn.sigmoid(z @ w_glu.astype(F32))).astype(dt)
    return (glu(y_c) if with_ctx else None), glu(y_l)


def _rglru_gates(xc, wr, br, wi, bi, lam):
    bn, n, _ = xc.shape
    blk = xc.reshape(bn, n, LRU_BLOCKS, LRU_BLOCK)
    r = jax.nn.sigmoid(jnp.einsum('blnc,ncd->blnd', blk, wr.astype(F32)).reshape(bn, n, W_LRU) + br.astype(F32))
    i = jax.nn.sigmoid(jnp.einsum('blnc,ncd->blnd', blk, wi.astype(F32)).reshape(bn, n, W_LRU) + bi.astype(F32))
    log_a = LRU_C * r * jax.nn.log_sigmoid(lam.astype(F32))
    a = jnp.exp(log_a)
    b = jnp.sqrt(-jnp.expm1(2.0 * log_a)) * (i * xc)
    return a, b


def _linear_scan(a, b, h0):
    b = b.at[:, 0].add(a[:, 0] * h0)
    _, h = lax.associative_scan(lambda e1, e2: (e1[0] * e2[0], e2[0] * e1[1] + e2[1]), (a, b), axis=1)
    return h


def _rglru_mixer(z_c, z_l, conv_w, conv_b, wr, br, wi, bi, lam, with_ctx):
    bn, dt = z_l['lru_x'].shape[0], z_l['lru_x'].dtype
    xc_l = _dwconv(z_l['lru_x'], conv_w, conv_b, LRU_PAD).astype(F32)
    xc_c = _dwconv(z_c['lru_x'], conv_w, conv_b, LRU_PAD).astype(F32)
    zero = jnp.zeros((bn, W_LRU), F32)
    h_l, h_c = 0.0, 0.0
    for di in range(2):
        rev = di == 1
        a_c, b_c = _rglru_gates(_flip(xc_c, rev), wr[di], br[di], wi[di], bi[di], lam[di])
        hs_c = _linear_scan(a_c, b_c, zero)
        a_l, b_l = _rglru_gates(_flip(xc_l, rev), wr[di], br[di], wi[di], bi[di], lam[di])
        hs_l = _linear_scan(a_l, b_l, hs_c[:, -1])
        h_l = h_l + _flip(hs_l, rev)
        if with_ctx:
            h_c = h_c + _flip(hs_c, rev)
    y_l = (h_l * jax.nn.gelu(z_l['lru_y'].astype(F32))).astype(dt)
    y_c = (h_c * jax.nn.gelu(z_c['lru_y'].astype(F32))).astype(dt) if with_ctx else None
    return y_c, y_l


def _diff_softmax(q, k, v, lam):
    s = jnp.einsum('bhcqd,bhckd->bhcqk', q, k).astype(F32) * (DA_HEAD ** -0.5)
    p = jax.nn.softmax(s, axis=-1)
    w = p[:, :, 0] - lam * p[:, :, 1]
    return jnp.einsum('bhqk,bhkv->bhqv', w.astype(v.dtype), v)


def _diff_attention(z_c, z_l, q_norm, k_norm, lam_p, out_norm, cos, sin, lam_init, with_ctx):
    bn, n_lat, _ = z_l['da_q'].shape

    def heads_qk(t, g):
        t = _rmsnorm(t.reshape(bn, t.shape[1], DA_HEADS, 2, DA_HEAD), g)
        return t.transpose(0, 2, 3, 1, 4)

    def heads_v(t):
        return t.reshape(bn, t.shape[1], DA_HEADS, DA_VDIM).transpose(0, 2, 1, 3)

    q_l = _apply_axial_rope(heads_qk(z_l['da_q'], q_norm), cos, sin)
    k_l = _apply_axial_rope(heads_qk(z_l['da_k'], k_norm), cos, sin)
    v_l = heads_v(z_l['da_v'])
    k_c = heads_qk(z_c['da_k'], k_norm)
    v_c = heads_v(z_c['da_v'])
    lp = lam_p.astype(F32)
    lam = jnp.exp(jnp.sum(lp[0] * lp[1])) - jnp.exp(jnp.sum(lp[2] * lp[3])) + lam_init
    k_all = jnp.concatenate([k_c, k_l], axis=3)
    v_all = jnp.concatenate([v_c, v_l], axis=2)
    nb = n_lat // Q_BLOCK
    q_blocks = q_l.reshape(bn, DA_HEADS, 2, nb, Q_BLOCK, DA_HEAD).transpose(3, 0, 1, 2, 4, 5)
    o_l = lax.map(lambda qb: _diff_softmax(qb, k_all, v_all, lam), q_blocks)
    o_l = o_l.transpose(1, 2, 0, 3, 4).reshape(bn, DA_HEADS, n_lat, DA_VDIM)

    def finish(o):
        o = _rmsnorm(o, out_norm) * (1.0 - lam_init)
        return o.transpose(0, 2, 1, 3).reshape(bn, o.shape[2], W_DA)

    y_c = finish(_diff_softmax(heads_qk(z_c['da_q'], q_norm), k_c, v_c, lam)) if with_ctx else None
    return y_c, finish(o_l)


def _gla_chunked(q, k, v, log_a, s0, with_out):
    bn, n_tok, nh, _ = k.shape
    dv = v.shape[-1]
    nc = n_tok // GLA_CHUNK
    chunks = lambda t: t.reshape(bn, nc, GLA_CHUNK, nh, t.shape[-1]).transpose(1, 0, 3, 2, 4)
    kc, vc = chunks(k), chunks(v)
    b = jnp.cumsum(chunks(log_a), axis=-2)
    b_last = b[..., -1:, :]
    kv = jnp.einsum('nbhjd,nbhjv->nbhdv', kc * jnp.exp(b_last - b), vc)
    decay = jnp.exp(b_last[..., 0, :])

    def step(s, xs):
        dec, kvn = xs
        return dec[..., None] * s + kvn, (s if with_out else None)
    s_fin, s_start = lax.scan(step, s0, (decay, kv))
    if not with_out:
        return None, s_fin
    qc = chunks(q) * jnp.exp(b)
    mask = jnp.tril(jnp.ones((GLA_CHUNK, GLA_CHUNK), dtype=bool))
    att = jnp.where(mask, jnp.einsum('nbhid,nbhjd->nbhij', qc, kc * jnp.exp(-b)), 0.0)
    o = jnp.einsum('nbhij,nbhjv->nbhiv', att, vc) + jnp.einsum('nbhid,nbhdv->nbhiv', qc, s_start)
    return o.transpose(1, 0, 3, 2, 4).reshape(bn, n_tok, nh, dv), s_fin


def _gla_mixer(z_c, z_l, wa2, ba, out_norm, with_ctx):
    bn, dt = z_l['gla_q'].shape[0], z_l['gla_q'].dtype
    heads = lambda t, d: t.astype(F32).reshape(bn, t.shape[1], GLA_HEADS, d)
    q_l = heads(z_l['gla_q'], GLA_DK) * (GLA_DK ** -0.5)
    k_l, v_l = heads(z_l['gla_k'], GLA_DK), heads(z_l['gla_v'], GLA_DV)
    q_c = heads(z_c['gla_q'], GLA_DK) * (GLA_DK ** -0.5) if with_ctx else None
    k_c, v_c = heads(z_c['gla_k'], GLA_DK), heads(z_c['gla_v'], GLA_DV)

    def log_gate(a_low, di):
        z = a_low[..., di * GLA_RANK:(di + 1) * GLA_RANK].astype(F32) @ wa2[di].astype(F32) + ba[di].astype(F32)
        return heads(jax.nn.log_sigmoid(z) / GLA_TAU, GLA_DK)

    s0 = jnp.zeros((bn, GLA_HEADS, GLA_DK, GLA_DV), F32)
    o_l, o_c = 0.0, 0.0
    for di in range(2):
        rev = di == 1
        out_c, s_c = _gla_chunked(_flip(q_c, rev), _flip(k_c, rev), _flip(v_c, rev),
                                  _flip(log_gate(z_c['gla_a'], di), rev), s0, with_ctx)
        out_l, _ = _gla_chunked(_flip(q_l, rev), _flip(k_l, rev), _flip(v_l, rev),
                                _flip(log_gate(z_l['gla_a'], di), rev), s_c, True)
        o_l = o_l + _flip(out_l, rev)
        if with_ctx:
            o_c = o_c + _flip(out_c, rev)

    def finish(o, g):
        o = _rmsnorm(o, out_norm).reshape(bn, o.shape[1], W_GLA)
        return (o * jax.nn.silu(g.astype(F32))).astype(dt)
    return (finish(o_c, z_c['gla_g']) if with_ctx else None), finish(o_l, z_l['gla_g'])


def _merge(gate_logits, branches, w_branch, w_out):
    bn, n, _ = gate_logits.shape
    g = jax.nn.sigmoid(gate_logits.reshape(bn, n, N_BRANCH, D_MODEL))
    y = jnp.stack(branches, axis=2)
    proj = jnp.einsum('blnw,nwd->blnd', y, w_branch)
    return jnp.einsum('blnd,blnd->bld', g, proj) @ w_out


def _conv_ffn(h, w_up, conv_w, conv_b, w_down):
    a, gt = jnp.split(h @ w_up, 2, axis=-1)
    gt = _dwconv(gt, conv_w, conv_b, FFN_PAD)
    return (jax.nn.gelu(gt) * a) @ w_down


def _diff_lambda_init(layer):
    return LAMBDA_INIT_BASE - LAMBDA_INIT_AMP * math.exp(-LAMBDA_INIT_RATE * layer)


def setup_inputs(seed: int = 0) -> dict:
    key = jax.random.key(seed)
    ks = iter(jax.random.split(key, 40))
    nrm = lambda shape, scale: jax.random.normal(next(ks), shape, F32) * scale
    gain = lambda shape: 1.0 + nrm(shape, 0.05)
    L2 = (DEPTH, 2)
    lam_u = jax.random.uniform(next(ks), L2 + (W_LRU,), F32, 0.9, 0.999) ** (1.0 / LRU_C)
    return {
        'x': nrm((BATCH, SEQ, D_MODEL), 1.0),
        'c': nrm((BATCH, D_MODEL), 1.0),
        'ctx': nrm((BATCH, CTX_LEN, D_MODEL), 1.0),
        'c_ctx': nrm((D_MODEL,), 1.0),
        'w_ada': nrm((DEPTH, D_MODEL, 6 * D_MODEL), 0.5 * D_MODEL ** -0.5),
        'b_ada': nrm((DEPTH, 6 * D_MODEL), 0.01),
        'norm1_g': gain((DEPTH, D_MODEL)),
        'norm2_g': gain((DEPTH, D_MODEL)),
        'w_in': nrm((DEPTH, D_MODEL, IN_TOTAL), D_MODEL ** -0.5),
        'ssm_lam_re': -0.5 + nrm(L2 + (SSM_GROUPS, SSM_STATE), 0.01),
        'ssm_lam_im': jnp.pi * jnp.arange(SSM_STATE, dtype=F32) + nrm(L2 + (SSM_GROUPS, SSM_STATE), 0.01),
        'ssm_log_step': jax.random.uniform(next(ks), L2 + (SSM_GROUPS,), F32, math.log(1e-3), math.log(1e-1)),
        'ssm_b_re': nrm(L2 + (SSM_GROUPS, SSM_STATE, SSM_GROUP), (2 * SSM_GROUP) ** -0.5),
        'ssm_b_im': nrm(L2 + (SSM_GROUPS, SSM_STATE, SSM_GROUP), (2 * SSM_GROUP) ** -0.5),
        'ssm_c_re': nrm(L2 + (SSM_GROUPS, SSM_GROUP, SSM_STATE), SSM_STATE ** -0.5),
        'ssm_c_im': nrm(L2 + (SSM_GROUPS, SSM_GROUP, SSM_STATE), SSM_STATE ** -0.5),
        'ssm_d': nrm((DEPTH, W_SSM), 0.5),
        'ssm_w_glu': nrm((DEPTH, W_SSM, W_SSM), W_SSM ** -0.5),
        'lru_conv_w': nrm((DEPTH, LRU_CONV, W_LRU), LRU_CONV ** -0.5),
        'lru_conv_b': nrm((DEPTH, W_LRU), 0.01),
        'lru_wr': nrm(L2 + (LRU_BLOCKS, LRU_BLOCK, LRU_BLOCK), LRU_BLOCK ** -0.5),
        'lru_br': nrm(L2 + (W_LRU,), 0.01),
        'lru_wi': nrm(L2 + (LRU_BLOCKS, LRU_BLOCK, LRU_BLOCK), LRU_BLOCK ** -0.5),
        'lru_bi': nrm(L2 + (W_LRU,), 0.01),
        'lru_lam': jnp.log(lam_u) - jnp.log1p(-lam_u),
        'da_q_norm': gain((DEPTH, DA_HEAD)),
        'da_k_norm': gain((DEPTH, DA_HEAD)),
        'da_lam': nrm((DEPTH, 4, DA_HEAD), 0.1),
        'da_out_norm': gain((DEPTH, DA_VDIM)),
        'gla_wa2': nrm(L2 + (GLA_RANK, GLA_HEADS * GLA_DK), GLA_RANK ** -0.5),
        'gla_ba': nrm(L2 + (GLA_HEADS * GLA_DK,), 0.1),
        'gla_out_norm': gain((DEPTH, GLA_DV)),
        'w_branch': nrm((DEPTH, N_BRANCH, W_BRANCH, D_MODEL), W_BRANCH ** -0.5),
        'w_out': nrm((DEPTH, D_MODEL, D_MODEL), D_MODEL ** -0.5),
        'w_up': nrm((DEPTH, D_MODEL, 2 * D_FF), D_MODEL ** -0.5),
        'ffn_conv_w': nrm((DEPTH, FFN_CONV, D_FF), FFN_CONV ** -0.5),
        'ffn_conv_b': nrm((DEPTH, D_FF), 0.01),
        'w_down': nrm((DEPTH, D_FF, D_MODEL), D_FF ** -0.5),
    }


def reference(x, c, ctx, c_ctx, w_ada, b_ada, norm1_g, norm2_g, w_in,
              ssm_lam_re, ssm_lam_im, ssm_log_step, ssm_b_re, ssm_b_im, ssm_c_re, ssm_c_im, ssm_d, ssm_w_glu,
              lru_conv_w, lru_conv_b, lru_wr, lru_br, lru_wi, lru_bi, lru_lam,
              da_q_norm, da_k_norm, da_lam, da_out_norm,
              gla_wa2, gla_ba, gla_out_norm,
              w_branch, w_out, w_up, ffn_conv_w, ffn_conv_b, w_down):
    rows = x.shape[1] // GRID_W
    cos, sin = _axial_rope(rows, DA_HEAD)
    h_ctx = ctx
    for l in range(DEPTH):
        with_ctx = l < DEPTH - 1
        sh1, sc1, g1, sh2, sc2, g2 = _adaln(c, w_ada[l], b_ada[l], 6)
        cmod = _adaln(c_ctx[None], w_ada[l], b_ada[l], 6 if with_ctx else 2)
        hn_l = _modulate(_rmsnorm(x, norm1_g[l]), sh1, sc1)
        hn_c = _modulate(_rmsnorm(h_ctx, norm1_g[l]), cmod[0], cmod[1])
        z_l = _project(hn_l, w_in[l], ALL_PIECES)
        z_c = _project(hn_c, w_in[l], ALL_PIECES if with_ctx else CTX_STATE_PIECES)
        ya_c, ya_l = _s5_mixer(z_c['ssm_u'], z_l['ssm_u'], ssm_lam_re[l], ssm_lam_im[l], ssm_log_step[l],
                               ssm_b_re[l], ssm_b_im[l], ssm_c_re[l], ssm_c_im[l], ssm_d[l], ssm_w_glu[l], with_ctx)
        yb_c, yb_l = _rglru_mixer(z_c, z_l, lru_conv_w[l], lru_conv_b[l], lru_wr[l], lru_br[l],
                                  lru_wi[l], lru_bi[l], lru_lam[l], with_ctx)
        yc_c, yc_l = _diff_attention(z_c, z_l, da_q_norm[l], da_k_norm[l], da_lam[l], da_out_norm[l],
                                     cos, sin, _diff_lambda_init(l), with_ctx)
        yd_c, yd_l = _gla_mixer(z_c, z_l, gla_wa2[l], gla_ba[l], gla_out_norm[l], with_ctx)
        x = x + g1 * _merge(z_l['gates'], (ya_l, yb_l, yc_l, yd_l), w_branch[l], w_out[l])
        x = x + g2 * _conv_ffn(_modulate(_rmsnorm(x, norm2_g[l]), sh2, sc2),
                               w_up[l], ffn_conv_w[l], ffn_conv_b[l], w_down[l])
        if with_ctx:
            h_ctx = h_ctx + cmod[2] * _merge(z_c['gates'], (ya_c, yb_c, yc_c, yd_c), w_branch[l], w_out[l])
            h_ctx = h_ctx + cmod[5] * _conv_ffn(_modulate(_rmsnorm(h_ctx, norm2_g[l]), cmod[3], cmod[4]),
                                                w_up[l], ffn_conv_w[l], ffn_conv_b[l], w_down[l])
    return x
```

```cpp
#include <hip/hip_runtime.h>
#include <hip/hip_cooperative_groups.h>
#include <cstdio>
#include <cstdint>

typedef unsigned short bf16;
typedef float f32x4 __attribute__((ext_vector_type(4)));
typedef unsigned u32x4 __attribute__((ext_vector_type(4)));
typedef unsigned u32x2 __attribute__((ext_vector_type(2)));

constexpr int D = 1024, SEQ = 16384, CTX = 256, ROWS = SEQ + CTX, DEPTH = 2;
constexpr int IN_TOTAL = 6432, NZ = 2304, NZP = 2560, GATE0 = 2336, DFF = 2816;
constexpr int NCHUNK = ROWS / 64;
constexpr int NT = 512;
constexpr int ZC_SSM = 0, ZC_LRUX = 256, ZC_LRUY = 512, ZC_DAQ = 768, ZC_DAK = 1024, ZC_DAV = 1280, ZC_GQ = 1536, ZC_GK = 1664, ZC_GV = 1792, ZC_GG = 2048;

enum { I_X = 0, I_C, I_CTX, I_CCTX, I_WADA, I_BADA, I_N1G, I_N2G, I_WIN, I_SLRE, I_SLIM, I_SLOG, I_SBRE, I_SBIM, I_SCRE, I_SCIM, I_SD, I_SWGLU,
       I_LCW, I_LCB, I_LWR, I_LBR, I_LWI, I_LBI, I_LLAM, I_DQN, I_DKN, I_DLAM, I_DON, I_GWA2, I_GBA, I_GON, I_WBR, I_WOUT, I_WUP, I_FCW, I_FCB, I_WDN, N_IN };

constexpr size_t al256(size_t x) { return (x + 255) & ~(size_t)255; }
constexpr size_t WS_CTL = 0;
constexpr size_t WS_MODS = 65536;
constexpr size_t WS_S5LB = WS_MODS + al256((size_t)2 * 2 * 6144 * 4);
constexpr size_t WS_S5BB = WS_S5LB + al256((size_t)4096 * 2 * 4);
constexpr size_t WS_HCTX = WS_S5BB + al256((size_t)4096 * 32 * 4);
constexpr size_t WS_WINT = WS_HCTX + al256((size_t)CTX * D * 4);
constexpr size_t WS_WGT = WS_WINT + al256((size_t)NZP * D * 2);
constexpr size_t WS_WBRT = WS_WGT + al256((size_t)4096 * D * 2);
constexpr size_t WS_WOUTT = WS_WBRT + al256((size_t)4 * D * 256 * 2);
constexpr size_t WS_WUPT = WS_WOUTT + al256((size_t)D * D * 2);
constexpr size_t WS_WDNT = WS_WUPT + al256((size_t)2 * DFF * D * 2);
constexpr size_t WS_WGLUT = WS_WDNT + al256((size_t)D * DFF * 2);
constexpr size_t WS_HN = WS_WGLUT + al256((size_t)256 * 256 * 2);
constexpr size_t WS_Z = WS_HN + al256((size_t)(ROWS + 256) * D * 2);
constexpr size_t WS_ZA = WS_Z + al256((size_t)ROWS * DFF * 2);
constexpr size_t WS_Y = WS_ZA + al256((size_t)ROWS * 32 * 4);
constexpr size_t WS_YS5 = WS_Y + al256((size_t)ROWS * D * 2);
constexpr size_t WS_S5END = WS_YS5 + al256((size_t)ROWS * 256 * 2);
constexpr size_t WS_S5START = WS_S5END + al256((size_t)NCHUNK * 2 * 16 * 64 * 2 * 4);
constexpr size_t WS_LRUEND = WS_S5START + al256((size_t)NCHUNK * 2 * 16 * 64 * 2 * 4);
constexpr size_t WS_LRUSTART = WS_LRUEND + al256((size_t)NCHUNK * 2 * 256 * 2 * 4);
constexpr size_t WS_GLAKV = WS_LRUSTART + al256((size_t)NCHUNK * 2 * 256 * 4);
constexpr size_t WS_GLAS0 = WS_GLAKV + al256((size_t)NCHUNK * 2 * 4 * 32 * 64 * 4);
constexpr size_t WS_GLADEC = WS_GLAS0 + al256((size_t)NCHUNK * 2 * 4 * 32 * 64 * 4);
constexpr size_t WS_END = WS_GLADEC + al256((size_t)NCHUNK * 2 * 4 * 32 * 4);
static_assert(WS_END <= (size_t)256 * 1024 * 1024, "workspace map exceeds 256 MiB");

struct Params { const float* in[N_IN]; float* out; unsigned char* ws; int phase; int layer; };

__device__ __forceinline__ float bf2f(bf16 b) { return __uint_as_float(((unsigned)b) << 16); }
__device__ __forceinline__ bf16 f2bf(float f) { unsigned u = __float_as_uint(f); u += 0x7FFFu + ((u >> 16) & 1u); return (bf16)(u >> 16); }
__device__ __forceinline__ unsigned pack2(float lo, float hi) { return (unsigned)f2bf(lo) | ((unsigned)f2bf(hi) << 16); }
__device__ __forceinline__ float lo2f(unsigned w) { return __uint_as_float(w << 16); }
__device__ __forceinline__ float hi2f(unsigned w) { return __uint_as_float(w & 0xFFFF0000u); }
__device__ __forceinline__ float sigmoidf_(float x) { return 1.0f / (1.0f + __expf(-x)); }
__device__ __forceinline__ float siluf_(float x) { return x * sigmoidf_(x); }
__device__ __forceinline__ float gelu_tanh(float x) { const float u = 0.7978845608028654f * (x + 0.044715f * x * x * x); return 0.5f * x * (1.0f + tanhf(u)); }
__device__ __forceinline__ float logsigmoidf_(float x) { return x >= 0.f ? -log1pf(expf(-x)) : x - log1pf(expf(x)); }
__device__ __forceinline__ int chunk_of(int s, int d) { return d == 0 ? s : (s < 4 ? 3 - s : 263 - s); }
__device__ __forceinline__ float lam_init_of(int l) { return 0.8f - 0.6f * expf(-0.3f * (float)l); }

struct Ctx {
    const Params& p; int l; unsigned char* ws; float* lds;
    __device__ Ctx(const Params& p_, int l_, float* lds_) : p(p_), l(l_), ws(p_.ws), lds(lds_) {}
    template <class T> __device__ __forceinline__ T* W(size_t off) const { return (T*)(ws + off); }
    __device__ __forceinline__ const float* in(int i) const { return p.in[i]; }
    __device__ __forceinline__ const float* xin_row(int row) const {
        if (l == 0) return row < CTX ? p.in[I_CTX] + (size_t)row * D : p.in[I_X] + (size_t)(row - CTX) * D;
        return row < CTX ? W<float>(WS_HCTX) + (size_t)row * D : p.out + (size_t)(row - CTX) * D; }
    __device__ __forceinline__ float* xout_row(int row) const { return row < CTX ? W<float>(WS_HCTX) + (size_t)row * D : p.out + (size_t)(row - CTX) * D; }
    __device__ __forceinline__ const float* mods(int row) const { return W<float>(WS_MODS) + ((size_t)l * 2 + (row < CTX ? 1 : 0)) * 6144; }
    __device__ __forceinline__ int row_begin() const { return l == DEPTH - 1 ? CTX : 0; }
};

__device__ void convT_tile(const float* src, int ld, int col0, int nvalid, bf16* dst, int K, int drow0, int k0, float* lds) {
    const int t = threadIdx.x;
    for (int i = t; i < 4096; i += NT) { const int kk = i >> 6, j = i & 63; lds[kk * 65 + j] = (j < nvalid) ? src[(size_t)(k0 + kk) * ld + col0 + j] : 0.f; }
    __syncthreads();
    { const int j = t >> 3, kq = t & 7; u32x4 w;
      w.x = pack2(lds[(kq * 8 + 0) * 65 + j], lds[(kq * 8 + 1) * 65 + j]); w.y = pack2(lds[(kq * 8 + 2) * 65 + j], lds[(kq * 8 + 3) * 65 + j]);
      w.z = pack2(lds[(kq * 8 + 4) * 65 + j], lds[(kq * 8 + 5) * 65 + j]); w.w = pack2(lds[(kq * 8 + 6) * 65 + j], lds[(kq * 8 + 7) * 65 + j]);
      *(u32x4*)(dst + (size_t)(drow0 + j) * K + k0 + kq * 8) = w; }
    __syncthreads();
}
__device__ void phase_prep(const Ctx& c) {
    const int l = c.l;
    constexpr int T0 = 640, T1 = T0 + 1024, T2 = T1 + 256, T3 = T2 + 256, T4 = T3 + 1408, T5 = T4 + 704, T6 = T5 + 16;
    for (int ti = blockIdx.x; ti < T6; ti += gridDim.x) {
        if (ti < T0) { const int jt = ti >> 4, kt = ti & 15; int nv = GATE0 - jt * 64; nv = nv < 0 ? 0 : (nv > 64 ? 64 : nv);
            convT_tile(c.in(I_WIN) + (size_t)l * D * IN_TOTAL, IN_TOTAL, jt * 64, nv, c.W<bf16>(WS_WINT), D, jt * 64, kt * 64, c.lds); }
        else if (ti < T1) { const int u = ti - T0, jt = u >> 4, kt = u & 15;
            convT_tile(c.in(I_WIN) + (size_t)l * D * IN_TOTAL, IN_TOTAL, GATE0 + jt * 64, 64, c.W<bf16>(WS_WGT), D, jt * 64, kt * 64, c.lds); }
        else if (ti < T2) { const int u = ti - T1, n = u >> 6, jt = (u >> 2) & 15, kt = u & 3;
            convT_tile(c.in(I_WBR) + ((size_t)l * 4 + n) * 256 * D, D, jt * 64, 64, c.W<bf16>(WS_WBRT) + (size_t)n * D * 256, 256, jt * 64, kt * 64, c.lds); }
        else if (ti < T3) { const int u = ti - T2, jt = u >> 4, kt = u & 15;
            convT_tile(c.in(I_WOUT) + (size_t)l * D * D, D, jt * 64, 64, c.W<bf16>(WS_WOUTT), D, jt * 64, kt * 64, c.lds); }
        else if (ti < T4) { const int u = ti - T3, jt = u >> 4, kt = u & 15; const int r0 = jt * 64, pn = r0 >> 8, bj = (r0 >> 7) & 1, cc = r0 & 127;
            convT_tile(c.in(I_WUP) + (size_t)l * D * 2 * DFF, 2 * DFF, bj * DFF + 128 * pn + cc, 64, c.W<bf16>(WS_WUPT), D, r0, kt * 64, c.lds); }
        else if (ti < T5) { const int u = ti - T4, jt = u / 44, kt = u % 44;
            convT_tile(c.in(I_WDN) + (size_t)l * DFF * D, D, jt * 64, 64, c.W<bf16>(WS_WDNT), DFF, jt * 64, kt * 64, c.lds); }
        else { const int u = ti - T5, jt = u >> 2, kt = u & 3;
            convT_tile(c.in(I_SWGLU) + (size_t)l * 256 * 256, 256, jt * 64, 64, c.W<bf16>(WS_WGLUT), 256, jt * 64, kt * 64, c.lds); }
    }
    if (l != 0) return;
    for (int task = blockIdx.x; task < 192; task += gridDim.x) {
        const int ll = task / 96, cb = task % 96, t = threadIdx.x, kq = t >> 6, j = t & 63;
        const float* w = c.in(I_WADA) + (size_t)ll * D * 6144 + cb * 64 + j;
        float a0 = 0.f, a1 = 0.f;
        for (int k = kq * 128; k < kq * 128 + 128; ++k) { const float wv = w[(size_t)k * 6144]; a0 += siluf_(c.in(I_C)[k]) * wv; a1 += siluf_(c.in(I_CCTX)[k]) * wv; }
        c.lds[t] = a0; c.lds[512 + t] = a1;
        __syncthreads();
        if (t < 128) { const int s = t >> 6, jj = t & 63; float v = 0.f; for (int q = 0; q < 8; ++q) v += c.lds[s * 512 + q * 64 + jj];
            c.W<float>(WS_MODS)[((size_t)ll * 2 + s) * 6144 + cb * 64 + jj] = v + c.in(I_BADA)[(size_t)ll * 6144 + cb * 64 + jj]; }
        __syncthreads();
    }
    for (int i = blockIdx.x * NT + threadIdx.x; i < 4096; i += gridDim.x * NT) {
        const int g = (i >> 6) & 15;
        const float lre = c.in(I_SLRE)[i], lim = c.in(I_SLIM)[i], dt = expf(c.in(I_SLOG)[(i >> 6)]);
        (void)g;
        const float mag = expf(lre * dt), lbr = mag * cosf(lim * dt), lbi = mag * sinf(lim * dt);
        const float nr = lbr - 1.0f, ni = lbi, den = lre * lre + lim * lim;
        const float kr = (nr * lre + ni * lim) / den, ki = (ni * lre - nr * lim) / den;
        c.W<float>(WS_S5LB)[i * 2] = lbr; c.W<float>(WS_S5LB)[i * 2 + 1] = lbi;
        for (int cc = 0; cc < 16; ++cc) { const float br = c.in(I_SBRE)[(size_t)i * 16 + cc], bi = c.in(I_SBIM)[(size_t)i * 16 + cc];
            c.W<float>(WS_S5BB)[(size_t)i * 32 + cc] = kr * br - ki * bi; c.W<float>(WS_S5BB)[(size_t)i * 32 + 16 + cc] = kr * bi + ki * br; }
    }
}

__device__ void phase_norm(const Ctx& c, int which) {
    const int wave = threadIdx.x >> 6, lane = threadIdx.x & 63;
    const float* g = c.in(which == 0 ? I_N1G : I_N2G) + (size_t)c.l * D;
    const int r0 = which == 0 ? 0 : c.row_begin();
    for (int row = r0 + blockIdx.x * 8 + wave; row < ROWS; row += gridDim.x * 8) {
        const float* x = which == 0 ? c.xin_row(row) : c.xout_row(row);
        const float* m = c.mods(row) + (which == 0 ? 0 : 3 * D);
        f32x4 v[4]; float ss = 0.f;
#pragma unroll
        for (int i = 0; i < 4; ++i) { v[i] = *(const f32x4*)(x + i * 256 + lane * 4); ss += v[i].x * v[i].x + v[i].y * v[i].y + v[i].z * v[i].z + v[i].w * v[i].w; }
#pragma unroll
        for (int o = 32; o >= 1; o >>= 1) ss += __shfl_xor(ss, o);
        const float rstd = rsqrtf(ss * (1.0f / D) + 1e-6f);
        bf16* o = c.W<bf16>(WS_HN) + (size_t)row * D;
#pragma unroll
        for (int i = 0; i < 4; ++i) { const int col = i * 256 + lane * 4; const f32x4 gg = *(const f32x4*)(g + col), sh = *(const f32x4*)(m + col), sc = *(const f32x4*)(m + D + col);
            const f32x4 y = (v[i] * rstd * gg) * (1.0f + sc) + sh; u32x2 w; w.x = pack2(y.x, y.y); w.y = pack2(y.z, y.w); *(u32x2*)(o + col) = w; }
    }
}

template <class RowMap>
__device__ __forceinline__ void tile_mm(float (&acc)[4][4], const bf16* A, int lda, const RowMap& amap, const bf16* Bt, int ldb, int brow0, int K, float* lds) {
    float* As = lds; float* Bs = lds + 128 * 33;
    const int t = threadIdx.x, ty = t >> 4, tx = t & 15;
    const int ar = t >> 2, ks = (t & 3) * 8;
    const bf16* ap = A + (size_t)amap(ar) * lda + ks;
    const bf16* bp = Bt + (size_t)(brow0 + (ar & 63)) * ldb + ks;
    for (int k0 = 0; k0 < K; k0 += 32) {
        { const u32x4 v = *(const u32x4*)(ap + k0); float* d = As + ar * 33 + ks;
          d[0] = lo2f(v.x); d[1] = hi2f(v.x); d[2] = lo2f(v.y); d[3] = hi2f(v.y); d[4] = lo2f(v.z); d[5] = hi2f(v.z); d[6] = lo2f(v.w); d[7] = hi2f(v.w); }
        if (t < 256) { const u32x4 v = *(const u32x4*)(bp + k0); float* d = Bs + ar * 33 + ks;
          d[0] = lo2f(v.x); d[1] = hi2f(v.x); d[2] = lo2f(v.y); d[3] = hi2f(v.y); d[4] = lo2f(v.z); d[5] = hi2f(v.z); d[6] = lo2f(v.w); d[7] = hi2f(v.w); }
        __syncthreads();
#pragma unroll 8
        for (int kk = 0; kk < 32; ++kk) {
            float a[4], b[4];
#pragma unroll
            for (int i = 0; i < 4; ++i) { a[i] = As[(ty * 4 + i) * 33 + kk]; b[i] = Bs[(tx * 4 + i) * 33 + kk]; }
#pragma unroll
            for (int i = 0; i < 4; ++i)
#pragma unroll
                for (int j = 0; j < 4; ++j) acc[i][j] += a[i] * b[j];
        }
        __syncthreads();
    }
}
struct RowLin { int r0; __device__ __forceinline__ int operator()(int i) const { return r0 + i; } };

template <class Epi>
__device__ void gemm_naive(const bf16* A, int lda, const bf16* Bt, int ldb, int row0, int nrows, int N, int K, const Epi& epi, float* lds) {
    const int ntm = nrows / 128, ntn = N / 64, t = threadIdx.x, ty = t >> 4, tx = t & 15;
    for (int tile = blockIdx.x; tile < ntm * ntn; tile += gridDim.x) {
        const int tm = tile / ntn, tn = tile % ntn;
        float acc[4][4];
#pragma unroll
        for (int i = 0; i < 4; ++i)
#pragma unroll
            for (int j = 0; j < 4; ++j) acc[i][j] = 0.f;
        tile_mm(acc, A, lda, RowLin{row0 + tm * 128}, Bt, ldb, tn * 64, K, lds);
#pragma unroll
        for (int i = 0; i < 4; ++i) epi.store4(row0 + tm * 128 + ty * 4 + i, tn * 64 + tx * 4, (f32x4){acc[i][0], acc[i][1], acc[i][2], acc[i][3]});
    }
}

struct EpiInproj { bf16* z; float* za;
    __device__ __forceinline__ void store4(int row, int col, f32x4 v) const {
        if (col < NZ) { u32x2 w; w.x = pack2(v.x, v.y); w.y = pack2(v.z, v.w); *(u32x2*)(z + (size_t)row * NZ + col) = w; }
        else if (col < GATE0) *(f32x4*)(za + (size_t)row * 32 + (col - NZ)) = v; } };
struct EpiGlu { const bf16* ys5; bf16* y;
    __device__ __forceinline__ void store4(int row, int col, f32x4 v) const {
        const u32x2 zz = *(const u32x2*)(ys5 + (size_t)row * 256 + col);
        const float z0 = lo2f(zz.x), z1 = hi2f(zz.x), z2 = lo2f(zz.y), z3 = hi2f(zz.y);
        u32x2 w; w.x = pack2(z0 * sigmoidf_(v.x), z1 * sigmoidf_(v.y)); w.y = pack2(z2 * sigmoidf_(v.z), z3 * sigmoidf_(v.w));
        *(u32x2*)(y + (size_t)row * D + col) = w; } };
struct EpiResid { const Ctx* c; int gate_off; bool from_in;
    __device__ __forceinline__ void store4(int row, int col, f32x4 v) const {
        const float* xs = (from_in ? c->xin_row(row) : c->xout_row(row)) + col;
        const f32x4 g = *(const f32x4*)(c->mods(row) + gate_off + col);
        *(f32x4*)(c->xout_row(row) + col) = *(const f32x4*)xs + g * v; } };

__device__ void phase_merge(const Ctx& c) {
    const int r0 = c.row_begin(), ntm = (ROWS - r0) / 128, ntn = D / 64, t = threadIdx.x, ty = t >> 4, tx = t & 15;
    bf16* merged = c.W<bf16>(WS_Z);
    for (int tile = blockIdx.x; tile < ntm * ntn; tile += gridDim.x) {
        const int tm = tile / ntn, tn = tile % ntn, row0 = r0 + tm * 128;
        float m[4][4];
#pragma unroll
        for (int i = 0; i < 4; ++i)
#pragma unroll
            for (int j = 0; j < 4; ++j) m[i][j] = 0.f;
        for (int n = 0; n < 4; ++n) {
            float ag[4][4], ap[4][4];
#pragma unroll
            for (int i = 0; i < 4; ++i)
#pragma unroll
                for (int j = 0; j < 4; ++j) { ag[i][j] = 0.f; ap[i][j] = 0.f; }
            tile_mm(ag, c.W<bf16>(WS_HN), D, RowLin{row0}, c.W<bf16>(WS_WGT), D, n * D + tn * 64, D, c.lds);
            tile_mm(ap, c.W<bf16>(WS_Y) + n * 256, D, RowLin{row0}, c.W<bf16>(WS_WBRT) + (size_t)n * D * 256, 256, tn * 64, 256, c.lds);
#pragma unroll
            for (int i = 0; i < 4; ++i)
#pragma unroll
                for (int j = 0; j < 4; ++j) m[i][j] += sigmoidf_(ag[i][j]) * ap[i][j];
        }
#pragma unroll
        for (int i = 0; i < 4; ++i) { u32x2 w; w.x = pack2(m[i][0], m[i][1]); w.y = pack2(m[i][2], m[i][3]);
            *(u32x2*)(merged + (size_t)(row0 + ty * 4 + i) * D + tn * 64 + tx * 4) = w; }
    }
}

struct RowRun { int seg0, seglen, t0; __device__ __forceinline__ int operator()(int i) const { int t = t0 + i; t = t < 0 ? 0 : (t >= seglen ? seglen - 1 : t); return seg0 + t; } };
__device__ void phase_ffn_up(const Ctx& c) {
    const int t = threadIdx.x, ty = t >> 4, tx = t & 15;
    const int nrun_ctx = (c.l == DEPTH - 1) ? 0 : 3, nrun_lat = 131, ncb = DFF / 64;
    float* gts = c.lds + 128 * 33 + 64 * 33;
    bf16* act = c.W<bf16>(WS_Z);
    const float* cw = c.in(I_FCW) + (size_t)c.l * 3 * DFF; const float* cb = c.in(I_FCB) + (size_t)c.l * DFF;
    for (int tile = blockIdx.x; tile < (nrun_ctx + nrun_lat) * ncb; tile += gridDim.x) {
        const int run = tile / ncb, cbk = tile % ncb;
        RowRun rm; if (run < nrun_ctx) { rm.seg0 = 0; rm.seglen = CTX; rm.t0 = 126 * run - 1; } else { rm.seg0 = CTX; rm.seglen = SEQ; rm.t0 = 126 * (run - nrun_ctx) - 1; }
        const int ch0 = cbk * 64, brow_a = 256 * (ch0 >> 7) + (ch0 & 127);
        float aa[4][4], ag[4][4];
#pragma unroll
        for (int i = 0; i < 4; ++i)
#pragma unroll
            for (int j = 0; j < 4; ++j) { aa[i][j] = 0.f; ag[i][j] = 0.f; }
        tile_mm(aa, c.W<bf16>(WS_HN), D, rm, c.W<bf16>(WS_WUPT), D, brow_a, D, c.lds);
        tile_mm(ag, c.W<bf16>(WS_HN), D, rm, c.W<bf16>(WS_WUPT), D, brow_a + 128, D, c.lds);
#pragma unroll
        for (int i = 0; i < 4; ++i) { const int ri = ty * 4 + i, tok = rm.t0 + ri; const bool ok = tok >= 0 && tok < rm.seglen;
#pragma unroll
            for (int j = 0; j < 4; ++j) gts[(ri + 1) * 65 + tx * 4 + j] = ok ? ag[i][j] : 0.f; }
        __syncthreads();
#pragma unroll
        for (int i = 0; i < 4; ++i) { const int ri = ty * 4 + i, tok = rm.t0 + ri;
            if (ri >= 1 && ri <= 126 && tok >= 0 && tok < rm.seglen) { float o[4];
#pragma unroll
                for (int j = 0; j < 4; ++j) { const int ch = ch0 + tx * 4 + j, cl = tx * 4 + j;
                    const float gv = cw[ch] * gts[ri * 65 + cl] + cw[DFF + ch] * gts[(ri + 1) * 65 + cl] + cw[2 * DFF + ch] * gts[(ri + 2) * 65 + cl] + cb[ch];
                    o[j] = gelu_tanh(gv) * aa[i][j]; }
                u32x2 w; w.x = pack2(o[0], o[1]); w.y = pack2(o[2], o[3]);
                *(u32x2*)(act + (size_t)(rm.seg0 + tok) * DFF + ch0 + tx * 4) = w; } }
        __syncthreads();
    }
}

__device__ void da_prep(const Ctx& c) {
    const int wave = threadIdx.x >> 6, lane = threadIdx.x & 63, vec = lane >> 2, sub = lane & 3;
    const bool isq = vec < 8;
    const float* gain = c.in(isq ? I_DQN : I_DKN) + (size_t)c.l * 32 + sub * 8;
    const float qscale = 0.17677669529663687f * 1.4426950408889634f;
    bf16* z = c.W<bf16>(WS_Z);
    float inv[8];
#pragma unroll
    for (int e = 0; e < 8; ++e) inv[e] = 1.0f / powf(10000.0f, (float)(2 * e) / 16.0f);
    for (int row = blockIdx.x * 8 + wave; row < ROWS; row += gridDim.x * 8) {
        bf16* pz = z + (size_t)row * NZ + (isq ? ZC_DAQ : ZC_DAK) + (vec & 7) * 32 + sub * 8;
        const u32x4 raw = *(const u32x4*)pz;
        float x[8] = {lo2f(raw.x), hi2f(raw.x), lo2f(raw.y), hi2f(raw.y), lo2f(raw.z), hi2f(raw.z), lo2f(raw.w), hi2f(raw.w)};
        float ss = 0.f;
#pragma unroll
        for (int e = 0; e < 8; ++e) ss += x[e] * x[e];
        ss += __shfl_xor(ss, 1); ss += __shfl_xor(ss, 2);
        const float rstd = rsqrtf(ss * (1.0f / 32.0f) + 1e-6f);
#pragma unroll
        for (int e = 0; e < 8; ++e) x[e] = x[e] * rstd * gain[e];
        if (row >= CTX) {
            const int tok = row - CTX; const float pos = (float)((sub < 2) ? (tok >> 6) : (tok & 63));
#pragma unroll
            for (int e = 0; e < 8; ++e) { const float ang = pos * inv[e], cs = cosf(ang), sn = sinf(ang); const float other = __shfl_xor(x[e], 1);
                x[e] = (sub & 1) ? (other * sn + x[e] * cs) : (x[e] * cs - other * sn); }
        }
        if (isq) {
#pragma unroll
            for (int e = 0; e < 8; ++e) x[e] *= qscale; }
        u32x4 w; w.x = pack2(x[0], x[1]); w.y = pack2(x[2], x[3]); w.z = pack2(x[4], x[5]); w.w = pack2(x[6], x[7]);
        *(u32x4*)pz = w;
    }
}

__device__ void s5_local(const Ctx& c) {
    const int wave = threadIdx.x >> 6, lane = threadIdx.x & 63;
    float* ut = c.lds + wave * 1024;
    const bf16* z = c.W<bf16>(WS_Z);
    for (int task = blockIdx.x; task < NCHUNK * 2; task += gridDim.x) {
        const int ch = task >> 1, d = task & 1;
        for (int gi = 0; gi < 2; ++gi) {
            const int g = wave + 8 * gi; const int si = ((c.l * 2 + d) * 16 + g) * 64 + lane;
            const float lbr = c.W<float>(WS_S5LB)[si * 2], lbi = c.W<float>(WS_S5LB)[si * 2 + 1];
            float bbr[16], bbi[16];
#pragma unroll
            for (int k = 0; k < 16; ++k) { bbr[k] = c.W<float>(WS_S5BB)[(size_t)si * 32 + k]; bbi[k] = c.W<float>(WS_S5BB)[(size_t)si * 32 + 16 + k]; }
            __syncthreads();
            { const bf16* pu = z + (size_t)(ch * 64 + lane) * NZ + ZC_SSM + g * 16; const u32x4 a = *(const u32x4*)pu, b = *(const u32x4*)(pu + 8); float* o = ut + lane * 16;
              o[0] = lo2f(a.x); o[1] = hi2f(a.x); o[2] = lo2f(a.y); o[3] = hi2f(a.y); o[4] = lo2f(a.z); o[5] = hi2f(a.z); o[6] = lo2f(a.w); o[7] = hi2f(a.w);
              o[8] = lo2f(b.x); o[9] = hi2f(b.x); o[10] = lo2f(b.y); o[11] = hi2f(b.y); o[12] = lo2f(b.z); o[13] = hi2f(b.z); o[14] = lo2f(b.w); o[15] = hi2f(b.w); }
            __syncthreads();
            float hr = 0.f, hi = 0.f;
            for (int s = 0; s < 64; ++s) { const int i = d ? 63 - s : s; const float* u = ut + i * 16; float br = 0.f, bi = 0.f;
#pragma unroll
                for (int k = 0; k < 16; ++k) { br += bbr[k] * u[k]; bi += bbi[k] * u[k]; }
                const float nr = lbr * hr - lbi * hi + br, ni = lbr * hi + lbi * hr + bi; hr = nr; hi = ni; }
            float* e = c.W<float>(WS_S5END) + ((size_t)(ch * 2 + d) * 16 + g) * 128 + lane * 2; e[0] = hr; e[1] = hi;
        }
    }
}
__device__ void s5_final(const Ctx& c) {
    const int wave = threadIdx.x >> 6, lane = threadIdx.x & 63;
    float* ut = c.lds + wave * 2048; float* ya = ut + 1024;
    const bf16* z = c.W<bf16>(WS_Z);
    const int c0 = (c.l == DEPTH - 1) ? 4 : 0;
    for (int ch = c0 + blockIdx.x; ch < NCHUNK; ch += gridDim.x) {
        for (int gi = 0; gi < 2; ++gi) {
            const int g = wave + 8 * gi;
            __syncthreads();
            { const bf16* pu = z + (size_t)(ch * 64 + lane) * NZ + ZC_SSM + g * 16; const u32x4 a = *(const u32x4*)pu, b = *(const u32x4*)(pu + 8); float* o = ut + lane * 16;
              o[0] = lo2f(a.x); o[1] = hi2f(a.x); o[2] = lo2f(a.y); o[3] = hi2f(a.y); o[4] = lo2f(a.z); o[5] = hi2f(a.z); o[6] = lo2f(a.w); o[7] = hi2f(a.w);
              o[8] = lo2f(b.x); o[9] = hi2f(b.x); o[10] = lo2f(b.y); o[11] = hi2f(b.y); o[12] = lo2f(b.z); o[13] = hi2f(b.z); o[14] = lo2f(b.w); o[15] = hi2f(b.w);
              const float* dsk = c.in(I_SD) + (size_t)c.l * 256 + g * 16;
#pragma unroll
              for (int k = 0; k < 16; ++k) ya[lane * 16 + k] = o[k] * dsk[k]; }
            __syncthreads();
            for (int d = 0; d < 2; ++d) {
                const int si = ((c.l * 2 + d) * 16 + g) * 64 + lane;
                const float lbr = c.W<float>(WS_S5LB)[si * 2], lbi = c.W<float>(WS_S5LB)[si * 2 + 1];
                float bbr[16], bbi[16], cr[16], ci[16];
#pragma unroll
                for (int k = 0; k < 16; ++k) { bbr[k] = c.W<float>(WS_S5BB)[(size_t)si * 32 + k]; bbi[k] = c.W<float>(WS_S5BB)[(size_t)si * 32 + 16 + k];
                    const size_t cix = ((size_t)((c.l * 2 + d) * 16 + g) * 16 + k) * 64 + lane; cr[k] = c.in(I_SCRE)[cix]; ci[k] = c.in(I_SCIM)[cix]; }
                const float* st = c.W<float>(WS_S5START) + ((size_t)(ch * 2 + d) * 16 + g) * 128 + lane * 2;
                float hr = st[0], hi = st[1];
                const bool b5 = lane & 32, b4 = lane & 16, b3 = lane & 8, b2 = lane & 4;
                const int cidx = (b5 ? 8 : 0) + (b4 ? 4 : 0) + (b3 ? 2 : 0) + (b2 ? 1 : 0);
                for (int s = 0; s < 64; ++s) { const int i = d ? 63 - s : s; const float* u = ut + i * 16; float br = 0.f, bi = 0.f;
#pragma unroll
                    for (int k = 0; k < 16; ++k) { br += bbr[k] * u[k]; bi += bbi[k] * u[k]; }
                    const float nr = lbr * hr - lbi * hi + br, ni = lbr * hi + lbi * hr + bi; hr = nr; hi = ni;
                    float v8[8], v4[4], v2[2], v1;
#pragma unroll
                    for (int k = 0; k < 8; ++k) { const float a = hr * cr[k] - hi * ci[k], b = hr * cr[k + 8] - hi * ci[k + 8]; const float send = b5 ? a : b, keep = b5 ? b : a; v8[k] = keep + __shfl_xor(send, 32); }
#pragma unroll
                    for (int k = 0; k < 4; ++k) { const float send = b4 ? v8[k] : v8[k + 4], keep = b4 ? v8[k + 4] : v8[k]; v4[k] = keep + __shfl_xor(send, 16); }
#pragma unroll
                    for (int k = 0; k < 2; ++k) { const float send = b3 ? v4[k] : v4[k + 2], keep = b3 ? v4[k + 2] : v4[k]; v2[k] = keep + __shfl_xor(send, 8); }
                    { const float send = b2 ? v2[0] : v2[1], keep = b2 ? v2[1] : v2[0]; v1 = keep + __shfl_xor(send, 4); }
                    v1 += __shfl_xor(v1, 2); v1 += __shfl_xor(v1, 1);
                    if ((lane & 3) == 0) ya[i * 16 + cidx] += v1;
                }
            }
            __syncthreads();
            { bf16* po = c.W<bf16>(WS_YS5) + (size_t)(ch * 64 + lane) * 256 + g * 16; const float* yy = ya + lane * 16; u32x4 a, b;
              a.x = pack2(gelu_tanh(yy[0]), gelu_tanh(yy[1])); a.y = pack2(gelu_tanh(yy[2]), gelu_tanh(yy[3])); a.z = pack2(gelu_tanh(yy[4]), gelu_tanh(yy[5])); a.w = pack2(gelu_tanh(yy[6]), gelu_tanh(yy[7]));
              b.x = pack2(gelu_tanh(yy[8]), gelu_tanh(yy[9])); b.y = pack2(gelu_tanh(yy[10]), gelu_tanh(yy[11])); b.z = pack2(gelu_tanh(yy[12]), gelu_tanh(yy[13])); b.w = pack2(gelu_tanh(yy[14]), gelu_tanh(yy[15]));
              *(u32x4*)po = a; *(u32x4*)(po + 8) = b; }
        }
    }
}

__device__ void lru_pass(const Ctx& c, bool final_pass) {
    const int t = threadIdx.x, d = t >> 8, chn = t & 255, nb = chn >> 5, jj = chn & 31;
    float* xc = c.lds; float* hs = c.lds + 64 * 256;
    const bf16* z = c.W<bf16>(WS_Z);
    const float* cw = c.in(I_LCW) + (size_t)c.l * 4 * 256; const float cbv = c.in(I_LCB)[(size_t)c.l * 256 + chn];
    float wr[32], wi[32];
    { const size_t base = ((size_t)(c.l * 2 + d) * 8 + nb) * 1024 + jj;
#pragma unroll
      for (int k = 0; k < 32; ++k) { wr[k] = c.in(I_LWR)[base + k * 32]; wi[k] = c.in(I_LWI)[base + k * 32]; } }
    const float brv = c.in(I_LBR)[(size_t)(c.l * 2 + d) * 256 + chn], biv = c.in(I_LBI)[(size_t)(c.l * 2 + d) * 256 + chn];
    const float ls = logsigmoidf_(c.in(I_LLAM)[(size_t)(c.l * 2 + d) * 256 + chn]);
    const float w0 = cw[chn], w1 = cw[256 + chn], w2 = cw[512 + chn], w3 = cw[768 + chn];
    const int c0 = (final_pass && c.l == DEPTH - 1) ? 4 : 0;
    for (int ch = c0 + blockIdx.x; ch < NCHUNK; ch += gridDim.x) {
        const int segb = ch < 4 ? 0 : CTX, sege = ch < 4 ? CTX : ROWS;
        __syncthreads();
        for (int i = d * 32; i < d * 32 + 32; ++i) { const int row = ch * 64 + i; float v = cbv;
            { const int r = row - 2; if (r >= segb && r < sege) v += w0 * bf2f(z[(size_t)r * NZ + ZC_LRUX + chn]); }
            { const int r = row - 1; if (r >= segb && r < sege) v += w1 * bf2f(z[(size_t)r * NZ + ZC_LRUX + chn]); }
            { const int r = row;     v += w2 * bf2f(z[(size_t)r * NZ + ZC_LRUX + chn]); }
            { const int r = row + 1; if (r >= segb && r < sege) v += w3 * bf2f(z[(size_t)r * NZ + ZC_LRUX + chn]); }
            xc[i * 256 + chn] = v; if (final_pass) hs[i * 256 + chn] = 0.f; }
        __syncthreads();
        float A = 1.f, h = final_pass ? c.W<float>(WS_LRUSTART)[(size_t)(ch * 2 + d) * 256 + chn] : 0.f;
        for (int s = 0; s < 64; ++s) { const int i = d ? 63 - s : s; const float* xv = xc + i * 256 + nb * 32; float ar = brv, ai = biv;
#pragma unroll
            for (int k = 0; k < 32; ++k) { const float x = xv[k]; ar += x * wr[k]; ai += x * wi[k]; }
            const float r = sigmoidf_(ar), ig = sigmoidf_(ai), la = 8.0f * r * ls, a = expf(la);
            const float b = sqrtf(-expm1f(2.0f * la)) * (ig * xc[i * 256 + chn]);
            A *= a; h = a * h + b;
            if (final_pass) atomicAdd(&hs[i * 256 + chn], h); }
        if (!final_pass) { float* e = c.W<float>(WS_LRUEND) + ((size_t)(ch * 2 + d) * 256 + chn) * 2; e[0] = A; e[1] = h; }
        else { __syncthreads();
            for (int i = d * 32; i < d * 32 + 32; ++i) { const int row = ch * 64 + i; const float yv = bf2f(z[(size_t)row * NZ + ZC_LRUY + chn]);
                c.W<bf16>(WS_Y)[(size_t)row * D + 256 + chn] = f2bf(hs[i * 256 + chn] * gelu_tanh(yv)); } }
    }
}

__device__ void gla_pass(const Ctx& c, bool final_pass) {
    const int t = threadIdx.x;
    float* qs = c.lds;
    float* ks = qs + 64 * 33;
    float* bs = ks + 64 * 33;
    float* vs = bs + 64 * 33;
    float* at = vs + 64 * 65;
    float* S0 = at + 64 * 65;
    float* os = S0 + 32 * 65;
    const bf16* z = c.W<bf16>(WS_Z); const float* za = c.W<float>(WS_ZA);
    const int c0 = (final_pass && c.l == DEPTH - 1) ? 4 : 0;
    for (int task = c0 * 4 + blockIdx.x; task < NCHUNK * 4; task += gridDim.x) {
        const int ch = task >> 2, hd = task & 3;
        for (int d = 0; d < 2; ++d) {
            __syncthreads();
            for (int e = t; e < 64 * 32; e += NT) { const int i = e >> 5, k = e & 31, row = ch * 64 + (d ? 63 - i : i);
                qs[i * 33 + k] = bf2f(z[(size_t)row * NZ + ZC_GQ + hd * 32 + k]) * 0.17677669529663687f;
                ks[i * 33 + k] = bf2f(z[(size_t)row * NZ + ZC_GK + hd * 32 + k]);
                const float* a = za + (size_t)row * 32 + d * 16; const float* w2 = c.in(I_GWA2) + (size_t)(c.l * 2 + d) * 16 * 128 + hd * 32 + k;
                float zz = c.in(I_GBA)[(size_t)(c.l * 2 + d) * 128 + hd * 32 + k];
#pragma unroll
                for (int r = 0; r < 16; ++r) zz += a[r] * w2[r * 128];
                bs[i * 33 + k] = logsigmoidf_(zz) * (1.0f / 16.0f); }
            for (int e = t; e < 64 * 64; e += NT) { const int i = e >> 6, k = e & 63, row = ch * 64 + (d ? 63 - i : i); vs[i * 65 + k] = bf2f(z[(size_t)row * NZ + ZC_GV + hd * 64 + k]); }
            if (final_pass) for (int e = t; e < 32 * 64; e += NT) S0[(e >> 6) * 65 + (e & 63)] = c.W<float>(WS_GLAS0)[((size_t)(ch * 2 + d) * 4 + hd) * 2048 + e];
            __syncthreads();
            if (t < 32) { float a = 0.f; for (int i = 0; i < 64; ++i) { a += bs[i * 33 + t]; bs[i * 33 + t] = a; } }
            __syncthreads();
            if (!final_pass) {
                for (int e = t; e < 64 * 32; e += NT) { const int i = e >> 5, k = e & 31; ks[i * 33 + k] *= expf(bs[63 * 33 + k] - bs[i * 33 + k]); }
                __syncthreads();
                for (int e = t; e < 32 * 64; e += NT) { const int dk = e >> 6, dv = e & 63; float a = 0.f; for (int j = 0; j < 64; ++j) a += ks[j * 33 + dk] * vs[j * 65 + dv];
                    c.W<float>(WS_GLAKV)[((size_t)(ch * 2 + d) * 4 + hd) * 2048 + e] = a; }
                if (t < 32) c.W<float>(WS_GLADEC)[((size_t)(ch * 2 + d) * 4 + hd) * 32 + t] = expf(bs[63 * 33 + t]);
            } else {
                for (int e = t; e < 64 * 32; e += NT) { const int i = e >> 5, k = e & 31; const float b = bs[i * 33 + k]; qs[i * 33 + k] *= expf(b); ks[i * 33 + k] *= expf(-b); }
                __syncthreads();
                for (int e = t; e < 64 * 64; e += NT) { const int i = e >> 6, j = e & 63; float a = 0.f;
                    if (j <= i) { for (int k = 0; k < 32; ++k) a += qs[i * 33 + k] * ks[j * 33 + k]; }
                    at[i * 65 + j] = a; }
                __syncthreads();
                for (int e = t; e < 64 * 64; e += NT) { const int i = e >> 6, dv = e & 63; float a = 0.f;
                    for (int j = 0; j <= i; ++j) a += at[i * 65 + j] * vs[j * 65 + dv];
                    for (int k = 0; k < 32; ++k) a += qs[i * 33 + k] * S0[k * 65 + dv];
                    const int tk = d ? 63 - i : i; if (d == 0) os[tk * 65 + dv] = a; else os[tk * 65 + dv] += a; }
            }
        }
        if (final_pass) { __syncthreads();
            const int tk = t >> 3, sub = t & 7, row = ch * 64 + tk; float ss = 0.f;
#pragma unroll
            for (int k = 0; k < 8; ++k) { const float v = os[tk * 65 + sub * 8 + k]; ss += v * v; }
            ss += __shfl_xor(ss, 1); ss += __shfl_xor(ss, 2); ss += __shfl_xor(ss, 4);
            const float rstd = rsqrtf(ss * (1.0f / 64.0f) + 1e-6f); float o[8];
#pragma unroll
            for (int k = 0; k < 8; ++k) { const int dv = sub * 8 + k; const float gg = bf2f(z[(size_t)row * NZ + ZC_GG + hd * 64 + dv]);
                o[k] = os[tk * 65 + dv] * rstd * c.in(I_GON)[(size_t)c.l * 64 + dv] * siluf_(gg); }
            u32x4 w; w.x = pack2(o[0], o[1]); w.y = pack2(o[2], o[3]); w.z = pack2(o[4], o[5]); w.w = pack2(o[6], o[7]);
            *(u32x4*)(c.W<bf16>(WS_Y) + (size_t)row * D + 768 + hd * 64 + sub * 8) = w; }
    }
}

__device__ void phase_carry(const Ctx& c) {
    const int b = blockIdx.x, t = threadIdx.x;
    if (b < 4) {
        const int i = b * NT + t, d = i >> 10, gp = i & 1023; const int si = (c.l * 2 + d) * 1024 + gp;
        float ar = c.W<float>(WS_S5LB)[si * 2], ai = c.W<float>(WS_S5LB)[si * 2 + 1];
        for (int q = 0; q < 6; ++q) { const float nr = ar * ar - ai * ai, ni = 2.f * ar * ai; ar = nr; ai = ni; }
        float hr = 0.f, hi = 0.f;
        for (int s = 0; s < NCHUNK; ++s) { const int ch = chunk_of(s, d); const size_t ix = ((size_t)(ch * 2 + d) * 1024 + gp) * 2;
            const float er = c.W<float>(WS_S5END)[ix], ei = c.W<float>(WS_S5END)[ix + 1];
            c.W<float>(WS_S5START)[ix] = hr; c.W<float>(WS_S5START)[ix + 1] = hi;
            const float nr = ar * hr - ai * hi + er, ni = ar * hi + ai * hr + ei; hr = nr; hi = ni; }
    } else if (b == 4) {
        const int d = t >> 8, chn = t & 255; float h = 0.f;
        for (int s = 0; s < NCHUNK; ++s) { const int ch = chunk_of(s, d); const size_t ix = (size_t)(ch * 2 + d) * 256 + chn;
            const float A = c.W<float>(WS_LRUEND)[ix * 2], B = c.W<float>(WS_LRUEND)[ix * 2 + 1];
            c.W<float>(WS_LRUSTART)[ix] = h; h = A * h + B; }
    } else if (b >= 8 && b < 40) {
        const int i = (b - 8) * NT + t, d = i >> 13, hd = (i >> 11) & 3, e = i & 2047, dk = e >> 6; float S = 0.f;
        for (int s = 0; s < NCHUNK; ++s) { const int ch = chunk_of(s, d); const size_t ix = ((size_t)(ch * 2 + d) * 4 + hd) * 2048 + e;
            const float kv = c.W<float>(WS_GLAKV)[ix], dec = c.W<float>(WS_GLADEC)[((size_t)(ch * 2 + d) * 4 + hd) * 32 + dk];
            c.W<float>(WS_GLAS0)[ix] = S; S = dec * S + kv; }
    }
}

__device__ void attn_naive(const Ctx& c) {
    const int t = threadIdx.x, comp = t >> 8, qi = t & 255;
    float* kt = c.lds;
    float* vt = kt + 64 * 64;
    float* ex = vt + 64 * 64;
    const bf16* z = c.W<bf16>(WS_Z);
    const float li = lam_init_of(c.l);
    float lam; { const float* lp = c.in(I_DLAM) + (size_t)c.l * 128; float s0 = 0.f, s1 = 0.f; for (int k = 0; k < 32; ++k) { s0 += lp[k] * lp[32 + k]; s1 += lp[64 + k] * lp[96 + k]; } lam = expf(s0) - expf(s1) + li; }
    float gq = 0.f, gk = 0.f; for (int k = 0; k < 32; ++k) { gq = fmaxf(gq, fabsf(c.in(I_DQN)[(size_t)c.l * 32 + k])); gk = fmaxf(gk, fabsf(c.in(I_DKN)[(size_t)c.l * 32 + k])); }
    const float mb = 32.0f * gq * gk * (0.17677669529663687f * 1.4426950408889634f) * 1.02f;
    const int qb0 = (c.l == DEPTH - 1) ? 1 : 0;
    for (int task = qb0 * 4 + blockIdx.x; task < 65 * 4; task += gridDim.x) {
        const int qb = task >> 2, hd = task & 3, row = qb * 256 + qi; const int nkeys = qb == 0 ? CTX : ROWS;
        float q[32], o[64], lsum = 0.f;
        { const bf16* pq = z + (size_t)row * NZ + ZC_DAQ + hd * 64 + comp * 32;
#pragma unroll
          for (int k = 0; k < 4; ++k) { const u32x4 v = *(const u32x4*)(pq + k * 8); q[k * 8 + 0] = lo2f(v.x); q[k * 8 + 1] = hi2f(v.x); q[k * 8 + 2] = lo2f(v.y); q[k * 8 + 3] = hi2f(v.y); q[k * 8 + 4] = lo2f(v.z); q[k * 8 + 5] = hi2f(v.z); q[k * 8 + 6] = lo2f(v.w); q[k * 8 + 7] = hi2f(v.w); } }
#pragma unroll
        for (int k = 0; k < 64; ++k) o[k] = 0.f;
        for (int k0 = 0; k0 < nkeys; k0 += 64) {
            __syncthreads();
            { const int j = t >> 3, seg = (t & 7) * 8;
              const u32x4 a = *(const u32x4*)(z + (size_t)(k0 + j) * NZ + ZC_DAK + hd * 64 + seg); float* dk = kt + j * 64 + seg;
              dk[0] = lo2f(a.x); dk[1] = hi2f(a.x); dk[2] = lo2f(a.y); dk[3] = hi2f(a.y); dk[4] = lo2f(a.z); dk[5] = hi2f(a.z); dk[6] = lo2f(a.w); dk[7] = hi2f(a.w);
              const u32x4 b = *(const u32x4*)(z + (size_t)(k0 + j) * NZ + ZC_DAV + hd * 64 + seg); float* dv = vt + j * 64 + seg;
              dv[0] = lo2f(b.x); dv[1] = hi2f(b.x); dv[2] = lo2f(b.y); dv[3] = hi2f(b.y); dv[4] = lo2f(b.z); dv[5] = hi2f(b.z); dv[6] = lo2f(b.w); dv[7] = hi2f(b.w); }
            __syncthreads();
            for (int j = 0; j < 64; ++j) { const float* kk = kt + j * 64 + comp * 32; float s = 0.f;
#pragma unroll
                for (int k = 0; k < 32; ++k) s += q[k] * kk[k];
                const float pv = exp2f(s - mb); lsum += pv; const float* vv = vt + j * 64;
#pragma unroll
                for (int k = 0; k < 64; ++k) o[k] += pv * vv[k]; }
        }
        __syncthreads();
        const float il = 1.0f / lsum;
        if (comp == 1) {
#pragma unroll
            for (int k = 0; k < 64; ++k) ex[qi * 66 + k] = o[k] * il; }
        __syncthreads();
        if (comp == 0) { float ss = 0.f;
#pragma unroll
            for (int k = 0; k < 64; ++k) { o[k] = o[k] * il - lam * ex[qi * 66 + k]; ss += o[k] * o[k]; }
            const float rstd = rsqrtf(ss * (1.0f / 64.0f) + 1e-6f) * (1.0f - li);
            bf16* po = c.W<bf16>(WS_Y) + (size_t)row * D + 512 + hd * 64; const float* gn = c.in(I_DON) + (size_t)c.l * 64;
#pragma unroll
            for (int k = 0; k < 8; ++k) { u32x4 w; w.x = pack2(o[k * 8 + 0] * rstd * gn[k * 8 + 0], o[k * 8 + 1] * rstd * gn[k * 8 + 1]); w.y = pack2(o[k * 8 + 2] * rstd * gn[k * 8 + 2], o[k * 8 + 3] * rstd * gn[k * 8 + 3]);
                w.z = pack2(o[k * 8 + 4] * rstd * gn[k * 8 + 4], o[k * 8 + 5] * rstd * gn[k * 8 + 5]); w.w = pack2(o[k * 8 + 6] * rstd * gn[k * 8 + 6], o[k * 8 + 7] * rstd * gn[k * 8 + 7]); *(u32x4*)(po + k * 8) = w; } }
    }
}

enum { PH_PREP = 0, PH_NORM1, PH_INPROJ, PH_MIX1, PH_CARRY, PH_MIX3, PH_GLU, PH_MERGE, PH_WOUT, PH_NORM2, PH_FFNUP, PH_FFNDN, PH_COUNT };

__device__ void run_phase(const Params& p, int l, int ph, float* lds) {
    Ctx c(p, l, lds);
    switch (ph) {
    case PH_PREP: phase_prep(c); break;
    case PH_NORM1: phase_norm(c, 0); break;
    case PH_INPROJ: { EpiInproj e{c.W<bf16>(WS_Z), c.W<float>(WS_ZA)}; gemm_naive(c.W<bf16>(WS_HN), D, c.W<bf16>(WS_WINT), D, 0, ROWS, NZP, D, e, lds); } break;
    case PH_MIX1: da_prep(c); s5_local(c); lru_pass(c, false); gla_pass(c, false); break;
    case PH_CARRY: phase_carry(c); break;
    case PH_MIX3: attn_naive(c); s5_final(c); lru_pass(c, true); gla_pass(c, true); break;
    case PH_GLU: { EpiGlu e{c.W<bf16>(WS_YS5), c.W<bf16>(WS_Y)}; const int r0 = c.row_begin(); gemm_naive(c.W<bf16>(WS_YS5), 256, c.W<bf16>(WS_WGLUT), 256, r0, ROWS - r0, 256, 256, e, lds); } break;
    case PH_MERGE: phase_merge(c); break;
    case PH_WOUT: { EpiResid e{&c, 2 * D, true}; const int r0 = c.row_begin(); gemm_naive(c.W<bf16>(WS_Z), D, c.W<bf16>(WS_WOUTT), D, r0, ROWS - r0, D, D, e, lds); } break;
    case PH_NORM2: phase_norm(c, 1); break;
    case PH_FFNUP: phase_ffn_up(c); break;
    case PH_FFNDN: { EpiResid e{&c, 5 * D, false}; const int r0 = c.row_begin(); gemm_naive(c.W<bf16>(WS_Z), DFF, c.W<bf16>(WS_WDNT), DFF, r0, ROWS - r0, D, DFF, e, lds); } break;
    default: break;
    }
}

__global__ void __launch_bounds__(NT) k_phase(Params p) {
    extern __shared__ __attribute__((aligned(16))) float lds[];
    run_phase(p, p.layer, p.phase, lds);
}

constexpr int LDS_BYTES = 144 * 1024;

extern "C" void kernel_launch(void* const* d_in, const int* in_sizes, int n_in, void* d_out, int out_size, void* d_ws, size_t ws_size, hipStream_t stream) {
    static int ready = 0;
    if (!ready) {
        if (n_in != N_IN || ws_size < WS_END) { fprintf(stderr, "kernel_launch: unexpected n_in %d or ws_size %zu (need %zu)\n", n_in, ws_size, (size_t)WS_END); ready = -1; return; }
        if (hipFuncSetAttribute((const void*)k_phase, hipFuncAttributeMaxDynamicSharedMemorySize, LDS_BYTES) != hipSuccess) { fprintf(stderr, "kernel_launch: hipFuncSetAttribute failed\n"); ready = -1; return; }
        ready = 1;
    }
    if (ready < 0) return;
    Params p{};
    for (int i = 0; i < N_IN; ++i) p.in[i] = (const float*)d_in[i];
    p.out = (float*)d_out; p.ws = (unsigned char*)d_ws;
    for (int l = 0; l < DEPTH; ++l)
        for (int ph = 0; ph < PH_COUNT; ++ph) { p.layer = l; p.phase = ph; hipLaunchKernelGGL(k_phase, dim3(256), dim3(NT), LDS_BYTES, stream, p); }
}
```

```cpp
#include <hip/hip_runtime.h>
#include <hip/hip_cooperative_groups.h>
#include <cstdio>
#include <cstdint>

typedef unsigned short bf16;
typedef float f32x4 __attribute__((ext_vector_type(4)));
typedef unsigned u32x4 __attribute__((ext_vector_type(4)));
typedef unsigned u32x2 __attribute__((ext_vector_type(2)));
typedef short bf16x8 __attribute__((ext_vector_type(8)));
typedef float f32x16 __attribute__((ext_vector_type(16)));
typedef float f32x8 __attribute__((ext_vector_type(8)));
typedef __bf16 bf16v8 __attribute__((ext_vector_type(8)));
#define MFMA32(a, b, c) __builtin_amdgcn_mfma_f32_32x32x16_bf16((a), (b), (c), 0, 0, 0)

constexpr int D = 1024, SEQ = 16384, CTX = 256, ROWS = SEQ + CTX, DEPTH = 2;
constexpr int IN_TOTAL = 6432, NZ = 2304, NZP = 2560, GATE0 = 2336, DFF = 2816;
constexpr int NCHUNK = ROWS / 64;
constexpr int NT = 512;
constexpr int ZC_SSM = 0, ZC_LRUX = 256, ZC_LRUY = 512, ZC_DAQ = 768, ZC_DAK = 1024, ZC_DAV = 1280, ZC_GQ = 1536, ZC_GK = 1664, ZC_GV = 1792, ZC_GG = 2048;

enum { I_X = 0, I_C, I_CTX, I_CCTX, I_WADA, I_BADA, I_N1G, I_N2G, I_WIN, I_SLRE, I_SLIM, I_SLOG, I_SBRE, I_SBIM, I_SCRE, I_SCIM, I_SD, I_SWGLU,
       I_LCW, I_LCB, I_LWR, I_LBR, I_LWI, I_LBI, I_LLAM, I_DQN, I_DKN, I_DLAM, I_DON, I_GWA2, I_GBA, I_GON, I_WBR, I_WOUT, I_WUP, I_FCW, I_FCB, I_WDN, N_IN };

constexpr size_t al256(size_t x) { return (x + 255) & ~(size_t)255; }
constexpr size_t WS_CTL = 0;
constexpr size_t WS_ROPE = 32768;
constexpr size_t WS_MODS = 65536;
constexpr size_t WS_S5LB = WS_MODS + al256((size_t)2 * 2 * 6144 * 4);
constexpr size_t WS_S5BB = WS_S5LB + al256((size_t)4096 * 2 * 4);
constexpr size_t WS_HCTX = WS_S5BB + al256((size_t)4096 * 32 * 4);
constexpr size_t WS_WINT = WS_HCTX + al256((size_t)CTX * D * 4);
constexpr size_t WS_WGT = WS_WINT + al256((size_t)NZP * D * 2);
constexpr size_t WS_WBRT = WS_WGT + al256((size_t)4096 * D * 2);
constexpr size_t WS_WOUTT = WS_WBRT + al256((size_t)4 * D * 256 * 2);
constexpr size_t WS_WUPT = WS_WOUTT + al256((size_t)D * D * 2);
constexpr size_t WS_WDNT = WS_WUPT + al256((size_t)2 * DFF * D * 2);
constexpr size_t WS_WGLUT = WS_WDNT + al256((size_t)D * DFF * 2);
constexpr size_t WS_HN = WS_WGLUT + al256((size_t)256 * 256 * 2);
constexpr size_t WS_Z = WS_HN + al256((size_t)(ROWS + 256) * D * 2);
constexpr size_t WS_ZA = WS_Z + al256((size_t)ROWS * DFF * 2);
constexpr size_t WS_Y = WS_ZA + al256((size_t)ROWS * 32 * 4);
constexpr size_t WS_YS5 = WS_Y + al256((size_t)ROWS * D * 2);
constexpr size_t WS_S5END = WS_YS5 + al256((size_t)ROWS * 256 * 2);
constexpr size_t WS_S5START = WS_S5END + al256((size_t)NCHUNK * 2 * 16 * 64 * 2 * 4);
constexpr size_t WS_LRUEND = WS_S5START + al256((size_t)NCHUNK * 2 * 16 * 64 * 2 * 4);
constexpr size_t WS_LRUSTART = WS_LRUEND + al256((size_t)NCHUNK * 2 * 256 * 2 * 4);
constexpr size_t WS_GLAKV = WS_LRUSTART + al256((size_t)NCHUNK * 2 * 256 * 4);
constexpr size_t WS_GLAS0 = WS_GLAKV + al256((size_t)NCHUNK * 2 * 4 * 32 * 64 * 4);
constexpr size_t WS_GLADEC = WS_GLAS0 + al256((size_t)NCHUNK * 2 * 4 * 32 * 64 * 4);
constexpr size_t WS_VT = WS_GLADEC + al256((size_t)NCHUNK * 2 * 4 * 32 * 4);
constexpr size_t WS_END = WS_VT + al256((size_t)256 * ROWS * 2);
constexpr size_t WS_SLABW = WS_Z + (size_t)48 * 1024 * 1024;
constexpr size_t WS_SLABF = WS_Y;
static_assert(WS_END <= (size_t)256 * 1024 * 1024, "workspace map exceeds 256 MiB");

constexpr int LDS_TOTAL = 144 * 1024;
constexpr int LDS_BYTES = LDS_TOTAL;
struct Params { const float* in[N_IN]; float* out; unsigned char* ws; int phase; int layer; };

__device__ __forceinline__ int tidx() { int t = threadIdx.x; asm volatile("" : "+v"(t)); return t; }
__device__ __forceinline__ float bf2f(bf16 b) { return __uint_as_float(((unsigned)b) << 16); }
__device__ __forceinline__ bf16 f2bf(float f) { unsigned u = __float_as_uint(f); u += 0x7FFFu + ((u >> 16) & 1u); return (bf16)(u >> 16); }
typedef __bf16 bf16v2 __attribute__((ext_vector_type(2)));
typedef float f32x2 __attribute__((ext_vector_type(2)));
__device__ __forceinline__ unsigned pack2(float lo, float hi) { return __builtin_bit_cast(unsigned, __builtin_convertvector((f32x2){lo, hi}, bf16v2)); }
__device__ __forceinline__ float lo2f(unsigned w) { return __uint_as_float(w << 16); }
__device__ __forceinline__ float hi2f(unsigned w) { return __uint_as_float(w & 0xFFFF0000u); }
__device__ __forceinline__ float sigmoidf_(float x) { return __builtin_amdgcn_rcpf(1.0f + __expf(-x)); }
__device__ __forceinline__ float siluf_(float x) { return x * sigmoidf_(x); }
__device__ __forceinline__ float gelu_tanh(float x) { const float u = 0.7978845608028654f * (x + 0.044715f * x * x * x); return x * sigmoidf_(2.0f * u); }
__device__ __forceinline__ float logsigmoidf_(float x) { return x >= 0.f ? -log1pf(expf(-x)) : x - log1pf(expf(x)); }
__device__ __forceinline__ int rot_bid(int k) { return (int)((blockIdx.x + gridDim.x - k) % gridDim.x); }
__device__ __forceinline__ int chunk_of(int s, int d) { return d == 0 ? s : (s < 4 ? 3 - s : 263 - s); }
__device__ __forceinline__ float lam_init_of(int l) { return 0.8f - 0.6f * expf(-0.3f * (float)l); }

typedef const __attribute__((address_space(4))) Params KParams;
struct Ctx {
    const KParams* pp; int l; unsigned char* ws; float* lds; float* out;
    __device__ Ctx(const KParams* p_, int l_, float* lds_) : pp(p_), l(l_), ws(p_->ws), lds(lds_), out(p_->out) {}
    template <class T> __device__ __forceinline__ T* W(size_t off) const { return (T*)(ws + off); }
    __device__ __forceinline__ const float* in(int i) const { return pp->in[i]; }
    __device__ __forceinline__ const float* xin_row(int row) const {
        if (l == 0) return row < CTX ? pp->in[I_CTX] + (size_t)row * D : pp->in[I_X] + (size_t)(row - CTX) * D;
        return row < CTX ? W<float>(WS_HCTX) + (size_t)row * D : out + (size_t)(row - CTX) * D; }
    __device__ __forceinline__ float* xout_row(int row) const { return row < CTX ? W<float>(WS_HCTX) + (size_t)row * D : out + (size_t)(row - CTX) * D; }
    __device__ __forceinline__ const float* mods(int row) const { return W<float>(WS_MODS) + ((size_t)l * 2 + (row < CTX ? 1 : 0)) * 6144; }
    __device__ __forceinline__ int row_begin() const { return l == DEPTH - 1 ? CTX : 0; }
};

struct ConvDesc { const float* src; bf16* dst; int ld, col0, nvalid, K, drow0, k0; };
__device__ __forceinline__ ConvDesc conv_decode(const Ctx& c, int ti) {
    const int l = c.l; ConvDesc d;
    constexpr int T0 = 640, T1 = T0 + 1024, T2 = T1 + 256, T3 = T2 + 256, T4 = T3 + 1408, T5 = T4 + 704;
    if (ti < T0) { const int jt = ti >> 4, kt = ti & 15; int nv = GATE0 - jt * 64; nv = nv < 0 ? 0 : (nv > 64 ? 64 : nv);
        d = ConvDesc{c.in(I_WIN) + (size_t)l * D * IN_TOTAL, c.W<bf16>(WS_WINT), IN_TOTAL, jt * 64, nv, D, jt * 64, kt * 64}; }
    else if (ti < T1) { const int u = ti - T0, jt = u >> 4, kt = u & 15;
        d = ConvDesc{c.in(I_WIN) + (size_t)l * D * IN_TOTAL, c.W<bf16>(WS_WGT), IN_TOTAL, GATE0 + jt * 64, 64, D, jt * 64, kt * 64}; }
    else if (ti < T2) { const int u = ti - T1, n = u >> 6, jt = (u >> 2) & 15, kt = u & 3;
        d = ConvDesc{c.in(I_WBR) + ((size_t)l * 4 + n) * 256 * D, c.W<bf16>(WS_WBRT) + (size_t)n * D * 256, D, jt * 64, 64, 256, jt * 64, kt * 64}; }
    else if (ti < T3) { const int u = ti - T2, jt = u >> 4, kt = u & 15;
        d = ConvDesc{c.in(I_WOUT) + (size_t)l * D * D, c.W<bf16>(WS_WOUTT), D, jt * 64, 64, D, jt * 64, kt * 64}; }
    else if (ti < T4) { const int u = ti - T3, jt = u >> 4, kt = u & 15; const int r0 = jt * 64, pn = r0 >> 8, bj = (r0 >> 7) & 1, cc = r0 & 127;
        d = ConvDesc{c.in(I_WUP) + (size_t)l * D * 2 * DFF, c.W<bf16>(WS_WUPT), 2 * DFF, bj * DFF + 128 * pn + cc, 64, D, r0, kt * 64}; }
    else if (ti < T5) { const int u = ti - T4, jt = u / 44, kt = u % 44;
        d = ConvDesc{c.in(I_WDN) + (size_t)l * DFF * D, c.W<bf16>(WS_WDNT), D, jt * 64, 64, DFF, jt * 64, kt * 64}; }
    else { const int u = ti - T5, jt = u >> 2, kt = u & 3;
        d = ConvDesc{c.in(I_SWGLU) + (size_t)l * 256 * 256, c.W<bf16>(WS_WGLUT), 256, jt * 64, 64, 256, jt * 64, kt * 64}; }
    return d;
}
__device__ __forceinline__ void phase_prep(const Ctx& c) {
    const int l = c.l, t = tidx();
    constexpr int T6 = 640 + 1024 + 256 + 256 + 1408 + 704 + 16;
    { int ti = blockIdx.x; float v[8]; ConvDesc d;
      if (ti < T6) { d = conv_decode(c, ti);
#pragma unroll
          for (int q = 0; q < 8; ++q) { const int i = t + q * NT, kk = i >> 6, j = i & 63; v[q] = (j < d.nvalid) ? d.src[(size_t)(d.k0 + kk) * d.ld + d.col0 + j] : 0.f; } }
      while (ti < T6) {
          const int nti = ti + gridDim.x; float nv[8]; ConvDesc nd = d;
          if (nti < T6) { nd = conv_decode(c, nti);
#pragma unroll
              for (int q = 0; q < 8; ++q) { const int i = t + q * NT, kk = i >> 6, j = i & 63; nv[q] = (j < nd.nvalid) ? nd.src[(size_t)(nd.k0 + kk) * nd.ld + nd.col0 + j] : 0.f; } }
          else {
#pragma unroll
              for (int q = 0; q < 8; ++q) nv[q] = 0.f; }
          __syncthreads();
#pragma unroll
          for (int q = 0; q < 8; ++q) { const int i = t + q * NT; c.lds[(i >> 6) * 65 + (i & 63)] = v[q]; }
          __syncthreads();
          { const int j = t >> 3, kq = t & 7;
            const int js = (j & 32) | (((j >> 2) & 3) << 3) | (((j >> 4) & 1) << 2) | (j & 3);
            const float* lp = c.lds + (kq * 8) * 65 + js; u32x4 w;
            w.x = pack2(lp[0], lp[65]); w.y = pack2(lp[130], lp[195]); w.z = pack2(lp[260], lp[325]); w.w = pack2(lp[390], lp[455]);
            *(u32x4*)(d.dst + (size_t)(d.drow0 + j) * d.K + d.k0 + kq * 8) = w; }
          d = nd; ti = nti;
#pragma unroll
          for (int q = 0; q < 8; ++q) v[q] = nv[q];
      } }
    __syncthreads();
    if (l != 0) return;
    for (int task = blockIdx.x; task < 192; task += gridDim.x) {
        const int ll = task / 96, cb = task % 96, t = tidx(), kq = t >> 6, j = t & 63;
        const float* w = c.in(I_WADA) + (size_t)ll * D * 6144 + cb * 64 + j;
        float a0 = 0.f, a1 = 0.f;
#pragma unroll 16
        for (int k = kq * 128; k < kq * 128 + 128; ++k) { const float wv = w[(size_t)k * 6144]; a0 += siluf_(c.in(I_C)[k]) * wv; a1 += siluf_(c.in(I_CCTX)[k]) * wv; }
        c.lds[t] = a0; c.lds[512 + t] = a1;
        __syncthreads();
        if (t < 128) { const int s = t >> 6, jj = t & 63; float v = 0.f; for (int q = 0; q < 8; ++q) v += c.lds[s * 512 + q * 64 + jj];
            c.W<float>(WS_MODS)[((size_t)ll * 2 + s) * 6144 + cb * 64 + jj] = v + c.in(I_BADA)[(size_t)ll * 6144 + cb * 64 + jj]; }
        __syncthreads();
    }
    for (int i = blockIdx.x * NT + tidx(); i < 2048; i += gridDim.x * NT) { const int pos = i >> 3, e = i & 7; const float ang = (float)pos * (1.0f / powf(10000.0f, (float)(2 * e) / 16.0f));
        c.W<float>(WS_ROPE)[i * 2] = cosf(ang); c.W<float>(WS_ROPE)[i * 2 + 1] = sinf(ang); }
    for (int i = blockIdx.x * NT + tidx(); i < 4096; i += gridDim.x * NT) {
        const int g = (i >> 6) & 15;
        const float lre = c.in(I_SLRE)[i], lim = c.in(I_SLIM)[i], dt = expf(c.in(I_SLOG)[(i >> 6)]);
        (void)g;
        const float mag = expf(lre * dt), lbr = mag * cosf(lim * dt), lbi = mag * sinf(lim * dt);
        const float nr = lbr - 1.0f, ni = lbi, den = lre * lre + lim * lim;
        const float kr = (nr * lre + ni * lim) / den, ki = (ni * lre - nr * lim) / den;
        c.W<float>(WS_S5LB)[i * 2] = lbr; c.W<float>(WS_S5LB)[i * 2 + 1] = lbi;
        for (int cc = 0; cc < 16; ++cc) { const float br = c.in(I_SBRE)[(size_t)i * 16 + cc], bi = c.in(I_SBIM)[(size_t)i * 16 + cc];
            c.W<float>(WS_S5BB)[(size_t)i * 32 + cc] = kr * br - ki * bi; c.W<float>(WS_S5BB)[(size_t)i * 32 + 16 + cc] = kr * bi + ki * br; }
    }
}

__device__ __forceinline__ u32x4 pack8(f32x4 a, f32x4 b) { u32x4 w; w.x = pack2(a.x, a.y); w.y = pack2(a.z, a.w); w.z = pack2(b.x, b.y); w.w = pack2(b.z, b.w); return w; }
__device__ __forceinline__ void phase_norm(const Ctx& c, int which) {
    const int wave = tidx() >> 6, lane = tidx() & 63;
    const float* g = c.in(which == 0 ? I_N1G : I_N2G) + (size_t)c.l * D;
    const int r0 = which == 0 ? 0 : c.row_begin();
    for (int row = r0 + blockIdx.x * 8 + wave; row < ROWS; row += gridDim.x * 8) {
        const float* x = which == 0 ? c.xin_row(row) : c.xout_row(row);
        const float* m = c.mods(row) + (which == 0 ? 0 : 3 * D);
        f32x4 v[4]; float ss = 0.f;
        const int nsl = (row >= CTX) ? 0 : ((c.l == 0 && which == 1) ? 4 : ((c.l == 1 && which == 0) ? 11 : 0));
        if (nsl) { const float* slab = (c.l == 0) ? c.W<float>(WS_SLABW) : c.W<float>(WS_SLABF); const float* gate = c.W<float>(WS_MODS) + 6144 + (c.l == 0 ? 2 : 5) * D;
            const float* xb = (c.l == 0) ? c.in(I_CTX) + (size_t)row * D : c.W<float>(WS_HCTX) + (size_t)row * D;
#pragma unroll
            for (int i = 0; i < 4; ++i) { const int col = (i >> 1) * 512 + lane * 8 + (i & 1) * 4; f32x4 a = (f32x4){0.f, 0.f, 0.f, 0.f};
                for (int k = 0; k < nsl; ++k) a += *(const f32x4*)(slab + ((size_t)k * CTX + row) * D + col);
                v[i] = *(const f32x4*)(xb + col) + *(const f32x4*)(gate + col) * a;
                if (c.l == 0) *(f32x4*)(c.W<float>(WS_HCTX) + (size_t)row * D + col) = v[i];
                ss += v[i].x * v[i].x + v[i].y * v[i].y + v[i].z * v[i].z + v[i].w * v[i].w; } }
        else {
#pragma unroll
            for (int i = 0; i < 4; ++i) { v[i] = *(const f32x4*)(x + (i >> 1) * 512 + lane * 8 + (i & 1) * 4); ss += v[i].x * v[i].x + v[i].y * v[i].y + v[i].z * v[i].z + v[i].w * v[i].w; } }
#pragma unroll
        for (int o = 32; o >= 1; o >>= 1) ss += __shfl_xor(ss, o);
        const float rstd = rsqrtf(ss * (1.0f / D) + 1e-6f);
        bf16* o = c.W<bf16>(WS_HN) + (size_t)row * D;
#pragma unroll
        for (int h = 0; h < 2; ++h) { f32x4 y[2];
#pragma unroll
            for (int e = 0; e < 2; ++e) { const int col = h * 512 + lane * 8 + e * 4; const f32x4 gg = *(const f32x4*)(g + col), sh = *(const f32x4*)(m + col), sc = *(const f32x4*)(m + D + col);
                y[e] = (v[h * 2 + e] * rstd * gg) * (1.0f + sc) + sh; }
            *(u32x4*)(o + h * 512 + lane * 8) = pack8(y[0], y[1]); }
    }
}

__device__ __forceinline__ u32x2 pack4(f32x4 v) { u32x2 w; w.x = pack2(v.x, v.y); w.y = pack2(v.z, v.w); return w; }
struct EpiInproj { static constexpr bool BATCH4 = false; bf16* z; float* za;
    __device__ __forceinline__ void store_row(int row, int col0, f32x4 v00, f32x4 v01, f32x4 v10, f32x4 v11) const {
        if (col0 < NZ) { bf16* p = z + (size_t)row * NZ + col0; *(u32x4*)p = pack8(v00, v01); *(u32x4*)(p + 128) = pack8(v10, v11); }
        else if (col0 < NZ + 32) { float* p = za + (size_t)row * 32 + (col0 - NZ); *(f32x4*)p = v00; *(f32x4*)(p + 4) = v01; } } };
struct EpiGlu { static constexpr bool BATCH4 = false; const bf16* ys5; bf16* y;
    __device__ __forceinline__ u32x4 one(const bf16* pz, f32x4 v, f32x4 u) const { const u32x4 zz = *(const u32x4*)pz; f32x4 o, q;
        o.x = lo2f(zz.x) * sigmoidf_(v.x); o.y = hi2f(zz.x) * sigmoidf_(v.y); o.z = lo2f(zz.y) * sigmoidf_(v.z); o.w = hi2f(zz.y) * sigmoidf_(v.w);
        q.x = lo2f(zz.z) * sigmoidf_(u.x); q.y = hi2f(zz.z) * sigmoidf_(u.y); q.z = lo2f(zz.w) * sigmoidf_(u.z); q.w = hi2f(zz.w) * sigmoidf_(u.w); return pack8(o, q); }
    __device__ __forceinline__ void store_row(int row, int col0, f32x4 v00, f32x4 v01, f32x4 v10, f32x4 v11) const {
        const bf16* pz = ys5 + (size_t)row * 256 + col0; bf16* py = y + (size_t)row * D + col0;
        *(u32x4*)py = one(pz, v00, v01); *(u32x4*)(py + 128) = one(pz + 128, v10, v11); } };
struct EpiResid { static constexpr bool BATCH4 = true; const float* xs_ctx; const float* xs_lat; float* xo_ctx; float* xo_lat; const float* g_ctx; const float* g_lat;
    __device__ __forceinline__ void store_rows4(int row, int col0, const f32x4 (&a)[2][4][2]) const {
        const bool ic = row < CTX; const size_t off = (size_t)(ic ? row : row - CTX) * D + col0;
        const float* xs = (ic ? xs_ctx : xs_lat) + off; float* xo = (ic ? xo_ctx : xo_lat) + off; const float* g = (ic ? g_ctx : g_lat) + col0;
        f32x4 xv[4][2][2];
#pragma unroll
        for (int m = 0; m < 4; ++m)
#pragma unroll
            for (int bj = 0; bj < 2; ++bj)
#pragma unroll
                for (int n = 0; n < 2; ++n) xv[m][bj][n] = *(const f32x4*)(xs + (size_t)m * 16 * D + bj * 128 + n * 4);
#pragma unroll
        for (int bj = 0; bj < 2; ++bj)
#pragma unroll
            for (int n = 0; n < 2; ++n) { const f32x4 gg = *(const f32x4*)(g + bj * 128 + n * 4);
#pragma unroll
                for (int m = 0; m < 4; ++m) *(f32x4*)(xo + (size_t)m * 16 * D + bj * 128 + n * 4) = xv[m][bj][n] + gg * a[bj][m][n]; } }
    __device__ __forceinline__ void store_row(int row, int col0, f32x4 v00, f32x4 v01, f32x4 v10, f32x4 v11) const {
        const bool ic = row < CTX; const size_t off = (size_t)(ic ? row : row - CTX) * D + col0;
        const float* xs = (ic ? xs_ctx : xs_lat) + off; float* xo = (ic ? xo_ctx : xo_lat) + off; const float* g = (ic ? g_ctx : g_lat) + col0;
        *(f32x4*)xo = *(const f32x4*)xs + *(const f32x4*)g * v00; *(f32x4*)(xo + 4) = *(const f32x4*)(xs + 4) + *(const f32x4*)(g + 4) * v01;
        *(f32x4*)(xo + 128) = *(const f32x4*)(xs + 128) + *(const f32x4*)(g + 128) * v10; *(f32x4*)(xo + 132) = *(const f32x4*)(xs + 132) + *(const f32x4*)(g + 132) * v11; } };
__device__ __forceinline__ EpiResid make_resid(const Ctx& c, int gate_off, bool from_in) {
    EpiResid e; float* hc = c.W<float>(WS_HCTX);
    e.xs_ctx = (from_in && c.l == 0) ? c.in(I_CTX) : hc; e.xs_lat = (from_in && c.l == 0) ? c.in(I_X) : c.out;
    e.xo_ctx = hc; e.xo_lat = c.out;
    e.g_ctx = c.W<float>(WS_MODS) + ((size_t)c.l * 2 + 1) * 6144 + gate_off; e.g_lat = c.W<float>(WS_MODS) + ((size_t)c.l * 2) * 6144 + gate_off; return e; }

namespace pg8 {
#define PG8_LAS __attribute__((address_space(3)))
constexpr int BM = 256, BK = 64, HALF = 128, HTB = HALF * BK * 2, STAGE_BYTES = 8 * HTB, NXCD = 8, WGM = 8;
__device__ __forceinline__ int lds_byte(int r, int c) { const int st = (r >> 4) * 2 + (c >> 5), rr = r & 15, cc = c & 31, ob = rr * 64 + cc * 2; return st * 1024 + (ob ^ (((ob >> 9) & 1) << 5)); }
__device__ __forceinline__ void stage_rc(int b, int& R, int& C) { const int st = b / 1024, sb = b % 1024, swz = sb ^ (((sb >> 9) & 1) << 5); R = (st >> 1) * 16 + swz / 64; C = (st & 1) * 32 + (swz % 64) / 2; }
struct Unit { int pm, pn; };
__device__ __forceinline__ bool static_next(int i, int G, int c, int nM, int nN, Unit& u) {
    const int nwg = nM * nN; const long L = (long)i * G + c; if (L >= nwg) return false;
    int wgid = (int)L; { const int q = nwg / NXCD, r = nwg % NXCD, xcd = wgid % NXCD, off = wgid / NXCD; wgid = (xcd < r ? xcd * (q + 1) : r * (q + 1) + (xcd - r) * q) + off; }
    const int nig = WGM * nN, gid = wgid / nig, fm = gid * WGM, gsz = (nM - fm) < WGM ? (nM - fm) : WGM;
    u.pm = fm + ((wgid % nig) % gsz); u.pn = (wgid % nig) / gsz; return true;
}
template <class Epi, class Sched>
__device__ __forceinline__ void gemm_phase(PG8_LAS unsigned char* lds, const int K, const Sched& S, const Epi& E) {
    const int tid = tidx(), wid = __builtin_amdgcn_readfirstlane(tid >> 6), lane = tid & 63, wr = wid >> 2, wc = wid & 3, fr = lane & 15, fq = lane >> 4;
    int sR[2], sC[2];
#pragma unroll
    for (int i = 0; i < 2; ++i) { int R, C; stage_rc(tid * 16 + i * 8192, R, C); sR[i] = R; sC[i] = C; }
    const size_t kstep = (size_t)(BK * 2);
    const unsigned ldsw = (unsigned)wid * 1024u;
    const int aoff = lds_byte(wr * 64 + fr, fq * 8), boff = lds_byte(wc * 32 + fr, fq * 8);
#define PG8_SA(b, h) (((b) * 2 + (h)) * HTB)
#define PG8_SB(b, h) ((4 + (b) * 2 + (h)) * HTB)
#define PG8_STAGE(bufoff, gbase, voff) do { _Pragma("unroll") for (int _i = 0; _i < 2; ++_i) \
        __builtin_amdgcn_global_load_lds((const unsigned*)((const char*)(gbase) + (voff)[_i]), (PG8_LAS unsigned*)(lds + (bufoff) + ldsw + _i * 8192), 16, 0, 0); } while (0)
#define PG8_LDA(dst, b, h) do { _Pragma("unroll") for (int m = 0; m < 4; ++m) _Pragma("unroll") for (int k = 0; k < 2; ++k) dst[m][k] = *(const PG8_LAS bf16x8*)(lds + PG8_SA(b, h) + aoff + m * 2048 + k * 1024); } while (0)
#define PG8_LDB(dst, b, h) do { _Pragma("unroll") for (int n = 0; n < 2; ++n) _Pragma("unroll") for (int k = 0; k < 2; ++k) dst[n][k] = *(const PG8_LAS bf16x8*)(lds + PG8_SB(b, h) + boff + n * 2048 + k * 1024); } while (0)
#define PG8_MMA(ai, bj, At, Bt) do { __builtin_amdgcn_s_setprio(1); _Pragma("unroll") for (int m = 0; m < 4; ++m) _Pragma("unroll") for (int n = 0; n < 2; ++n) _Pragma("unroll") for (int k = 0; k < 2; ++k) \
        acc[ai][bj][m][n] = __builtin_amdgcn_mfma_f32_16x16x32_bf16(Bt[n][k], At[m][k], acc[ai][bj][m][n], 0, 0, 0); __builtin_amdgcn_s_setprio(0); } while (0)
#define PG8_WAIT_V(n) asm volatile("s_waitcnt vmcnt(" #n ")" ::: "memory")
#define PG8_WAIT_L(n) asm volatile("s_waitcnt lgkmcnt(" #n ")" ::: "memory")
#define PG8_BAR __builtin_amdgcn_s_barrier()
#define PG8_SCHED __builtin_amdgcn_sched_barrier(0)
    Unit cur, nxt; int ui = 0;
    if (!S.next(0, cur)) return;
    int Kc = Sched::HETERO ? S.Kof(cur) : K, nt = Kc / BK; const int ldb0 = Sched::HETERO ? S.ldbof(cur) : K;
    unsigned voffB[2], voffBn[2]; size_t hstepB = (size_t)HALF * ldb0 * 2, hstepBn = hstepB;
#pragma unroll
    for (int i = 0; i < 2; ++i) { voffB[i] = (unsigned)(sR[i] * ldb0 + sC[i]) * 2u; voffBn[i] = voffB[i]; }
    f32x4 acc[2][2][4][2];
#pragma unroll
    for (int a = 0; a < 2; ++a)
#pragma unroll
        for (int b = 0; b < 2; ++b)
#pragma unroll
            for (int m = 0; m < 4; ++m)
#pragma unroll
                for (int n = 0; n < 2; ++n) acc[a][b][m][n] = (f32x4){0.f, 0.f, 0.f, 0.f};
    bf16x8 At[4][2], B0[2][2], B1[2][2];
    unsigned oc0[2], oc1[2], on0[2], on1[2];
#pragma unroll
    for (int i = 0; i < 2; ++i) { oc0[i] = S.aoff(cur, 0, sR[i], sC[i]); oc1[i] = S.aoff(cur, 1, sR[i], sC[i]); }
    const char* cA = S.abase(cur); const char* cB = S.bbase(cur);
    PG8_STAGE(PG8_SB(0, 0), cB, voffB); PG8_STAGE(PG8_SB(0, 1), cB + hstepB, voffB); PG8_STAGE(PG8_SA(0, 0), cA, oc0); PG8_STAGE(PG8_SA(0, 1), cA, oc1);
    if (wr == 1) PG8_BAR;
    PG8_WAIT_V(2); PG8_BAR;
    PG8_STAGE(PG8_SB(1, 0), cB + kstep, voffB); PG8_STAGE(PG8_SA(1, 0), cA + kstep, oc0); PG8_STAGE(PG8_SB(1, 1), cB + hstepB + kstep, voffB);
    PG8_WAIT_V(6); PG8_BAR;
    for (;;) {
        const bool has_next = S.next(ui + 1, nxt);
        const char* nA = has_next ? S.abase(nxt) : cA; const char* nB = has_next ? S.bbase(nxt) : cB;
        int Kn = Kc;
        if (Sched::HETERO) { Kn = has_next ? S.Kof(nxt) : Kc; const int ldbn = has_next ? S.ldbof(nxt) : (int)(hstepB / (HALF * 2)); hstepBn = (size_t)HALF * ldbn * 2;
#pragma unroll
            for (int i = 0; i < 2; ++i) voffBn[i] = (unsigned)(sR[i] * ldbn + sC[i]) * 2u; }
#pragma unroll
        for (int i = 0; i < 2; ++i) { if (Sched::AMAP) { on0[i] = has_next ? S.aoff(nxt, 0, sR[i], sC[i]) : oc0[i]; on1[i] = has_next ? S.aoff(nxt, 1, sR[i], sC[i]) : oc1[i]; } else { on0[i] = oc0[i]; on1[i] = oc1[i]; } }
        for (int t = 0; t < nt; t += 2) {
            const bool last = (t == nt - 2);
            const char* a1 = cA + (size_t)(t + 1) * kstep;
            const char* a2 = last ? nA : cA + (size_t)(t + 2) * kstep; const char* b2 = last ? nB : cB + (size_t)(t + 2) * kstep;
            const char* a3 = a2 + kstep; const char* b3 = b2 + kstep;
            unsigned o20[2], o21[2];
#pragma unroll
            for (int i = 0; i < 2; ++i) { o20[i] = last ? on0[i] : oc0[i]; o21[i] = last ? on1[i] : oc1[i]; }
            unsigned vb2[2]; size_t hs2 = hstepB;
#pragma unroll
            for (int i = 0; i < 2; ++i) vb2[i] = (Sched::HETERO && last) ? voffBn[i] : voffB[i];
            if (Sched::HETERO && last) hs2 = hstepBn;
            PG8_LDB(B0, 0, 0); PG8_LDB(B1, 0, 1); PG8_SCHED; PG8_LDA(At, 0, 0); PG8_STAGE(PG8_SA(1, 1), a1, oc1);
            PG8_WAIT_V(8); PG8_WAIT_L(0); PG8_BAR; PG8_MMA(0, 0, At, B0); PG8_MMA(0, 1, At, B1); PG8_BAR; PG8_SCHED;
            PG8_LDA(At, 0, 1); PG8_STAGE(PG8_SB(0, 0), b2, vb2); PG8_STAGE(PG8_SB(0, 1), b2 + hs2, vb2); PG8_STAGE(PG8_SA(0, 0), a2, o20);
            PG8_WAIT_V(8); PG8_WAIT_L(0); PG8_BAR; PG8_MMA(1, 0, At, B0); PG8_MMA(1, 1, At, B1); PG8_BAR; PG8_SCHED;
            PG8_LDB(B0, 1, 0); PG8_LDB(B1, 1, 1); PG8_SCHED; PG8_LDA(At, 1, 0); PG8_STAGE(PG8_SA(0, 1), a2, o21);
            PG8_WAIT_V(8); PG8_WAIT_L(0); PG8_BAR; PG8_MMA(0, 0, At, B0); PG8_MMA(0, 1, At, B1); PG8_BAR; PG8_SCHED;
            PG8_LDA(At, 1, 1); PG8_STAGE(PG8_SB(1, 0), b3, vb2); PG8_STAGE(PG8_SB(1, 1), b3 + hs2, vb2); PG8_STAGE(PG8_SA(1, 0), a3, o20);
            PG8_WAIT_V(8); PG8_WAIT_L(0); PG8_BAR; PG8_MMA(1, 0, At, B0); PG8_MMA(1, 1, At, B1); PG8_BAR; PG8_SCHED;
        }
        if (wr == 0) PG8_BAR;
        E(acc, cur, wr, wc, fr, fq);
        if (!has_next) break;
#pragma unroll
        for (int a = 0; a < 2; ++a)
#pragma unroll
            for (int b = 0; b < 2; ++b)
#pragma unroll
                for (int m = 0; m < 4; ++m)
#pragma unroll
                    for (int n = 0; n < 2; ++n) acc[a][b][m][n] = (f32x4){0.f, 0.f, 0.f, 0.f};
        cur = nxt; cA = nA; cB = nB; ++ui;
        if (Sched::HETERO) { Kc = Kn; nt = Kc / BK; hstepB = hstepBn;
#pragma unroll
            for (int i = 0; i < 2; ++i) voffB[i] = voffBn[i]; }
        if (wr == 1) PG8_BAR;
#pragma unroll
        for (int i = 0; i < 2; ++i) { oc0[i] = on0[i]; oc1[i] = on1[i]; }
    }
    PG8_WAIT_V(0);
    PG8_BAR;
#undef PG8_SA
#undef PG8_SB
#undef PG8_STAGE
#undef PG8_LDA
#undef PG8_LDB
#undef PG8_MMA
#undef PG8_WAIT_V
#undef PG8_WAIT_L
#undef PG8_BAR
#undef PG8_SCHED
}
struct SchedLin { static constexpr bool AMAP = false, HETERO = false; __device__ __forceinline__ int Kof(const Unit&) const { return K; } __device__ __forceinline__ int ldbof(const Unit&) const { return K; }
    const bf16* A; const bf16* Bt; int lda, K, row0, nM, nN, G, c;
    __device__ __forceinline__ bool next(int i, Unit& u) const { return static_next(i, G, c, nM, nN, u); }
    __device__ __forceinline__ const char* abase(const Unit& u) const { return (const char*)(A + (size_t)(row0 + BM * u.pm) * lda); }
    __device__ __forceinline__ const char* bbase(const Unit& u) const { return (const char*)(Bt + (size_t)BM * u.pn * K); }
    __device__ __forceinline__ unsigned aoff(const Unit&, int h, int R, int C) const { return (unsigned)((h * HALF + R) * lda + C) * 2u; }
};
template <class F> struct EpiLin { F f; int row0;
    __device__ __forceinline__ void operator()(const f32x4 (&acc)[2][2][4][2], const Unit& u, int wr, int wc, int fr, int fq) const {
        const int col0 = u.pn * BM + wc * 32 + 8 * fq;
#pragma unroll
        for (int ai = 0; ai < 2; ++ai) {
            if constexpr (F::BATCH4) {
                f.store_rows4(row0 + u.pm * BM + ai * HALF + wr * 64 + fr, col0, acc[ai]);
                asm volatile("" ::: "memory");
            } else {
#pragma unroll
                for (int m = 0; m < 4; ++m) { const int row = row0 + u.pm * BM + ai * HALF + wr * 64 + m * 16 + fr;
                    f.store_row(row, col0, acc[ai][0][m][0], acc[ai][0][m][1], acc[ai][1][m][0], acc[ai][1][m][1]);
                    asm volatile("" ::: "memory"); }
            } }
    } };
struct SchedRes { static constexpr bool AMAP = false, HETERO = true; const bf16* A; const bf16* Bt; int lda, K, nks, G, c;
    __device__ __forceinline__ bool next(int i, Unit& u) const {
        if (i == 0) { Unit v; if (!static_next(0, G, c, 64, 4, v)) return false; u.pm = v.pm + 1; u.pn = v.pn; return true; }
        if (i == 1 && c < 4 * nks) { u.pm = 0; u.pn = (c & 3) | ((c >> 2) << 2) | 64; return true; }
        return false; }
    __device__ __forceinline__ int Kof(const Unit& u) const { return (u.pn & 64) ? 256 : K; }
    __device__ __forceinline__ int ldbof(const Unit&) const { return K; }
    __device__ __forceinline__ const char* abase(const Unit& u) const { return (u.pn & 64) ? (const char*)(A + ((u.pn >> 2) & 15) * 256) : (const char*)(A + (size_t)(BM * u.pm) * lda); }
    __device__ __forceinline__ const char* bbase(const Unit& u) const { return (u.pn & 64) ? (const char*)(Bt + (size_t)BM * (u.pn & 3) * K + ((u.pn >> 2) & 15) * 256) : (const char*)(Bt + (size_t)BM * u.pn * K); }
    __device__ __forceinline__ unsigned aoff(const Unit&, int h, int R, int C) const { return (unsigned)((h * HALF + R) * lda + C) * 2u; } };
template <class F> struct EpiRes { F f; float* slab;
    __device__ __forceinline__ void operator()(const f32x4 (&acc)[2][2][4][2], const Unit& u, int wr, int wc, int fr, int fq) const {
        if (u.pn & 64) { float* sp = slab + ((size_t)((u.pn >> 2) & 15) * CTX + wr * 64 + fr) * D + (u.pn & 3) * BM + wc * 32 + 8 * fq;
#pragma unroll
            for (int ai = 0; ai < 2; ++ai)
#pragma unroll
                for (int m = 0; m < 4; ++m)
#pragma unroll
                    for (int bj = 0; bj < 2; ++bj)
#pragma unroll
                        for (int n = 0; n < 2; ++n) *(f32x4*)(sp + (size_t)(ai * HALF + m * 16) * D + bj * HALF + n * 4) = acc[ai][bj][m][n];
        } else { const int col0 = u.pn * BM + wc * 32 + 8 * fq;
#pragma unroll
            for (int ai = 0; ai < 2; ++ai) { f.store_rows4(u.pm * BM + ai * HALF + wr * 64 + fr, col0, acc[ai]); asm volatile("" ::: "memory"); } }
    } };
}
template <class F>
__device__ __forceinline__ void gemm_lin(const bf16* A, int lda, const bf16* Bt, int row0, int nrows, int N, int K, const F& f, float* lds) {
    pg8::SchedLin S{A, Bt, lda, K, row0, nrows / 256, N / 256, (int)gridDim.x, (int)blockIdx.x};
    pg8::EpiLin<F> E{f, row0};
    pg8::gemm_phase(( __attribute__((address_space(3))) unsigned char*)lds, K, S, E);
}

template <class F>
__device__ __forceinline__ void gemm_res_l0(const bf16* A, int lda, const bf16* Bt, int K, int nks, const F& f, float* slab, float* lds) {
    pg8::SchedRes S{A, Bt, lda, K, nks, (int)gridDim.x, (int)blockIdx.x};
    pg8::EpiRes<F> E{f, slab};
    pg8::gemm_phase((__attribute__((address_space(3))) unsigned char*)lds, K, S, E);
}
namespace pg8 {
struct MergeGeo { int mode, G, c;
    __device__ __forceinline__ bool decode(int i, Unit& u) const {
        if (mode == 2) { const int idx = c - 64; if (idx < 0 || idx >= 12 || i >= 2) return false; u.pm = 0; u.pn = (idx / 3) | ((1 + idx % 3) << 2) | (i << 4) | (1 << 5); return true; }
        if (i < 8) { const int s = c; if (s >= 256) return false; const int sp = (s & 7) * 32 + (s >> 3); u.pm = CTX + (sp >> 2) * 256; u.pn = (sp & 3) | ((i >> 1) << 2) | ((i & 1) << 4); return true; }
        if (mode == 1 && c < 4 && i < 10) { u.pm = 0; u.pn = c | (0 << 2) | ((i & 1) << 4) | (2 << 5); return true; }
        return false; } };
struct SchedPG { static constexpr bool AMAP = false, HETERO = true; const bf16* hn; const bf16* y; const bf16* wg; const bf16* wb; MergeGeo geo;
    __device__ __forceinline__ bool next(int i, Unit& u) const { return geo.decode(i, u); }
    __device__ __forceinline__ int Kof(const Unit& u) const { return (u.pn & 16) ? D : 256; }
    __device__ __forceinline__ int ldbof(const Unit& u) const { return (u.pn & 16) ? D : 256; }
    __device__ __forceinline__ const char* abase(const Unit& u) const { const int n = (u.pn >> 2) & 3;
        return (u.pn & 16) ? (const char*)(hn + (size_t)u.pm * D) : (const char*)(y + (size_t)u.pm * D + n * 256); }
    __device__ __forceinline__ const char* bbase(const Unit& u) const { const int n = (u.pn >> 2) & 3, dt = u.pn & 3;
        return (u.pn & 16) ? (const char*)(wg + ((size_t)n * D + (size_t)dt * BM) * D) : (const char*)(wb + ((size_t)n * D + (size_t)dt * BM) * 256); }
    __device__ __forceinline__ unsigned aoff(const Unit&, int h, int R, int C) const { return (unsigned)((h * HALF + R) * D + C) * 2u; } };
struct EpiPG { unsigned char* scr; unsigned char* parts; bf16* merged;
    __device__ __forceinline__ void operator()(const f32x4 (&acc)[2][2][4][2], const Unit& u, int wr, int wc, int fr, int fq) const {
        const size_t lo = (size_t)tidx() * 16; unsigned char* p = scr + lo;
        const int dt = u.pn & 3, n = (u.pn >> 2) & 3, kind = u.pn >> 5;
        if (!(u.pn & 16)) {
#pragma unroll
            for (int ai = 0; ai < 2; ++ai)
#pragma unroll
                for (int bj = 0; bj < 2; ++bj)
#pragma unroll
                    for (int m = 0; m < 4; ++m) { const u32x2 w0 = pack4(acc[ai][bj][m][0]), w1 = pack4(acc[ai][bj][m][1]);
                        *(u32x4*)(p + ((ai * 2 + bj) * 4 + m) * 8192) = (u32x4){w0.x, w0.y, w1.x, w1.y}; }
        } else {
            const int row0 = u.pm; const bool part = (kind == 1), fin = (kind == 2), first = (n == 0) || part;
            unsigned char* q = parts + (size_t)(dt * 3 + (part ? n - 1 : 0)) * 131072 + lo;
            if (!fin) {
#pragma unroll
                for (int ai = 0; ai < 2; ++ai) {
                    u32x4 pw[2][4], ow[2][4];
                    bf16* mp = merged + (size_t)(row0 + ai * HALF + wr * 64 + fr) * D + dt * BM + wc * 32 + 8 * fq;
#pragma unroll
                    for (int bj = 0; bj < 2; ++bj)
#pragma unroll
                        for (int m = 0; m < 4; ++m) { pw[bj][m] = *(const u32x4*)(p + ((ai * 2 + bj) * 4 + m) * 8192);
                            ow[bj][m] = first ? (u32x4){0u, 0u, 0u, 0u} : *(const u32x4*)(mp + (size_t)m * 16 * D + bj * HALF); }
#pragma unroll
                    for (int bj = 0; bj < 2; ++bj)
#pragma unroll
                        for (int m = 0; m < 4; ++m) { const f32x4 a = acc[ai][bj][m][0], b = acc[ai][bj][m][1]; const u32x4 w = pw[bj][m], o = ow[bj][m]; f32x4 v, u2;
                            v.x = sigmoidf_(a.x) * lo2f(w.x) + lo2f(o.x); v.y = sigmoidf_(a.y) * hi2f(w.x) + hi2f(o.x); v.z = sigmoidf_(a.z) * lo2f(w.y) + lo2f(o.y); v.w = sigmoidf_(a.w) * hi2f(w.y) + hi2f(o.y);
                            u2.x = sigmoidf_(b.x) * lo2f(w.z) + lo2f(o.z); u2.y = sigmoidf_(b.y) * hi2f(w.z) + hi2f(o.z); u2.z = sigmoidf_(b.z) * lo2f(w.w) + lo2f(o.w); u2.w = sigmoidf_(b.w) * hi2f(w.w) + hi2f(o.w);
                            if (part) *(u32x4*)(q + ((ai * 2 + bj) * 4 + m) * 8192) = pack8(v, u2);
                            else *(u32x4*)(mp + (size_t)m * 16 * D + bj * HALF) = pack8(v, u2); }
                    asm volatile("" ::: "memory"); }
            } else {
#pragma unroll
                for (int ai = 0; ai < 2; ++ai)
#pragma unroll
                    for (int bj = 0; bj < 2; ++bj)
#pragma unroll
                        for (int mh = 0; mh < 2; ++mh) {
                            u32x4 pw[2], e0[2], e1[2], e2[2];
                            bf16* mp = merged + (size_t)(row0 + ai * HALF + wr * 64 + mh * 32 + fr) * D + dt * BM + wc * 32 + 8 * fq + bj * HALF;
#pragma unroll
                            for (int m2 = 0; m2 < 2; ++m2) { const int fo = ((ai * 2 + bj) * 4 + mh * 2 + m2) * 8192; pw[m2] = *(const u32x4*)(p + fo);
                                e0[m2] = *(const u32x4*)(q + fo); e1[m2] = *(const u32x4*)(q + 131072 + fo); e2[m2] = *(const u32x4*)(q + 262144 + fo); }
#pragma unroll
                            for (int m2 = 0; m2 < 2; ++m2) { const f32x4 a = acc[ai][bj][mh * 2 + m2][0], b = acc[ai][bj][mh * 2 + m2][1]; const u32x4 w = pw[m2], x0 = e0[m2], x1 = e1[m2], x2 = e2[m2]; f32x4 v, u2;
                                v.x = sigmoidf_(a.x) * lo2f(w.x) + ((lo2f(x0.x) + lo2f(x1.x)) + lo2f(x2.x)); v.y = sigmoidf_(a.y) * hi2f(w.x) + ((hi2f(x0.x) + hi2f(x1.x)) + hi2f(x2.x));
                                v.z = sigmoidf_(a.z) * lo2f(w.y) + ((lo2f(x0.y) + lo2f(x1.y)) + lo2f(x2.y)); v.w = sigmoidf_(a.w) * hi2f(w.y) + ((hi2f(x0.y) + hi2f(x1.y)) + hi2f(x2.y));
                                u2.x = sigmoidf_(b.x) * lo2f(w.z) + ((lo2f(x0.z) + lo2f(x1.z)) + lo2f(x2.z)); u2.y = sigmoidf_(b.y) * hi2f(w.z) + ((hi2f(x0.z) + hi2f(x1.z)) + hi2f(x2.z));
                                u2.z = sigmoidf_(b.z) * lo2f(w.w) + ((lo2f(x0.w) + lo2f(x1.w)) + lo2f(x2.w)); u2.w = sigmoidf_(b.w) * hi2f(w.w) + ((hi2f(x0.w) + hi2f(x1.w)) + hi2f(x2.w));
                                *(u32x4*)(mp + (size_t)m2 * 16 * D) = pack8(v, u2); }
                            asm volatile("" ::: "memory"); }
            }
        }
    } };
struct SchedUp { static constexpr bool AMAP = true, HETERO = false; __device__ __forceinline__ int Kof(const Unit&) const { return D; } __device__ __forceinline__ int ldbof(const Unit&) const { return D; } const bf16* hn; const bf16* Bt; int nctxu, nM, nN, G, c;
    __device__ __forceinline__ bool next(int i, Unit& u) const { return static_next(i, G, c, nM, nN, u); }
    __device__ __forceinline__ const char* abase(const Unit&) const { return (const char*)hn; }
    __device__ __forceinline__ const char* bbase(const Unit& u) const { return (const char*)(Bt + (size_t)BM * u.pn * D); }
    __device__ __forceinline__ unsigned aoff(const Unit& u, int h, int R, int C) const {
        const int wr = R >> 6, m = (R >> 4) & 3, fr = R & 15, i = 8 * fr + 4 * h + m; const bool ic = u.pm < nctxu;
        const int run = 2 * (ic ? u.pm : u.pm - nctxu) + wr, seglen = ic ? CTX : SEQ; int t = 126 * run - 1 + i; t = t < 0 ? 0 : (t >= seglen ? seglen - 1 : t);
        return (unsigned)(((ic ? 0 : CTX) + t) * D + C) * 2u; } };
struct EpiUp { bf16* act; const float* cw; const float* cb; int nctxu;
    __device__ __forceinline__ void operator()(const f32x4 (&acc)[2][2][4][2], const Unit& u, int wr, int wc, int fr, int fq) const {
        const bool ic = u.pm < nctxu; const int run = 2 * (ic ? u.pm : u.pm - nctxu) + wr, seglen = ic ? CTX : SEQ, seg0 = ic ? 0 : CTX;
        const int t0 = 126 * run - 1 + 8 * fr;
        const int lane = tidx() & 63;
        u32x2 held[8];
#pragma unroll
        for (int n = 0; n < 2; ++n) {
            const int ch = 128 * u.pn + 32 * wc + 8 * fq + 4 * n;
            const f32x4 w0 = *(const f32x4*)(cw + ch), w1 = *(const f32x4*)(cw + DFF + ch), w2 = *(const f32x4*)(cw + 2 * DFF + ch), bb = *(const f32x4*)(cb + ch);
            f32x4 g[8];
#pragma unroll
            for (int j = 0; j < 8; ++j) { const int t = t0 + j; const bool ok = t >= 0 && t < seglen; g[j] = ok ? acc[j >> 2][1][j & 3][n] : (f32x4){0.f, 0.f, 0.f, 0.f}; }
            f32x4 prev, next;
            prev.x = __shfl(g[7].x, lane - 1); prev.y = __shfl(g[7].y, lane - 1); prev.z = __shfl(g[7].z, lane - 1); prev.w = __shfl(g[7].w, lane - 1);
            next.x = __shfl(g[0].x, lane + 1); next.y = __shfl(g[0].y, lane + 1); next.z = __shfl(g[0].z, lane + 1); next.w = __shfl(g[0].w, lane + 1);
#pragma unroll
            for (int j = 0; j < 8; ++j) { const int i = 8 * fr + j, t = t0 + j;
                const f32x4 gm = (j == 0) ? prev : g[j == 0 ? 0 : j - 1], gp = (j == 7) ? next : g[j == 7 ? 7 : j + 1];
                const f32x4 cv = w0 * gm + w1 * g[j] + w2 * gp + bb; const f32x4 a = acc[j >> 2][0][j & 3][n]; f32x4 o;
                o.x = gelu_tanh(cv.x) * a.x; o.y = gelu_tanh(cv.y) * a.y; o.z = gelu_tanh(cv.z) * a.z; o.w = gelu_tanh(cv.w) * a.w;
                const u32x2 pk = pack4(o);
                if (n == 0) held[j] = pk;
                else if (i >= 1 && i <= 126 && t >= 0 && t < seglen) *(u32x4*)(act + (size_t)(seg0 + t) * DFF + ch - 4) = (u32x4){held[j].x, held[j].y, pk.x, pk.y}; }
        }
    } };
}
constexpr size_t WS_MERGED = WS_S5END;
static_assert(WS_END - WS_S5END >= (size_t)ROWS * D * 2, "merged alias does not fit");
__device__ __forceinline__ void phase_merge_pg(const Ctx& c, const int mode) {
    pg8::MergeGeo geo{mode, (int)gridDim.x, (int)blockIdx.x};
    pg8::SchedPG S{c.W<bf16>(WS_HN), c.W<bf16>(WS_Y), c.W<bf16>(WS_WGT), c.W<bf16>(WS_WBRT), geo};
    pg8::EpiPG E{c.W<unsigned char>(WS_Z) + (size_t)blockIdx.x * 131072, c.W<unsigned char>(WS_Z) + (size_t)256 * 131072, c.W<bf16>(WS_MERGED)};
    pg8::gemm_phase((__attribute__((address_space(3))) unsigned char*)c.lds, D, S, E);
}
__device__ __forceinline__ void phase_ffn_up_pg(const Ctx& c) {
    const int nctxu = (c.l == DEPTH - 1) ? 0 : 2, nM = nctxu + 66;
    pg8::SchedUp S{c.W<bf16>(WS_HN), c.W<bf16>(WS_WUPT), nctxu, nM, DFF * 2 / 256, (int)gridDim.x, (int)blockIdx.x};
    pg8::EpiUp E{c.W<bf16>(WS_Z), c.in(I_FCW) + (size_t)c.l * 3 * DFF, c.in(I_FCB) + (size_t)c.l * DFF, nctxu};
    pg8::gemm_phase((__attribute__((address_space(3))) unsigned char*)c.lds, D, S, E);
}

__device__ __forceinline__ void da_prep(const Ctx& c, const int bid, const int nb) {
    const int wave = tidx() >> 6, lane = tidx() & 63, vec = lane >> 2, sub = lane & 3;
    const bool isq = vec < 8;
    const float* gain = c.in(isq ? I_DQN : I_DKN) + (size_t)c.l * 32 + sub * 8;
    const float qscale = 0.17677669529663687f * 1.4426950408889634f;
    bf16* z = c.W<bf16>(WS_Z);
    for (int row = bid * 8 + wave; row < ROWS; row += nb * 8) {
        bf16* pz = z + (size_t)row * NZ + (isq ? ZC_DAQ : ZC_DAK) + (vec & 7) * 32 + sub * 8;
        const u32x4 raw = *(const u32x4*)pz;
        float x[8] = {lo2f(raw.x), hi2f(raw.x), lo2f(raw.y), hi2f(raw.y), lo2f(raw.z), hi2f(raw.z), lo2f(raw.w), hi2f(raw.w)};
        float ss = 0.f;
#pragma unroll
        for (int e = 0; e < 8; ++e) ss += x[e] * x[e];
        ss += __shfl_xor(ss, 1); ss += __shfl_xor(ss, 2);
        const float rstd = rsqrtf(ss * (1.0f / 32.0f) + 1e-6f);
#pragma unroll
        for (int e = 0; e < 8; ++e) x[e] = x[e] * rstd * gain[e];
        if (row >= CTX) {
            const int tok = row - CTX; const float* rt = c.W<float>(WS_ROPE) + ((sub < 2) ? (tok >> 6) : (tok & 63)) * 16;
#pragma unroll
            for (int e = 0; e < 8; ++e) { const float cs = rt[e * 2], sn = rt[e * 2 + 1]; const float other = __shfl_xor(x[e], 1);
                x[e] = (sub & 1) ? (other * sn + x[e] * cs) : (x[e] * cs - other * sn); }
        }
        if (isq) {
#pragma unroll
            for (int e = 0; e < 8; ++e) x[e] *= qscale; }
        u32x4 w; w.x = pack2(x[0], x[1]); w.y = pack2(x[2], x[3]); w.z = pack2(x[4], x[5]); w.w = pack2(x[6], x[7]);
        *(u32x4*)pz = w;
    }
}

__device__ __forceinline__ void s5_mfma(const Ctx& c, const bool final_pass) {
    const int tid = tidx(), wave = tid >> 6, lane = tid & 63, r = lane & 31, hh = lane >> 5, cq = lane & 15, q4 = lane >> 4;
    unsigned char* hb = (unsigned char*)c.lds + wave * 8704;
    const bf16* z = c.W<bf16>(WS_Z);
    const int c0 = (final_pass && c.l == DEPTH - 1) ? 4 : 0;
    for (int task = c0 * 2 + blockIdx.x; task < NCHUNK * 2; task += gridDim.x) {
        const int ch = task >> 1, g = wave + 8 * (task & 1);
        f32x4 yacc[4];
        if (final_pass) { const float dsk = c.in(I_SD)[(size_t)c.l * 256 + g * 16 + cq];
#pragma unroll
            for (int tb = 0; tb < 4; ++tb)
#pragma unroll
                for (int rg = 0; rg < 4; ++rg) yacc[tb][rg] = bf2f(z[(size_t)(ch * 64 + tb * 16 + 4 * q4 + rg) * NZ + ZC_SSM + g * 16 + cq]) * dsk; }
        for (int d = 0; d < 2; ++d) {
            const int sib = ((c.l * 2 + d) * 16 + g) * 64;
            float lbr[2], lbi[2], hr[2], hi[2]; bf16x8 cmB[4];
#pragma unroll
            for (int j = 0; j < 2; ++j) { const int si = sib + j * 32 + r; lbr[j] = c.W<float>(WS_S5LB)[si * 2]; lbi[j] = c.W<float>(WS_S5LB)[si * 2 + 1];
                if (final_pass) { const float* st = c.W<float>(WS_S5START) + ((size_t)(ch * 2 + d) * 16 + g) * 128 + (j * 32 + r) * 2; hr[j] = st[0]; hi[j] = st[1]; } else { hr[j] = 0.f; hi[j] = 0.f; } }
            if (final_pass) { const size_t cix = ((size_t)((c.l * 2 + d) * 16 + g) * 16 + cq) * 64;
#pragma unroll
                for (int s4 = 0; s4 < 4; ++s4) { const f32x4 re = *(const f32x4*)(c.in(I_SCRE) + cix + 16 * s4 + 4 * q4), im = *(const f32x4*)(c.in(I_SCIM) + cix + 16 * s4 + 4 * q4);
                    cmB[s4] = __builtin_bit_cast(bf16x8, __builtin_convertvector((f32x8){re.x, -im.x, re.y, -im.y, re.z, -im.z, re.w, -im.w}, bf16v8)); } }
#pragma unroll
            for (int mbi = 0; mbi < 2; ++mbi) { const int mb = d ? 1 - mbi : mbi;
                f32x16 X0, X1, X2, X3;
#pragma unroll
                for (int i = 0; i < 16; ++i) { X0[i] = 0.f; X1[i] = 0.f; X2[i] = 0.f; X3[i] = 0.f; }
                { int zo = 0; asm volatile("" : "+v"(zo));
                  const bf16x8 afm = *(const bf16x8*)(z + (size_t)(ch * 64 + mb * 32 + r) * NZ + ZC_SSM + g * 16 + 8 * hh + zo); bf16x8 bfr[4];
#pragma unroll
                  for (int nb = 0; nb < 4; ++nb) { const float* pb = c.W<float>(WS_S5BB) + (size_t)(sib + (nb & 1) * 32 + r) * 32 + (nb >> 1) * 16 + 8 * hh + zo; const f32x4 b0 = *(const f32x4*)pb, b1 = *(const f32x4*)(pb + 4);
                      bfr[nb] = __builtin_bit_cast(bf16x8, __builtin_convertvector((f32x8){b0.x, b0.y, b0.z, b0.w, b1.x, b1.y, b1.z, b1.w}, bf16v8)); }
                  X0 = MFMA32(afm, bfr[0], X0); X1 = MFMA32(afm, bfr[1], X1); X2 = MFMA32(afm, bfr[2], X2); X3 = MFMA32(afm, bfr[3], X3); }
#define S5_SEG(XR, XI, J, G, FIRST_HH, K0, K1, K2, K3) do { \
                    const float ar = lbr[J], ai = lbi[J]; \
                    const float tr0 = ar * hr[J] - ai * hi[J] + XR[4 * (G) + K0], ti0 = ar * hi[J] + ai * hr[J] + XI[4 * (G) + K0]; \
                    const float tr1 = ar * tr0 - ai * ti0 + XR[4 * (G) + K1], ti1 = ar * ti0 + ai * tr0 + XI[4 * (G) + K1]; \
                    const float tr2 = ar * tr1 - ai * ti1 + XR[4 * (G) + K2], ti2 = ar * ti1 + ai * tr1 + XI[4 * (G) + K2]; \
                    const float tr3 = ar * tr2 - ai * ti2 + XR[4 * (G) + K3], ti3 = ar * ti2 + ai * tr2 + XI[4 * (G) + K3]; \
                    const float pr_ = __shfl_xor(tr3, 32), pi_ = __shfl_xor(ti3, 32); \
                    const float ur0 = ar * pr_ - ai * pi_ + XR[4 * (G) + K0], ui0 = ar * pi_ + ai * pr_ + XI[4 * (G) + K0]; \
                    const float ur1 = ar * ur0 - ai * ui0 + XR[4 * (G) + K1], ui1 = ar * ui0 + ai * ur0 + XI[4 * (G) + K1]; \
                    const float ur2 = ar * ur1 - ai * ui1 + XR[4 * (G) + K2], ui2 = ar * ui1 + ai * ur1 + XI[4 * (G) + K2]; \
                    const float ur3 = ar * ur2 - ai * ui2 + XR[4 * (G) + K3], ui3 = ar * ui2 + ai * ur2 + XI[4 * (G) + K3]; \
                    const bool fst = (hh == (FIRST_HH)); \
                    XR[4 * (G) + K0] = fst ? tr0 : ur0; XI[4 * (G) + K0] = fst ? ti0 : ui0; XR[4 * (G) + K1] = fst ? tr1 : ur1; XI[4 * (G) + K1] = fst ? ti1 : ui1; \
                    XR[4 * (G) + K2] = fst ? tr2 : ur2; XI[4 * (G) + K2] = fst ? ti2 : ui2; XR[4 * (G) + K3] = fst ? tr3 : ur3; XI[4 * (G) + K3] = fst ? ti3 : ui3; \
                    const float qr_ = __shfl_xor(ur3, 32), qi_ = __shfl_xor(ui3, 32); hr[J] = fst ? qr_ : ur3; hi[J] = fst ? qi_ : ui3; } while (0)
                if (d == 0) { S5_SEG(X0, X2, 0, 0, 0, 0, 1, 2, 3); S5_SEG(X1, X3, 1, 0, 0, 0, 1, 2, 3); S5_SEG(X0, X2, 0, 1, 0, 0, 1, 2, 3); S5_SEG(X1, X3, 1, 1, 0, 0, 1, 2, 3);
                              S5_SEG(X0, X2, 0, 2, 0, 0, 1, 2, 3); S5_SEG(X1, X3, 1, 2, 0, 0, 1, 2, 3); S5_SEG(X0, X2, 0, 3, 0, 0, 1, 2, 3); S5_SEG(X1, X3, 1, 3, 0, 0, 1, 2, 3); }
                else        { S5_SEG(X0, X2, 0, 3, 1, 3, 2, 1, 0); S5_SEG(X1, X3, 1, 3, 1, 3, 2, 1, 0); S5_SEG(X0, X2, 0, 2, 1, 3, 2, 1, 0); S5_SEG(X1, X3, 1, 2, 1, 3, 2, 1, 0);
                              S5_SEG(X0, X2, 0, 1, 1, 3, 2, 1, 0); S5_SEG(X1, X3, 1, 1, 1, 3, 2, 1, 0); S5_SEG(X0, X2, 0, 0, 1, 3, 2, 1, 0); S5_SEG(X1, X3, 1, 0, 1, 3, 2, 1, 0); }
#undef S5_SEG
                if (final_pass) {
#pragma unroll
                    for (int i = 0; i < 16; ++i) { const int tl = (i & 3) + 8 * (i >> 2) + 4 * hh;
                        *(unsigned*)(hb + tl * 272 + r * 4) = pack2(X0[i], X2[i]); *(unsigned*)(hb + tl * 272 + (32 + r) * 4) = pack2(X1[i], X3[i]); }
#pragma unroll
                    for (int tb2 = 0; tb2 < 2; ++tb2)
#pragma unroll
                        for (int s4 = 0; s4 < 4; ++s4) { const bf16x8 a16 = *(const bf16x8*)(hb + (tb2 * 16 + cq) * 272 + (32 * s4 + 8 * q4) * 2);
                            if (mb == 0) yacc[tb2] = __builtin_amdgcn_mfma_f32_16x16x32_bf16(a16, cmB[s4], yacc[tb2], 0, 0, 0);
                            else yacc[2 + tb2] = __builtin_amdgcn_mfma_f32_16x16x32_bf16(a16, cmB[s4], yacc[2 + tb2], 0, 0, 0); } } }
            if (!final_pass) {
#pragma unroll
                for (int j = 0; j < 2; ++j) if (hh == 0) { float* e = c.W<float>(WS_S5END) + ((size_t)(ch * 2 + d) * 16 + g) * 128 + (j * 32 + r) * 2; e[0] = hr[j]; e[1] = hi[j]; } }
        }
        if (final_pass) { int q4o = q4; asm volatile("" : "+v"(q4o));
#pragma unroll
            for (int tb = 0; tb < 4; ++tb)
#pragma unroll
                for (int rg = 0; rg < 4; ++rg) c.W<bf16>(WS_YS5)[(size_t)(ch * 64 + tb * 16 + 4 * q4o + rg) * 256 + g * 16 + cq] = f2bf(gelu_tanh(yacc[tb][rg])); }
    }
}

__device__ __forceinline__ void lru_mfma(const Ctx& c, const bool final_pass) {
    const int tid = tidx(), wave = tid >> 6, lane = tid & 63, r = lane & 31, hh = lane >> 5, chn = wave * 32 + r;
    unsigned char* L = (unsigned char*)c.lds;
    bf16* xt = (bf16*)L;
    unsigned char* xcb = L + 34816;
    float* xcf = (float*)(L + 68608);
    const bf16* z = c.W<bf16>(WS_Z);
    const int sg = tid & 31;
    const int c0 = (final_pass && c.l == DEPTH - 1) ? 4 : 0;
    for (int ch = c0 + rot_bid(8); ch < NCHUNK; ch += gridDim.x) {
        const int segb = ch < 4 ? 0 : CTX, sege = ch < 4 ? CTX : ROWS;
        __syncthreads();
        { u32x4 v[5];
#pragma unroll
          for (int q = 0; q < 5; ++q) { const int pc = tid + q * NT, rr = pc >> 5, row = ch * 64 - 2 + rr;
              v[q] = (pc < 67 * 32 && row >= segb && row < sege) ? *(const u32x4*)(z + (size_t)row * NZ + ZC_LRUX + (pc & 31) * 8) : (u32x4){0u, 0u, 0u, 0u}; }
#pragma unroll
          for (int q = 0; q < 5; ++q) { const int pc = tid + q * NT; if (pc < 67 * 32) *(u32x4*)(xt + (size_t)pc * 8) = v[q]; } }
        __syncthreads();
        { int zo = 0; asm volatile("" : "+v"(zo));
          float cwv[4][8], cbv8[8];
#pragma unroll
          for (int e = 0; e < 8; ++e) { cbv8[e] = c.in(I_LCB)[(size_t)c.l * 256 + sg * 8 + e + zo];
#pragma unroll
              for (int k = 0; k < 4; ++k) cwv[k][e] = c.in(I_LCW)[(size_t)c.l * 1024 + k * 256 + sg * 8 + e + zo]; }
#pragma unroll
        for (int q = 0; q < 4; ++q) { const int i = (tid >> 5) + q * 16; float o[8];
#pragma unroll
            for (int e = 0; e < 8; ++e) o[e] = cbv8[e];
#pragma unroll
            for (int k = 0; k < 4; ++k) { const u32x4 xv = *(const u32x4*)(xt + (size_t)(i + k) * 256 + sg * 8);
                o[0] += cwv[k][0] * lo2f(xv.x); o[1] += cwv[k][1] * hi2f(xv.x); o[2] += cwv[k][2] * lo2f(xv.y); o[3] += cwv[k][3] * hi2f(xv.y);
                o[4] += cwv[k][4] * lo2f(xv.z); o[5] += cwv[k][5] * hi2f(xv.z); o[6] += cwv[k][6] * lo2f(xv.w); o[7] += cwv[k][7] * hi2f(xv.w); }
            *(f32x4*)(xcf + i * 256 + sg * 8) = (f32x4){o[0], o[1], o[2], o[3]}; *(f32x4*)(xcf + i * 256 + sg * 8 + 4) = (f32x4){o[4], o[5], o[6], o[7]};
            u32x4 w; w.x = pack2(o[0], o[1]); w.y = pack2(o[2], o[3]); w.z = pack2(o[4], o[5]); w.w = pack2(o[6], o[7]); *(u32x4*)(xcb + i * 528 + sg * 16) = w; } }
        __syncthreads();
        bf16x8 af[2][2]; float xv[2][16], hs[2][16];
#pragma unroll
        for (int mb = 0; mb < 2; ++mb) {
#pragma unroll
            for (int s2 = 0; s2 < 2; ++s2) af[mb][s2] = *(const bf16x8*)(xcb + (mb * 32 + r) * 528 + (wave * 32 + 16 * s2 + 8 * hh) * 2);
#pragma unroll
            for (int i = 0; i < 16; ++i) xv[mb][i] = xcf[(mb * 32 + (i & 3) + 8 * (i >> 2) + 4 * hh) * 256 + chn]; }
#pragma unroll
        for (int d = 0; d < 2; ++d) {
            int zo = 0; asm volatile("" : "+v"(zo));
            bf16x8 wrf[2], wif[2]; const size_t base = ((size_t)(c.l * 2 + d) * 8 + wave) * 1024 + r + zo;
            const float brv = c.in(I_LBR)[(size_t)(c.l * 2 + d) * 256 + chn + zo], biv = c.in(I_LBI)[(size_t)(c.l * 2 + d) * 256 + chn + zo], lsv = 8.0f * logsigmoidf_(c.in(I_LLAM)[(size_t)(c.l * 2 + d) * 256 + chn + zo]);
#pragma unroll
            for (int s2 = 0; s2 < 2; ++s2) { const float* pr_ = c.in(I_LWR) + base + (size_t)(16 * s2 + 8 * hh) * 32; const float* pi_ = c.in(I_LWI) + base + (size_t)(16 * s2 + 8 * hh) * 32;
                wrf[s2] = __builtin_bit_cast(bf16x8, __builtin_convertvector((f32x8){pr_[0], pr_[32], pr_[64], pr_[96], pr_[128], pr_[160], pr_[192], pr_[224]}, bf16v8));
                wif[s2] = __builtin_bit_cast(bf16x8, __builtin_convertvector((f32x8){pi_[0], pi_[32], pi_[64], pi_[96], pi_[128], pi_[160], pi_[192], pi_[224]}, bf16v8)); }
            float av[2][16], bv[2][16];
#pragma unroll
            for (int mb = 0; mb < 2; ++mb) { f32x16 ra, ia;
#pragma unroll
                for (int i = 0; i < 16; ++i) { ra[i] = brv; ia[i] = biv; }
#pragma unroll
                for (int s2 = 0; s2 < 2; ++s2) { ra = MFMA32(af[mb][s2], wrf[s2], ra); ia = MFMA32(af[mb][s2], wif[s2], ia); }
#pragma unroll
                for (int i = 0; i < 16; ++i) { const float rg = sigmoidf_(ra[i]), ig = sigmoidf_(ia[i]), a = __expf(rg * lsv);
                    av[mb][i] = a; bv[mb][i] = sqrtf(fmaxf(1.0f - a * a, 0.f)) * (ig * xv[mb][i]); } }
            float h = final_pass ? c.W<float>(WS_LRUSTART)[(size_t)(ch * 2 + d) * 256 + chn] : 0.f;
#define LRU_SEG(MB, G, FIRST_HH, K0, K1, K2, K3) do { \
                float t0 = av[MB][4 * (G) + K0] * h + bv[MB][4 * (G) + K0], t1 = av[MB][4 * (G) + K1] * t0 + bv[MB][4 * (G) + K1], t2 = av[MB][4 * (G) + K2] * t1 + bv[MB][4 * (G) + K2], t3 = av[MB][4 * (G) + K3] * t2 + bv[MB][4 * (G) + K3]; \
                const float hin = __shfl_xor(t3, 32); \
                const float u0 = av[MB][4 * (G) + K0] * hin + bv[MB][4 * (G) + K0], u1 = av[MB][4 * (G) + K1] * u0 + bv[MB][4 * (G) + K1], u2 = av[MB][4 * (G) + K2] * u1 + bv[MB][4 * (G) + K2], u3 = av[MB][4 * (G) + K3] * u2 + bv[MB][4 * (G) + K3]; \
                const bool fst = (hh == (FIRST_HH)); \
                bv[MB][4 * (G) + K0] = fst ? t0 : u0; bv[MB][4 * (G) + K1] = fst ? t1 : u1; bv[MB][4 * (G) + K2] = fst ? t2 : u2; bv[MB][4 * (G) + K3] = fst ? t3 : u3; \
                const float ho = __shfl_xor(u3, 32); h = fst ? ho : u3; } while (0)
            if (d == 0) { LRU_SEG(0, 0, 0, 0, 1, 2, 3); LRU_SEG(0, 1, 0, 0, 1, 2, 3); LRU_SEG(0, 2, 0, 0, 1, 2, 3); LRU_SEG(0, 3, 0, 0, 1, 2, 3);
                          LRU_SEG(1, 0, 0, 0, 1, 2, 3); LRU_SEG(1, 1, 0, 0, 1, 2, 3); LRU_SEG(1, 2, 0, 0, 1, 2, 3); LRU_SEG(1, 3, 0, 0, 1, 2, 3); }
            else        { LRU_SEG(1, 3, 1, 3, 2, 1, 0); LRU_SEG(1, 2, 1, 3, 2, 1, 0); LRU_SEG(1, 1, 1, 3, 2, 1, 0); LRU_SEG(1, 0, 1, 3, 2, 1, 0);
                          LRU_SEG(0, 3, 1, 3, 2, 1, 0); LRU_SEG(0, 2, 1, 3, 2, 1, 0); LRU_SEG(0, 1, 1, 3, 2, 1, 0); LRU_SEG(0, 0, 1, 3, 2, 1, 0); }
#undef LRU_SEG
            if (!final_pass) { float A = 1.f;
#pragma unroll
                for (int mb = 0; mb < 2; ++mb)
#pragma unroll
                    for (int i = 0; i < 16; ++i) A *= av[mb][i];
                A *= __shfl_xor(A, 32);
                if (hh == 0) { float* e = c.W<float>(WS_LRUEND) + ((size_t)(ch * 2 + d) * 256 + chn) * 2; e[0] = A; e[1] = h; } }
            else {
#pragma unroll
                for (int mb = 0; mb < 2; ++mb)
#pragma unroll
                    for (int i = 0; i < 16; ++i) hs[mb][i] = d == 0 ? bv[mb][i] : hs[mb][i] + bv[mb][i]; }
        }
        if (final_pass) {
#pragma unroll
            for (int mb = 0; mb < 2; ++mb)
#pragma unroll
                for (int i = 0; i < 16; ++i) xcf[(mb * 32 + (i & 3) + 8 * (i >> 2) + 4 * hh) * 256 + chn] = hs[mb][i];
            __syncthreads();
            u32x4 yv[4];
#pragma unroll
            for (int q = 0; q < 4; ++q) { const int pc = tid + q * NT; yv[q] = *(const u32x4*)(z + (size_t)(ch * 64 + (pc >> 5)) * NZ + ZC_LRUY + (pc & 31) * 8); }
#pragma unroll
            for (int q = 0; q < 4; ++q) { const int pc = tid + q * NT, rr = pc >> 5; const float* hp = xcf + rr * 256 + (pc & 31) * 8; u32x4 w;
                w.x = pack2(hp[0] * gelu_tanh(lo2f(yv[q].x)), hp[1] * gelu_tanh(hi2f(yv[q].x))); w.y = pack2(hp[2] * gelu_tanh(lo2f(yv[q].y)), hp[3] * gelu_tanh(hi2f(yv[q].y)));
                w.z = pack2(hp[4] * gelu_tanh(lo2f(yv[q].z)), hp[5] * gelu_tanh(hi2f(yv[q].z))); w.w = pack2(hp[6] * gelu_tanh(lo2f(yv[q].w)), hp[7] * gelu_tanh(hi2f(yv[q].w)));
                *(u32x4*)(c.W<bf16>(WS_Y) + (size_t)(ch * 64 + rr) * D + 256 + (pc & 31) * 8) = w; } }
    }
}

__device__ __forceinline__ float logsig_fast(float x) { return fminf(x, 0.f) - __logf(1.0f + __expf(-fabsf(x))); }
__device__ __forceinline__ void gla_mfma(const Ctx& c, const bool final_pass) {
    const int tid = tidx(), wave = tid >> 6, lane = tid & 63, r = lane & 31, hh = lane >> 5, hd = wave >> 1, d = wave & 1;
    unsigned char* L = (unsigned char*)c.lds;
    unsigned char* QE = L + wave * 10240; unsigned char* KE = QE + 5120;
    unsigned char* VT = L + 81920 + hd * 9216;
    float* zt = (float*)(L + 118784);
    float* ex = (float*)(L + (wave & ~1) * 10240);
    const bf16* z = c.W<bf16>(WS_Z); const float* za = c.W<float>(WS_ZA);
    const int pr = (r & 19) | ((r & 4) << 1) | ((r & 8) >> 1);
    const int c0 = (final_pass && c.l == DEPTH - 1) ? 4 : 0;
    for (int ch = c0 + rot_bid(12); ch < NCHUNK; ch += gridDim.x) {
        __syncthreads();
        { const f32x4 zv = *(const f32x4*)(za + (size_t)(ch * 64 + (tid >> 3)) * 32 + (tid & 7) * 4); u32x4 vv[4];
#pragma unroll
          for (int q = 0; q < 4; ++q) { const int pc = tid + q * NT; vv[q] = *(const u32x4*)(z + (size_t)(ch * 64 + (pc >> 5)) * NZ + ZC_GV + (pc & 31) * 8); }
          *(f32x4*)(zt + (tid >> 3) * 32 + (tid & 7) * 4) = zv;
#pragma unroll
          for (int q = 0; q < 4; ++q) { const int pc = tid + q * NT, j = pc >> 5, sg = pc & 31; bf16* dst = (bf16*)(L + 81920 + (sg >> 3) * 9216 + ((sg & 7) * 8) * 144 + j * 2);
              dst[0] = (bf16)(vv[q].x & 0xffff); dst[72] = (bf16)(vv[q].x >> 16); dst[144] = (bf16)(vv[q].y & 0xffff); dst[216] = (bf16)(vv[q].y >> 16);
              dst[288] = (bf16)(vv[q].z & 0xffff); dst[360] = (bf16)(vv[q].z >> 16); dst[432] = (bf16)(vv[q].w & 0xffff); dst[504] = (bf16)(vv[q].w >> 16); } }
        __syncthreads();
        int zo = 0; asm volatile("" : "+v"(zo));
        float w2[16];
#pragma unroll
        for (int k = 0; k < 16; ++k) w2[k] = c.in(I_GWA2)[(size_t)(c.l * 2 + d) * 16 * 128 + k * 128 + hd * 32 + r + zo];
        const float bav = c.in(I_GBA)[(size_t)(c.l * 2 + d) * 128 + hd * 32 + r + zo];
        float lav[32]; float run = 0.f;
#pragma unroll
        for (int i = 0; i < 32; ++i) { const int tok = hh * 32 + (d ? 31 - i : i); const float* a = zt + tok * 32 + d * 16; float zz = bav;
            const f32x4 a0 = *(const f32x4*)a, a1 = *(const f32x4*)(a + 4), a2 = *(const f32x4*)(a + 8), a3 = *(const f32x4*)(a + 12);
            zz += (a0.x * w2[0] + a0.y * w2[1]) + (a0.z * w2[2] + a0.w * w2[3]) + (a1.x * w2[4] + a1.y * w2[5]) + (a1.z * w2[6] + a1.w * w2[7])
                + (a2.x * w2[8] + a2.y * w2[9]) + (a2.z * w2[10] + a2.w * w2[11]) + (a3.x * w2[12] + a3.y * w2[13]) + (a3.z * w2[14] + a3.w * w2[15]);
            run += logsig_fast(zz) * (1.0f / 16.0f); lav[i] = run; }
        const float other = __shfl_xor(run, 32), tot = run + other, add = ((d == 0) == (hh == 1)) ? other : 0.f;
        int koff = 0, hq = hh; asm volatile("" : "+v"(hq));
        const bf16* pq = z + (size_t)(ch * 64) * NZ + ZC_GQ + hd * 32 + r; const bf16* pk = z + (size_t)(ch * 64) * NZ + ZC_GK + hd * 32 + r;
        if (final_pass) {
#pragma unroll
            for (int i = 0; i < 32; ++i) { if ((i & 7) == 0) asm volatile("" : "+v"(koff) :: "memory");
                const int tok = hq * 32 + (d ? 31 - i : i); const float b = lav[i] + add;
                const float qv = bf2f(pq[(size_t)tok * NZ + koff]) * 0.17677669529663687f, kv = bf2f(pk[(size_t)tok * NZ + koff]);
                *(bf16*)(QE + tok * 80 + r * 2) = f2bf(qv * __expf(b)); *(bf16*)(KE + tok * 80 + r * 2) = f2bf(kv * __expf(-b));
                }
        } else {
#pragma unroll
            for (int i = 0; i < 32; ++i) { if ((i & 7) == 0) asm volatile("" : "+v"(koff) :: "memory");
                const int tok = hq * 32 + (d ? 31 - i : i); const float b = lav[i] + add; const float kv = bf2f(pk[(size_t)tok * NZ + koff]);
                *(bf16*)(QE + r * 144 + tok * 2) = f2bf(kv * __expf(tot - b));
                }
            if (hh == 0) c.W<float>(WS_GLADEC)[((size_t)(ch * 2 + d) * 4 + hd) * 32 + r] = __expf(tot);
        }
        if (!final_pass) {
            f32x16 kvt[2];
#pragma unroll
            for (int db = 0; db < 2; ++db)
#pragma unroll
                for (int i = 0; i < 16; ++i) kvt[db][i] = 0.f;
#pragma unroll
            for (int s4 = 0; s4 < 4; ++s4) { const bf16x8 bf = *(const bf16x8*)(QE + r * 144 + (16 * s4 + 8 * hh) * 2);
#pragma unroll
                for (int db = 0; db < 2; ++db) { const bf16x8 af = *(const bf16x8*)(VT + (db * 32 + r) * 144 + (16 * s4 + 8 * hh) * 2); kvt[db] = MFMA32(af, bf, kvt[db]); } }
            float* kvp = c.W<float>(WS_GLAKV) + ((size_t)(ch * 2 + d) * 4 + hd) * 2048 + r;
#pragma unroll
            for (int db = 0; db < 2; ++db)
#pragma unroll
                for (int i = 0; i < 16; ++i) kvp[(db * 32 + (i & 3) + 8 * (i >> 2) + 4 * hh) * 32] = kvt[db][i];
            continue;
        }
        f32x16 o[2][2];
#pragma unroll
        for (int db = 0; db < 2; ++db)
#pragma unroll
            for (int ib = 0; ib < 2; ++ib)
#pragma unroll
                for (int i = 0; i < 16; ++i) o[db][ib][i] = 0.f;
        bf16x8 qb[2][2];
#pragma unroll
        for (int ib = 0; ib < 2; ++ib)
#pragma unroll
            for (int s2 = 0; s2 < 2; ++s2) qb[ib][s2] = *(const bf16x8*)(QE + (ib * 32 + r) * 80 + s2 * 32 + hh * 16);
        { const bf16* s0t = c.W<bf16>(WS_GLAS0) + ((size_t)(ch * 2 + d) * 4 + hd) * 2048;
#pragma unroll
          for (int db = 0; db < 2; ++db)
#pragma unroll
              for (int s2 = 0; s2 < 2; ++s2) { const bf16x8 sf = *(const bf16x8*)(s0t + (db * 32 + r) * 32 + 16 * s2 + 8 * hh);
#pragma unroll
                  for (int ib = 0; ib < 2; ++ib) o[db][ib] = MFMA32(sf, qb[ib][s2], o[db][ib]); } }
#define GLA_BLOCK(JB, IB, MASKED) do { f32x16 x; _Pragma("unroll") for (int i = 0; i < 16; ++i) x[i] = 0.f; \
        _Pragma("unroll") for (int s2 = 0; s2 < 2; ++s2) { const bf16x8 kf = *(const bf16x8*)(KE + ((JB) * 32 + pr) * 80 + s2 * 32 + hh * 16); x = MFMA32(kf, qb[IB][s2], x); } \
        if (MASKED) { _Pragma("unroll") for (int i = 0; i < 16; ++i) { const int jl = (i & 3) + 4 * ((i >> 2) & 1) + 8 * hh + 16 * (i >> 3); const bool keep = d ? (jl >= r) : (jl <= r); x[i] = keep ? x[i] : 0.f; } } \
        _Pragma("unroll") for (int s2 = 0; s2 < 2; ++s2) { \
            const bf16x8 pb = __builtin_bit_cast(bf16x8, __builtin_convertvector((f32x8){x[8 * s2], x[8 * s2 + 1], x[8 * s2 + 2], x[8 * s2 + 3], x[8 * s2 + 4], x[8 * s2 + 5], x[8 * s2 + 6], x[8 * s2 + 7]}, bf16v8)); \
            _Pragma("unroll") for (int db = 0; db < 2; ++db) { const bf16x8 vf = *(const bf16x8*)(VT + (db * 32 + r) * 144 + ((JB) * 32 + s2 * 16 + hh * 8) * 2); o[db][IB] = MFMA32(vf, pb, o[db][IB]); } } } while (0)
        GLA_BLOCK(0, 0, true); GLA_BLOCK(1, 1, true);
        if (d == 0) GLA_BLOCK(0, 1, false); else GLA_BLOCK(1, 0, false);
#undef GLA_BLOCK
        __syncthreads();
        if (d == 1) {
#pragma unroll
            for (int db = 0; db < 2; ++db)
#pragma unroll
                for (int ib = 0; ib < 2; ++ib)
#pragma unroll
                    for (int i = 0; i < 16; ++i) ex[((db * 2 + ib) * 16 + i) * 64 + lane] = o[db][ib][i]; }
        __syncthreads();
        if (d == 0) {
            const float* gon = c.in(I_GON) + (size_t)c.l * 64;
#pragma unroll
            for (int ib = 0; ib < 2; ++ib) { float ss = 0.f;
#pragma unroll
                for (int db = 0; db < 2; ++db)
#pragma unroll
                    for (int i = 0; i < 16; ++i) { const float v = o[db][ib][i] + ex[((db * 2 + ib) * 16 + i) * 64 + lane]; o[db][ib][i] = v; ss += v * v; }
                ss += __shfl_xor(ss, 32);
                const float rstd = rsqrtf(ss * (1.0f / 64.0f) + 1e-6f); const int row = ch * 64 + ib * 32 + r;
#pragma unroll
                for (int db = 0; db < 2; ++db)
#pragma unroll
                    for (int g4 = 0; g4 < 4; ++g4) { const int dv0 = db * 32 + 8 * g4 + 4 * hh; const u32x2 gw = *(const u32x2*)(z + (size_t)row * NZ + ZC_GG + hd * 64 + dv0); const f32x4 gn = *(const f32x4*)(gon + dv0);
                        u32x2 w; w.x = pack2(o[db][ib][4 * g4] * rstd * gn.x * siluf_(lo2f(gw.x)), o[db][ib][4 * g4 + 1] * rstd * gn.y * siluf_(hi2f(gw.x)));
                        w.y = pack2(o[db][ib][4 * g4 + 2] * rstd * gn.z * siluf_(lo2f(gw.y)), o[db][ib][4 * g4 + 3] * rstd * gn.w * siluf_(hi2f(gw.y)));
                        *(u32x2*)(c.W<bf16>(WS_Y) + (size_t)row * D + 768 + hd * 64 + dv0) = w; } } }
    }
}

__device__ __forceinline__ void phase_carry(const Ctx& c) {
    const int b = blockIdx.x, t = tidx();
    constexpr int NB = 13, NBATCH = NCHUNK / NB;
    if (b < 4) {
        const int i = b * NT + t, d = i >> 10, gp = i & 1023; const int si = (c.l * 2 + d) * 1024 + gp;
        float ar = c.W<float>(WS_S5LB)[si * 2], ai = c.W<float>(WS_S5LB)[si * 2 + 1];
        for (int q = 0; q < 6; ++q) { const float nr = ar * ar - ai * ai, ni = 2.f * ar * ai; ar = nr; ai = ni; }
        float hr = 0.f, hi = 0.f;
        const f32x2* E = c.W<f32x2>(WS_S5END); f32x2* S = c.W<f32x2>(WS_S5START);
        f32x2 ea[NB], eb[NB];
#define S5C_LOAD(dst, s0) _Pragma("unroll") for (int j = 0; j < NB; ++j) dst[j] = E[(size_t)(chunk_of((s0) + j, d) * 2 + d) * 1024 + gp]
#define S5C_USE(src, s0) _Pragma("unroll") for (int j = 0; j < NB; ++j) { S[(size_t)(chunk_of((s0) + j, d) * 2 + d) * 1024 + gp] = (f32x2){hr, hi}; \
            const float nr = ar * hr - ai * hi + src[j].x, ni = ar * hi + ai * hr + src[j].y; hr = nr; hi = ni; }
        S5C_LOAD(ea, 0);
        for (int bt = 0; bt < NBATCH; bt += 2) { S5C_LOAD(eb, (bt + 1) * NB); S5C_USE(ea, bt * NB); if (bt + 2 < NBATCH) S5C_LOAD(ea, (bt + 2) * NB); S5C_USE(eb, (bt + 1) * NB); }
#undef S5C_LOAD
#undef S5C_USE
    } else if (b == 4) {
        const int d = t >> 8, chn = t & 255; float h = 0.f;
        const f32x2* E = c.W<f32x2>(WS_LRUEND); float* S = c.W<float>(WS_LRUSTART);
        f32x2 ea[NB], eb[NB];
#define LRC_LOAD(dst, s0) _Pragma("unroll") for (int j = 0; j < NB; ++j) dst[j] = E[(size_t)(chunk_of((s0) + j, d) * 2 + d) * 256 + chn]
#define LRC_USE(src, s0) _Pragma("unroll") for (int j = 0; j < NB; ++j) { S[(size_t)(chunk_of((s0) + j, d) * 2 + d) * 256 + chn] = h; h = src[j].x * h + src[j].y; }
        LRC_LOAD(ea, 0);
        for (int bt = 0; bt < NBATCH; bt += 2) { LRC_LOAD(eb, (bt + 1) * NB); LRC_USE(ea, bt * NB); if (bt + 2 < NBATCH) LRC_LOAD(ea, (bt + 2) * NB); LRC_USE(eb, (bt + 1) * NB); }
#undef LRC_LOAD
#undef LRC_USE
    } else if (b >= 8 && b < 40) {
        const int i = (b - 8) * NT + t, d = i >> 13, hd = (i >> 11) & 3, e = i & 2047, dk = e & 31; float S = 0.f;
        const float* KV = c.W<float>(WS_GLAKV); const float* DC = c.W<float>(WS_GLADEC); bf16* S0 = c.W<bf16>(WS_GLAS0);
        float ka[NB], da[NB], kb[NB], db[NB];
#define GLC_LOAD(kd, dd, s0) _Pragma("unroll") for (int j = 0; j < NB; ++j) { const size_t cb = (size_t)(chunk_of((s0) + j, d) * 2 + d) * 4 + hd; kd[j] = KV[cb * 2048 + e]; dd[j] = DC[cb * 32 + dk]; }
#define GLC_USE(kd, dd, s0) _Pragma("unroll") for (int j = 0; j < NB; ++j) { const size_t cb = (size_t)(chunk_of((s0) + j, d) * 2 + d) * 4 + hd; S0[cb * 2048 + e] = f2bf(S); S = dd[j] * S + kd[j]; }
        GLC_LOAD(ka, da, 0);
        for (int bt = 0; bt < NBATCH; bt += 2) { GLC_LOAD(kb, db, (bt + 1) * NB); GLC_USE(ka, da, bt * NB); if (bt + 2 < NBATCH) GLC_LOAD(ka, da, (bt + 2) * NB); GLC_USE(kb, db, (bt + 1) * NB); }
#undef GLC_LOAD
#undef GLC_USE
    }
}

__device__ __forceinline__ void v_transpose(const Ctx& c, const int bid, const int nb) {
    const int t = tidx(); bf16* sm = (bf16*)c.lds;
    const bf16* z = c.W<bf16>(WS_Z); bf16* vT = c.W<bf16>(WS_VT);
    for (int task = bid; task < NCHUNK * 4; task += nb) {
        const int kt = task >> 2, hd = task & 3, key = t >> 3, seg = t & 7;
        const u32x4 v = *(const u32x4*)(z + (size_t)(kt * 64 + key) * NZ + ZC_DAV + hd * 64 + seg * 8);
        __syncthreads();
        bf16* d = sm + (seg * 8) * 72 + key;
        d[0] = (bf16)(v.x & 0xffff); d[72] = (bf16)(v.x >> 16); d[144] = (bf16)(v.y & 0xffff); d[216] = (bf16)(v.y >> 16);
        d[288] = (bf16)(v.z & 0xffff); d[360] = (bf16)(v.z >> 16); d[432] = (bf16)(v.w & 0xffff); d[504] = (bf16)(v.w >> 16);
        __syncthreads();
        *(u32x4*)(vT + (size_t)(hd * 64 + key) * ROWS + kt * 64 + seg * 8) = *(const u32x4*)(sm + key * 72 + seg * 8);
    }
}
template <bool SHIFT>
__device__ __forceinline__ void attn_mfma_body(const Ctx& c) {
    const int tid = tidx(), wave = tid >> 6, lane = tid & 63, r = lane & 31, hh = lane >> 5;
    constexpr int KS = 144, VOFF = 64 * KS, BUF = 2 * 64 * KS;
    unsigned char* L = (unsigned char*)c.lds;
    const bf16* z = c.W<bf16>(WS_Z); const bf16* vT = c.W<bf16>(WS_VT);
    const float li = lam_init_of(c.l);
    float lam; { const float* lp = c.in(I_DLAM) + (size_t)c.l * 128; float s0 = 0.f, s1 = 0.f; for (int k = 0; k < 32; ++k) { s0 += lp[k] * lp[32 + k]; s1 += lp[64 + k] * lp[96 + k]; } lam = expf(s0) - expf(s1) + li; }
    float gq = 0.f, gk = 0.f; for (int k = 0; k < 32; ++k) { gq = fmaxf(gq, fabsf(c.in(I_DQN)[(size_t)c.l * 32 + k])); gk = fmaxf(gk, fabsf(c.in(I_DKN)[(size_t)c.l * 32 + k])); }
    const float mb = 32.0f * gq * gk * (0.17677669529663687f * 1.4426950408889634f) * 1.02f;
    const int pr = (r & 19) | ((r & 4) << 1) | ((r & 8) >> 1);
    const int skey = tid >> 3, sseg = tid & 7, lw = skey * KS + sseg * 16;
    const int qb0 = (c.l == DEPTH - 1) ? 1 : 0;
    for (int task = qb0 * 4 + blockIdx.x; task < 65 * 4; task += gridDim.x) {
        const int qb = task >> 2, hd = task & 3, nt = (qb == 0 ? CTX : ROWS) / 64; const int row = qb * 256 + wave * 32 + r;
        bf16x8 qf[2][2];
        { const bf16* pq = z + (size_t)row * NZ + ZC_DAQ + hd * 64 + hh * 8;
#pragma unroll
          for (int cc = 0; cc < 2; ++cc)
#pragma unroll
              for (int s2 = 0; s2 < 2; ++s2) qf[cc][s2] = *(const bf16x8*)(pq + cc * 32 + s2 * 16); }
        f32x16 o[2][2];
#pragma unroll
        for (int cc = 0; cc < 2; ++cc)
#pragma unroll
            for (int db = 0; db < 2; ++db)
#pragma unroll
                for (int i = 0; i < 16; ++i) o[cc][db][i] = 0.f;
        float ls0 = 0.f, ls1 = 0.f;
        const bf16* gk_ = z + (size_t)skey * NZ + ZC_DAK + hd * 64 + sseg * 8;
        const bf16* gv_ = vT + (size_t)(hd * 64 + skey) * ROWS + sseg * 8;
        u32x4 kr = *(const u32x4*)gk_, vr = *(const u32x4*)gv_;
        __syncthreads();
        *(u32x4*)(L + lw) = kr; *(u32x4*)(L + VOFF + lw) = vr;
        __syncthreads();
        for (int t = 0; t < nt; ++t) {
            const unsigned char* cur = L + (t & 1) * BUF;
            if (t + 1 < nt) { kr = *(const u32x4*)(gk_ + (size_t)(t + 1) * 64 * NZ); vr = *(const u32x4*)(gv_ + (t + 1) * 64); }
#pragma unroll
            for (int kb = 0; kb < 2; ++kb) {
                bf16x8 vf[2][2];
#pragma unroll
                for (int db = 0; db < 2; ++db)
#pragma unroll
                    for (int s2 = 0; s2 < 2; ++s2) vf[db][s2] = *(const bf16x8*)(cur + VOFF + (db * 32 + r) * KS + (kb * 32 + s2 * 16 + hh * 8) * 2);
#pragma unroll
                for (int cc = 0; cc < 2; ++cc) {
                    f32x16 sa;
#pragma unroll
                    for (int i = 0; i < 16; ++i) sa[i] = SHIFT ? -mb : 0.f;
#pragma unroll
                    for (int s2 = 0; s2 < 2; ++s2) { const bf16x8 kf = *(const bf16x8*)(cur + (kb * 32 + pr) * KS + cc * 64 + s2 * 32 + hh * 16); sa = MFMA32(kf, qf[cc][s2], sa); }
                    float p[16];
#pragma unroll
                    for (int i = 0; i < 16; ++i) p[i] = __builtin_amdgcn_exp2f(sa[i]);
                    const float ps = ((p[0] + p[1]) + (p[2] + p[3])) + ((p[4] + p[5]) + (p[6] + p[7])) + (((p[8] + p[9]) + (p[10] + p[11])) + ((p[12] + p[13]) + (p[14] + p[15])));
                    if (cc == 0) ls0 += ps; else ls1 += ps;
#pragma unroll
                    for (int s2 = 0; s2 < 2; ++s2) {
                        const bf16x8 pb = __builtin_bit_cast(bf16x8, __builtin_convertvector((f32x8){p[8 * s2], p[8 * s2 + 1], p[8 * s2 + 2], p[8 * s2 + 3], p[8 * s2 + 4], p[8 * s2 + 5], p[8 * s2 + 6], p[8 * s2 + 7]}, bf16v8));
#pragma unroll
                        for (int db = 0; db < 2; ++db) o[cc][db] = MFMA32(vf[db][s2], pb, o[cc][db]);
                    }
                }
            }
            if (t + 1 < nt) { unsigned char* nb = L + ((t + 1) & 1) * BUF; *(u32x4*)(nb + lw) = kr; *(u32x4*)(nb + VOFF + lw) = vr; }
            __syncthreads();
        }
        ls0 += __shfl_xor(ls0, 32); ls1 += __shfl_xor(ls1, 32);
        const float il0 = 1.0f / ls0, il1 = lam / ls1; float ss = 0.f;
#pragma unroll
        for (int db = 0; db < 2; ++db)
#pragma unroll
            for (int i = 0; i < 16; ++i) { const float v = o[0][db][i] * il0 - o[1][db][i] * il1; o[0][db][i] = v; ss += v * v; }
        ss += __shfl_xor(ss, 32);
        const float rstd = rsqrtf(ss * (1.0f / 64.0f) + 1e-6f) * (1.0f - li);
        bf16* po = c.W<bf16>(WS_Y) + (size_t)row * D + 512 + hd * 64 + 4 * hh; const float* gn = c.in(I_DON) + (size_t)c.l * 64 + 4 * hh;
#pragma unroll
        for (int db = 0; db < 2; ++db)
#pragma unroll
            for (int g = 0; g < 4; ++g) { const int dv0 = db * 32 + 8 * g; const f32x4 gg = *(const f32x4*)(gn + dv0);
                u32x2 w; w.x = pack2(o[0][db][4 * g] * rstd * gg.x, o[0][db][4 * g + 1] * rstd * gg.y); w.y = pack2(o[0][db][4 * g + 2] * rstd * gg.z, o[0][db][4 * g + 3] * rstd * gg.w);
                *(u32x2*)(po + dv0) = w; }
    }
}


__device__ __forceinline__ void attn_mfma(const Ctx& c) {
    float gq = 0.f, gk = 0.f; for (int k = 0; k < 32; ++k) { gq = fmaxf(gq, fabsf(c.in(I_DQN)[(size_t)c.l * 32 + k])); gk = fmaxf(gk, fabsf(c.in(I_DKN)[(size_t)c.l * 32 + k])); }
    const float mb = 32.0f * gq * gk * (0.17677669529663687f * 1.4426950408889634f) * 1.02f;
    if (mb > 64.0f) attn_mfma_body<true>(c); else attn_mfma_body<false>(c);
}

#define XB_TMO      128
#define XB_XCNT(j)  (256  + 64 * (j))
#define XB_XSUB(j)  (1280 + 64 * (j))
#define XB_XGEN(j)  (2304 + 64 * (j))
#define XB_TOP      3328
#define XB_TOPGEN   3392
#define XCD_BAR_WORDS 3456
#define XB_SPIN_CAP (1u << 18)
#define LAS __attribute__((address_space(3)))
__device__ __forceinline__ unsigned xb_ld(unsigned* p)              { return __hip_atomic_load(p, __ATOMIC_RELAXED, __HIP_MEMORY_SCOPE_AGENT); }
__device__ __forceinline__ unsigned xb_add(unsigned* p, unsigned v) { return __hip_atomic_fetch_add(p, v, __ATOMIC_RELAXED, __HIP_MEMORY_SCOPE_AGENT); }
__device__ __forceinline__ unsigned xb_xcc_id() { return (unsigned)__builtin_amdgcn_s_getreg((3 << 11) | 20) & 0xFu; }
#define XB_SPIN(cond, bar) do { unsigned _sp = 0; while (cond) { __builtin_amdgcn_s_sleep(1); \
    if ((++_sp & 255u) == 0u) { if (xb_ld(&(bar)[XB_TMO])) break; if (_sp > XB_SPIN_CAP) { atomicAdd(&(bar)[XB_TMO], 1u); break; } } } } while (0)
struct XcdBarrier { unsigned* bar; unsigned x; volatile LAS unsigned* st; };
__device__ __forceinline__ XcdBarrier xcd_barrier_post(unsigned* bar, volatile LAS unsigned* st) {
    XcdBarrier b; b.bar = bar; b.x = xb_xcc_id(); b.st = st;
    if (threadIdx.x == 0) (void)xb_add(&bar[XB_XCNT(b.x)], 1u);
    return b;
}
__device__ __forceinline__ void xcd_barrier_complete(unsigned* bar, unsigned x, unsigned& nloc, unsigned& nx) {
    const unsigned G = gridDim.x * gridDim.y * gridDim.z;
    unsigned sum, cnt, mine, sp = 0u;
    for (;;) {
        sum = 0u; cnt = 0u; mine = 0u;
#pragma unroll
        for (unsigned j = 0; j < 16; ++j) { const unsigned c = xb_ld(&bar[XB_XCNT(j)]); sum += c; cnt += (c > 0u) ? 1u : 0u; mine = (j == x) ? c : mine; }
        if (sum == G) break;
        __builtin_amdgcn_s_sleep(1);
        if ((++sp & 255u) == 0u) { if (xb_ld(&bar[XB_TMO])) break; if (sp > XB_SPIN_CAP) { atomicAdd(&bar[XB_TMO], 1u); break; } }
    }
    nloc = mine > 0u ? mine : 1u; nx = cnt > 0u ? cnt : 1u;
}
__device__ __forceinline__ void xcd_barrier(const XcdBarrier& b) {
    asm volatile("s_waitcnt vmcnt(0)" ::: "memory");
    __syncthreads();
    if (threadIdx.x == 0) {
        unsigned* bar = b.bar;
        __builtin_amdgcn_s_waitcnt(0);
        unsigned nloc = b.st[0], nx = b.st[1];
        if (nloc == 0u) { xcd_barrier_complete(bar, b.x, nloc, nx); b.st[0] = nloc; b.st[1] = nx; }
        const unsigned old = xb_add(&bar[XB_XSUB(b.x)], 1u);
        const unsigned gen = old / nloc;
        if (old + 1u == (gen + 1u) * nloc) {
            __builtin_amdgcn_fence(__ATOMIC_RELEASE, "agent");
            asm volatile("s_waitcnt vmcnt(0)" ::: "memory");
            const unsigned og = xb_add(&bar[XB_TOP], 1u);
            const unsigned tg = og / nx;
            if (og + 1u == (tg + 1u) * nx) xb_add(&bar[XB_TOPGEN], 1u);
            else XB_SPIN(xb_ld(&bar[XB_TOPGEN]) == tg, bar);
            __builtin_amdgcn_fence(__ATOMIC_ACQUIRE, "agent");
            xb_add(&bar[XB_XGEN(b.x)], 1u);
            asm volatile("s_waitcnt vmcnt(0)" ::: "memory");
        } else {
            XB_SPIN(xb_ld(&bar[XB_XGEN(b.x)]) == gen, bar);
            __builtin_amdgcn_fence(__ATOMIC_ACQUIRE, "agent");
            asm volatile("s_waitcnt vmcnt(0)" ::: "memory");
        }
    }
    __syncthreads();
}

enum { PH_PREP = 0, PH_NORM1, PH_INPROJ, PH_MIX1, PH_CARRY, PH_MIX3, PH_GLU, PH_MERGE, PH_WOUT, PH_NORM2, PH_FFNUP, PH_FFNDN, PH_COUNT };

__device__ __forceinline__ void run_phase(const int l, const int ph, float* lds, const bool rep = false) {
    KParams* pp = (KParams*)__builtin_amdgcn_kernarg_segment_ptr();
    asm volatile("" : "+s"(pp));
    Ctx c(pp, l, lds);
    switch (ph) {
    case PH_PREP: phase_prep(c); break;
    case PH_NORM1: phase_norm(c, 0); break;
    case PH_INPROJ: { EpiInproj e{c.W<bf16>(WS_Z), c.W<float>(WS_ZA)}; gemm_lin(c.W<bf16>(WS_HN), D, c.W<bf16>(WS_WINT), 0, ROWS, NZP, D, e, lds); } break;
    case PH_MIX1: s5_mfma(c, false); lru_mfma(c, false); gla_mfma(c, false); break;
    case PH_CARRY: phase_carry(c);
        if (blockIdx.x >= 40) { if (!rep) da_prep(c, (int)blockIdx.x - 40, (int)gridDim.x - 40); v_transpose(c, (int)blockIdx.x - 40, (int)gridDim.x - 40); } break;
    #ifndef PROBE_SUB
#define PROBE_SUB 15
#endif
    case PH_MIX3: if (!rep || (PROBE_SUB & 1)) attn_mfma(c); if (!rep || (PROBE_SUB & 2)) s5_mfma(c, true); if (!rep || (PROBE_SUB & 4)) lru_mfma(c, true); if (!rep || (PROBE_SUB & 8)) gla_mfma(c, true); break;
    case PH_GLU: { EpiGlu e{c.W<bf16>(WS_YS5), c.W<bf16>(WS_Y)}; const int r0 = c.row_begin(); gemm_lin(c.W<bf16>(WS_YS5), 256, c.W<bf16>(WS_WGLUT), r0, ROWS - r0, 256, 256, e, lds);
        if (c.l != DEPTH - 1) phase_merge_pg(c, 2); } break;
    case PH_MERGE: phase_merge_pg(c, c.l == DEPTH - 1 ? 0 : 1); break;
    case PH_WOUT: { const EpiResid e = make_resid(c, 2 * D, true);
        if (c.l == 0) gemm_res_l0(c.W<bf16>(WS_MERGED), D, c.W<bf16>(WS_WOUTT), D, 4, e, c.W<float>(WS_SLABW), lds);
        else gemm_lin(c.W<bf16>(WS_MERGED), D, c.W<bf16>(WS_WOUTT), CTX, ROWS - CTX, D, D, e, lds); } break;
    case PH_NORM2: phase_norm(c, 1); break;
    case PH_FFNUP: phase_ffn_up_pg(c); break;
    case PH_FFNDN: { const EpiResid e = make_resid(c, 5 * D, false);
        if (c.l == 0) gemm_res_l0(c.W<bf16>(WS_Z), DFF, c.W<bf16>(WS_WDNT), DFF, 11, e, c.W<float>(WS_SLABF), lds);
        else gemm_lin(c.W<bf16>(WS_Z), DFF, c.W<bf16>(WS_WDNT), CTX, ROWS - CTX, D, DFF, e, lds); } break;
    default: break;
    }
}

__global__ void __launch_bounds__(NT) k_mega(Params p) {
    extern __shared__ __attribute__((aligned(16))) float lds[];
    cooperative_groups::grid_group grid = cooperative_groups::this_grid();
    volatile LAS unsigned* st = (volatile LAS unsigned*)((LAS unsigned char*)lds + LDS_TOTAL - 16);
    if (threadIdx.x == 0) { st[0] = 0u; st[1] = 0u; st[2] = 0u; st[3] = 0u; }
    __syncthreads();
    const XcdBarrier bar = xcd_barrier_post((unsigned*)(p.ws + WS_CTL), st);
#ifndef PROBE_PH
#define PROBE_PH -1
#endif
#define PHASE(l, ph) do { run_phase(l, ph, lds); xcd_barrier(bar); if (PROBE_PH == (ph)) { run_phase(l, ph, lds, true); xcd_barrier(bar); } } while (0)
#define LAYER(l) PHASE(l, PH_NORM1); PHASE(l, PH_INPROJ); PHASE(l, PH_MIX1); PHASE(l, PH_CARRY); PHASE(l, PH_MIX3); PHASE(l, PH_GLU); \
    PHASE(l, PH_MERGE); PHASE(l, PH_WOUT); PHASE(l, PH_NORM2); PHASE(l, PH_FFNUP)
    run_phase(0, PH_PREP, lds);
    asm volatile("s_waitcnt vmcnt(0)" ::: "memory"); __syncthreads();
    if (threadIdx.x == 0) __builtin_amdgcn_fence(__ATOMIC_RELEASE, "agent");
    grid.sync();
    if (threadIdx.x == 0) __builtin_amdgcn_fence(__ATOMIC_ACQUIRE, "agent");
    __syncthreads();
    LAYER(0); PHASE(0, PH_FFNDN);
    run_phase(1, PH_PREP, lds); LAYER(1); run_phase(1, PH_FFNDN, lds);
#undef LAYER
#undef PHASE
}


extern "C" void kernel_launch(void* const* d_in, const int* in_sizes, int n_in, void* d_out, int out_size, void* d_ws, size_t ws_size, hipStream_t stream) {
    static int grid_blocks = 0;
    if (!grid_blocks) {
        if (n_in != N_IN || ws_size < WS_END) { fprintf(stderr, "kernel_launch: unexpected n_in %d or ws_size %zu (need %zu)\n", n_in, ws_size, (size_t)WS_END); grid_blocks = -1; return; }
        if (hipFuncSetAttribute((const void*)k_mega, hipFuncAttributeMaxDynamicSharedMemorySize, LDS_BYTES) != hipSuccess) { fprintf(stderr, "kernel_launch: hipFuncSetAttribute failed\n"); grid_blocks = -1; return; }
        int dev = 0, cus = 0, per_cu = 0;
        hipGetDevice(&dev);
        hipDeviceGetAttribute(&cus, hipDeviceAttributeMultiprocessorCount, dev);
        if (hipOccupancyMaxActiveBlocksPerMultiprocessor(&per_cu, (const void*)k_mega, NT, LDS_BYTES) != hipSuccess || per_cu < 1) { fprintf(stderr, "kernel_launch: occupancy query failed (%d)\n", per_cu); grid_blocks = -1; return; }
        grid_blocks = cus;
    }
    if (grid_blocks < 0) return;
    Params p{};
    for (int i = 0; i < N_IN; ++i) p.in[i] = (const float*)d_in[i];
    p.out = (float*)d_out; p.ws = (unsigned char*)d_ws;
    if (hipMemsetAsync((char*)d_ws + WS_CTL, 0, XCD_BAR_WORDS * 4, stream) != hipSuccess) { fprintf(stderr, "kernel_launch: memset of the barrier words failed\n"); return; }
    void* args[] = {&p};
    hipError_t e = hipLaunchCooperativeKernel((const void*)k_mega, dim3(grid_blocks), dim3(NT), args, LDS_BYTES, stream);
    if (e != hipSuccess) fprintf(stderr, "cooperative launch failed: %s (grid %d)\n", hipGetErrorString(e), grid_blocks);
}
```

```cpp
#include <hip/hip_runtime.h>
#include <hip/hip_cooperative_groups.h>
#include <cstdio>
#include <cstdint>

typedef unsigned short bf16;
typedef float f32x4 __attribute__((ext_vector_type(4)));
typedef unsigned u32x4 __attribute__((ext_vector_type(4)));
typedef unsigned u32x2 __attribute__((ext_vector_type(2)));
typedef short bf16x8 __attribute__((ext_vector_type(8)));
typedef float f32x16 __attribute__((ext_vector_type(16)));
typedef float f32x8 __attribute__((ext_vector_type(8)));
typedef __bf16 bf16v8 __attribute__((ext_vector_type(8)));
#define MFMA32(a, b, c) __builtin_amdgcn_mfma_f32_32x32x16_bf16((a), (b), (c), 0, 0, 0)

constexpr int D = 1024, SEQ = 16384, CTX = 256, ROWS = SEQ + CTX, DEPTH = 2;
constexpr int IN_TOTAL = 6432, NZ = 2304, NZP = 2560, GATE0 = 2336, DFF = 2816;
constexpr int NCHUNK = ROWS / 64;
constexpr int NT = 512;
constexpr int ZC_SSM = 0, ZC_LRUX = 256, ZC_LRUY = 512, ZC_DAQ = 768, ZC_DAK = 1024, ZC_DAV = 1280, ZC_GQ = 1536, ZC_GK = 1664, ZC_GV = 1792, ZC_GG = 2048;

enum { I_X = 0, I_C, I_CTX, I_CCTX, I_WADA, I_BADA, I_N1G, I_N2G, I_WIN, I_SLRE, I_SLIM, I_SLOG, I_SBRE, I_SBIM, I_SCRE, I_SCIM, I_SD, I_SWGLU,
       I_LCW, I_LCB, I_LWR, I_LBR, I_LWI, I_LBI, I_LLAM, I_DQN, I_DKN, I_DLAM, I_DON, I_GWA2, I_GBA, I_GON, I_WBR, I_WOUT, I_WUP, I_FCW, I_FCB, I_WDN, N_IN };

constexpr size_t al256(size_t x) { return (x + 255) & ~(size_t)255; }
constexpr size_t WS_CTL = 0;
constexpr size_t WS_ROPE = 32768;
constexpr size_t WS_MODS = 65536;
constexpr size_t WS_S5LB = WS_MODS + al256((size_t)2 * 2 * 6144 * 4);
constexpr size_t WS_S5BB = WS_S5LB + al256((size_t)4096 * 2 * 4);
constexpr size_t WS_HCTX = WS_S5BB + al256((size_t)4096 * 32 * 4);
constexpr size_t WS_WINT = WS_HCTX + al256((size_t)CTX * D * 4);
constexpr size_t WS_WGT = WS_WINT + al256((size_t)NZP * D * 2);
constexpr size_t WS_WBRT = WS_WGT + al256((size_t)4096 * D * 2);
constexpr size_t WS_WOUTT = WS_WBRT + al256((size_t)4 * D * 256 * 2);
constexpr size_t WS_WUPT = WS_WOUTT + al256((size_t)D * D * 2);
constexpr size_t WS_WDNT = WS_WUPT + al256((size_t)2 * DFF * D * 2);
constexpr size_t WS_WGLUT = WS_WDNT + al256((size_t)D * DFF * 2);
constexpr size_t WS_HN = WS_WGLUT + al256((size_t)256 * 256 * 2);
constexpr size_t WS_Z = WS_HN + al256((size_t)(ROWS + 256) * D * 2);
constexpr size_t WS_ZA = WS_Z + al256((size_t)ROWS * DFF * 2);
constexpr size_t WS_Y = WS_ZA + al256((size_t)ROWS * 32 * 4);
constexpr size_t WS_YS5 = WS_Y + al256((size_t)ROWS * D * 2);
constexpr size_t WS_S5END = WS_YS5 + al256((size_t)ROWS * 256 * 2);
constexpr size_t WS_S5START = WS_S5END + al256((size_t)NCHUNK * 2 * 16 * 64 * 2 * 4);
constexpr size_t WS_LRUEND = WS_S5START + al256((size_t)NCHUNK * 2 * 16 * 64 * 2 * 4);
constexpr size_t WS_LRUSTART = WS_LRUEND + al256((size_t)NCHUNK * 2 * 256 * 2 * 4);
constexpr size_t WS_GLAKV = WS_LRUSTART + al256((size_t)NCHUNK * 2 * 256 * 4);
constexpr size_t WS_GLAS0 = WS_GLAKV + al256((size_t)NCHUNK * 2 * 4 * 32 * 64 * 4);
constexpr size_t WS_GLADEC = WS_GLAS0 + al256((size_t)NCHUNK * 2 * 4 * 32 * 64 * 4);
constexpr size_t WS_VT = WS_GLADEC + al256((size_t)NCHUNK * 2 * 4 * 32 * 4);
constexpr size_t WS_END = WS_VT + al256((size_t)256 * ROWS * 2);
constexpr size_t WS_SLABW = WS_Z + (size_t)48 * 1024 * 1024;
constexpr size_t WS_SLABF = WS_Y;
static_assert(WS_END <= (size_t)256 * 1024 * 1024, "workspace map exceeds 256 MiB");

constexpr int LDS_TOTAL = 144 * 1024;
constexpr int LDS_BYTES = LDS_TOTAL;
struct Params { const float* in[N_IN]; float* out; unsigned char* ws; int phase; int layer; };

__device__ __forceinline__ int tidx() { int t = threadIdx.x; asm volatile("" : "+v"(t)); return t; }
__device__ __forceinline__ float bf2f(bf16 b) { return __uint_as_float(((unsigned)b) << 16); }
__device__ __forceinline__ bf16 f2bf(float f) { unsigned u = __float_as_uint(f); u += 0x7FFFu + ((u >> 16) & 1u); return (bf16)(u >> 16); }
typedef __bf16 bf16v2 __attribute__((ext_vector_type(2)));
typedef float f32x2 __attribute__((ext_vector_type(2)));
__device__ __forceinline__ unsigned pack2(float lo, float hi) { return __builtin_bit_cast(unsigned, __builtin_convertvector((f32x2){lo, hi}, bf16v2)); }
__device__ __forceinline__ float lo2f(unsigned w) { return __uint_as_float(w << 16); }
__device__ __forceinline__ float hi2f(unsigned w) { return __uint_as_float(w & 0xFFFF0000u); }
__device__ __forceinline__ float sigmoidf_(float x) { return __builtin_amdgcn_rcpf(1.0f + __expf(-x)); }
__device__ __forceinline__ float siluf_(float x) { return x * sigmoidf_(x); }
__device__ __forceinline__ float gelu_tanh(float x) { const float u = 0.7978845608028654f * (x + 0.044715f * x * x * x); return x * sigmoidf_(2.0f * u); }
__device__ __forceinline__ float logsigmoidf_(float x) { return x >= 0.f ? -log1pf(expf(-x)) : x - log1pf(expf(x)); }
__device__ __forceinline__ int rot_bid(int k) { return (int)((blockIdx.x + gridDim.x - k) % gridDim.x); }
__device__ __forceinline__ int chunk_of(int s, int d) { return d == 0 ? s : (s < 4 ? 3 - s : 263 - s); }
__device__ __forceinline__ float lam_init_of(int l) { return 0.8f - 0.6f * expf(-0.3f * (float)l); }

typedef const __attribute__((address_space(4))) Params KParams;
struct Ctx {
    const KParams* pp; int l; unsigned char* ws; float* lds; float* out;
    __device__ Ctx(const KParams* p_, int l_, float* lds_) : pp(p_), l(l_), ws(p_->ws), lds(lds_), out(p_->out) {}
    template <class T> __device__ __forceinline__ T* W(size_t off) const { return (T*)(ws + off); }
    __device__ __forceinline__ const float* in(int i) const { return pp->in[i]; }
    __device__ __forceinline__ const float* xin_row(int row) const {
        if (l == 0) return row < CTX ? pp->in[I_CTX] + (size_t)row * D : pp->in[I_X] + (size_t)(row - CTX) * D;
        return row < CTX ? W<float>(WS_HCTX) + (size_t)row * D : out + (size_t)(row - CTX) * D; }
    __device__ __forceinline__ float* xout_row(int row) const { return row < CTX ? W<float>(WS_HCTX) + (size_t)row * D : out + (size_t)(row - CTX) * D; }
    __device__ __forceinline__ const float* mods(int row) const { return W<float>(WS_MODS) + ((size_t)l * 2 + (row < CTX ? 1 : 0)) * 6144; }
    __device__ __forceinline__ int row_begin() const { return l == DEPTH - 1 ? CTX : 0; }
};

struct ConvDesc { const float* src; bf16* dst; int ld, col0, nvalid, K, drow0, k0; };
__device__ __forceinline__ ConvDesc conv_decode(const Ctx& c, int ti) {
    const int l = c.l; ConvDesc d;
    constexpr int T0 = 640, T1 = T0 + 1024, T2 = T1 + 256, T3 = T2 + 256, T4 = T3 + 1408, T5 = T4 + 704;
    if (ti < T0) { const int jt = ti >> 4, kt = ti & 15; int nv = GATE0 - jt * 64; nv = nv < 0 ? 0 : (nv > 64 ? 64 : nv);
        d = ConvDesc{c.in(I_WIN) + (size_t)l * D * IN_TOTAL, c.W<bf16>(WS_WINT), IN_TOTAL, jt * 64, nv, D, jt * 64, kt * 64}; }
    else if (ti < T1) { const int u = ti - T0, jt = u >> 4, kt = u & 15;
        d = ConvDesc{c.in(I_WIN) + (size_t)l * D * IN_TOTAL, c.W<bf16>(WS_WGT), IN_TOTAL, GATE0 + jt * 64, 64, D, jt * 64, kt * 64}; }
    else if (ti < T2) { const int u = ti - T1, n = u >> 6, jt = (u >> 2) & 15, kt = u & 3;
        d = ConvDesc{c.in(I_WBR) + ((size_t)l * 4 + n) * 256 * D, c.W<bf16>(WS_WBRT) + (size_t)n * D * 256, D, jt * 64, 64, 256, jt * 64, kt * 64}; }
    else if (ti < T3) { const int u = ti - T2, jt = u >> 4, kt = u & 15;
        d = ConvDesc{c.in(I_WOUT) + (size_t)l * D * D, c.W<bf16>(WS_WOUTT), D, jt * 64, 64, D, jt * 64, kt * 64}; }
    else if (ti < T4) { const int u = ti - T3, jt = u >> 4, kt = u & 15; const int r0 = jt * 64, pn = r0 >> 8, bj = (r0 >> 7) & 1, cc = r0 & 127;
        d = ConvDesc{c.in(I_WUP) + (size_t)l * D * 2 * DFF, c.W<bf16>(WS_WUPT), 2 * DFF, bj * DFF + 128 * pn + cc, 64, D, r0, kt * 64}; }
    else if (ti < T5) { const int u = ti - T4, jt = u / 44, kt = u % 44;
        d = ConvDesc{c.in(I_WDN) + (size_t)l * DFF * D, c.W<bf16>(WS_WDNT), D, jt * 64, 64, DFF, jt * 64, kt * 64}; }
    else { const int u = ti - T5, jt = u >> 2, kt = u & 3;
        d = ConvDesc{c.in(I_SWGLU) + (size_t)l * 256 * 256, c.W<bf16>(WS_WGLUT), 256, jt * 64, 64, 256, jt * 64, kt * 64}; }
    return d;
}
__device__ __forceinline__ void phase_prep(const Ctx& c) {
    const int l = c.l, t = tidx();
    constexpr int T6 = 640 + 1024 + 256 + 256 + 1408 + 704 + 16;
    { int ti = blockIdx.x; float v[8]; ConvDesc d;
      if (ti < T6) { d = conv_decode(c, ti);
#pragma unroll
          for (int q = 0; q < 8; ++q) { const int i = t + q * NT, kk = i >> 6, j = i & 63; v[q] = (j < d.nvalid) ? d.src[(size_t)(d.k0 + kk) * d.ld + d.col0 + j] : 0.f; } }
      while (ti < T6) {
          const int nti = ti + gridDim.x; float nv[8]; ConvDesc nd = d;
          if (nti < T6) { nd = conv_decode(c, nti);
#pragma unroll
              for (int q = 0; q < 8; ++q) { const int i = t + q * NT, kk = i >> 6, j = i & 63; nv[q] = (j < nd.nvalid) ? nd.src[(size_t)(nd.k0 + kk) * nd.ld + nd.col0 + j] : 0.f; } }
          else {
#pragma unroll
              for (int q = 0; q < 8; ++q) nv[q] = 0.f; }
          __syncthreads();
#pragma unroll
          for (int q = 0; q < 8; ++q) { const int i = t + q * NT; c.lds[(i >> 6) * 65 + (i & 63)] = v[q]; }
          __syncthreads();
          { const int j = t >> 3, kq = t & 7;
            const int js = (j & 32) | (((j >> 2) & 3) << 3) | (((j >> 4) & 1) << 2) | (j & 3);
            const float* lp = c.lds + (kq * 8) * 65 + js; u32x4 w;
            w.x = pack2(lp[0], lp[65]); w.y = pack2(lp[130], lp[195]); w.z = pack2(lp[260], lp[325]); w.w = pack2(lp[390], lp[455]);
            *(u32x4*)(d.dst + (size_t)(d.drow0 + j) * d.K + d.k0 + kq * 8) = w; }
          d = nd; ti = nti;
#pragma unroll
          for (int q = 0; q < 8; ++q) v[q] = nv[q];
      } }
    __syncthreads();
    if (l != 0) return;
    for (int task = blockIdx.x; task < 192; task += gridDim.x) {
        const int ll = task / 96, cb = task % 96, t = tidx(), kq = t >> 6, j = t & 63;
        const float* w = c.in(I_WADA) + (size_t)ll * D * 6144 + cb * 64 + j;
        float a0 = 0.f, a1 = 0.f;
#pragma unroll 16
        for (int k = kq * 128; k < kq * 128 + 128; ++k) { const float wv = w[(size_t)k * 6144]; a0 += siluf_(c.in(I_C)[k]) * wv; a1 += siluf_(c.in(I_CCTX)[k]) * wv; }
        c.lds[t] = a0; c.lds[512 + t] = a1;
        __syncthreads();
        if (t < 128) { const int s = t >> 6, jj = t & 63; float v = 0.f; for (int q = 0; q < 8; ++q) v += c.lds[s * 512 + q * 64 + jj];
            c.W<float>(WS_MODS)[((size_t)ll * 2 + s) * 6144 + cb * 64 + jj] = v + c.in(I_BADA)[(size_t)ll * 6144 + cb * 64 + jj]; }
        __syncthreads();
    }
    for (int i = blockIdx.x * NT + tidx(); i < 2048; i += gridDim.x * NT) { const int pos = i >> 3, e = i & 7; const float ang = (float)pos * (1.0f / powf(10000.0f, (float)(2 * e) / 16.0f));
        c.W<float>(WS_ROPE)[i * 2] = cosf(ang); c.W<float>(WS_ROPE)[i * 2 + 1] = sinf(ang); }
    for (int i = blockIdx.x * NT + tidx(); i < 4096; i += gridDim.x * NT) {
        const int g = (i >> 6) & 15;
        const float lre = c.in(I_SLRE)[i], lim = c.in(I_SLIM)[i], dt = expf(c.in(I_SLOG)[(i >> 6)]);
        (void)g;
        const float mag = expf(lre * dt), lbr = mag * cosf(lim * dt), lbi = mag * sinf(lim * dt);
        const float nr = lbr - 1.0f, ni = lbi, den = lre * lre + lim * lim;
        const float kr = (nr * lre + ni * lim) / den, ki = (ni * lre - nr * lim) / den;
        c.W<float>(WS_S5LB)[i * 2] = lbr; c.W<float>(WS_S5LB)[i * 2 + 1] = lbi;
        for (int cc = 0; cc < 16; ++cc) { const float br = c.in(I_SBRE)[(size_t)i * 16 + cc], bi = c.in(I_SBIM)[(size_t)i * 16 + cc];
            c.W<float>(WS_S5BB)[(size_t)i * 32 + cc] = kr * br - ki * bi; c.W<float>(WS_S5BB)[(size_t)i * 32 + 16 + cc] = kr * bi + ki * br; }
    }
}

__device__ __forceinline__ u32x4 pack8(f32x4 a, f32x4 b) { u32x4 w; w.x = pack2(a.x, a.y); w.y = pack2(a.z, a.w); w.z = pack2(b.x, b.y); w.w = pack2(b.z, b.w); return w; }
__device__ __forceinline__ void phase_norm(const Ctx& c, int which) {
    const int wave = tidx() >> 6, lane = tidx() & 63;
    const float* g = c.in(which == 0 ? I_N1G : I_N2G) + (size_t)c.l * D;
    const int r0 = which == 0 ? 0 : c.row_begin();
    for (int row = r0 + blockIdx.x * 8 + wave; row < ROWS; row += gridDim.x * 8) {
        const float* x = which == 0 ? c.xin_row(row) : c.xout_row(row);
        const float* m = c.mods(row) + (which == 0 ? 0 : 3 * D);
        f32x4 v[4]; float ss = 0.f;
        const int nsl = (row >= CTX) ? 0 : ((c.l == 0 && which == 1) ? 4 : ((c.l == 1 && which == 0) ? 11 : 0));
        if (nsl) { const float* slab = (c.l == 0) ? c.W<float>(WS_SLABW) : c.W<float>(WS_SLABF); const float* gate = c.W<float>(WS_MODS) + 6144 + (c.l == 0 ? 2 : 5) * D;
            const float* xb = (c.l == 0) ? c.in(I_CTX) + (size_t)row * D : c.W<float>(WS_HCTX) + (size_t)row * D;
#pragma unroll
            for (int i = 0; i < 4; ++i) { const int col = (i >> 1) * 512 + lane * 8 + (i & 1) * 4; f32x4 a = (f32x4){0.f, 0.f, 0.f, 0.f};
                for (int k = 0; k < nsl; ++k) a += *(const f32x4*)(slab + ((size_t)k * CTX + row) * D + col);
                v[i] = *(const f32x4*)(xb + col) + *(const f32x4*)(gate + col) * a;
                if (c.l == 0) *(f32x4*)(c.W<float>(WS_HCTX) + (size_t)row * D + col) = v[i];
                ss += v[i].x * v[i].x + v[i].y * v[i].y + v[i].z * v[i].z + v[i].w * v[i].w; } }
        else {
#pragma unroll
            for (int i = 0; i < 4; ++i) { v[i] = *(const f32x4*)(x + (i >> 1) * 512 + lane * 8 + (i & 1) * 4); ss += v[i].x * v[i].x + v[i].y * v[i].y + v[i].z * v[i].z + v[i].w * v[i].w; } }
#pragma unroll
        for (int o = 32; o >= 1; o >>= 1) ss += __shfl_xor(ss, o);
        const float rstd = rsqrtf(ss * (1.0f / D) + 1e-6f);
        bf16* o = c.W<bf16>(WS_HN) + (size_t)row * D;
#pragma unroll
        for (int h = 0; h < 2; ++h) { f32x4 y[2];
#pragma unroll
            for (int e = 0; e < 2; ++e) { const int col = h * 512 + lane * 8 + e * 4; const f32x4 gg = *(const f32x4*)(g + col), sh = *(const f32x4*)(m + col), sc = *(const f32x4*)(m + D + col);
                y[e] = (v[h * 2 + e] * rstd * gg) * (1.0f + sc) + sh; }
            *(u32x4*)(o + h * 512 + lane * 8) = pack8(y[0], y[1]); }
    }
}

__device__ __forceinline__ u32x2 pack4(f32x4 v) { u32x2 w; w.x = pack2(v.x, v.y); w.y = pack2(v.z, v.w); return w; }
struct EpiInproj { static constexpr bool BATCH4 = false; bf16* z; float* za;
    __device__ __forceinline__ void store_row(int row, int col0, f32x4 v00, f32x4 v01, f32x4 v10, f32x4 v11) const {
        if (col0 < NZ) { bf16* p = z + (size_t)row * NZ + col0; *(u32x4*)p = pack8(v00, v01); *(u32x4*)(p + 128) = pack8(v10, v11); }
        else if (col0 < NZ + 32) { float* p = za + (size_t)row * 32 + (col0 - NZ); *(f32x4*)p = v00; *(f32x4*)(p + 4) = v01; } } };
struct EpiGlu { static constexpr bool BATCH4 = false; const bf16* ys5; bf16* y;
    __device__ __forceinline__ u32x4 one(const bf16* pz, f32x4 v, f32x4 u) const { const u32x4 zz = *(const u32x4*)pz; f32x4 o, q;
        o.x = lo2f(zz.x) * sigmoidf_(v.x); o.y = hi2f(zz.x) * sigmoidf_(v.y); o.z = lo2f(zz.y) * sigmoidf_(v.z); o.w = hi2f(zz.y) * sigmoidf_(v.w);
        q.x = lo2f(zz.z) * sigmoidf_(u.x); q.y = hi2f(zz.z) * sigmoidf_(u.y); q.z = lo2f(zz.w) * sigmoidf_(u.z); q.w = hi2f(zz.w) * sigmoidf_(u.w); return pack8(o, q); }
    __device__ __forceinline__ void store_row(int row, int col0, f32x4 v00, f32x4 v01, f32x4 v10, f32x4 v11) const {
        const bf16* pz = ys5 + (size_t)row * 256 + col0; bf16* py = y + (size_t)row * D + col0;
        *(u32x4*)py = one(pz, v00, v01); *(u32x4*)(py + 128) = one(pz + 128, v10, v11); } };
struct EpiResid { static constexpr bool BATCH4 = true; const float* xs_ctx; const float* xs_lat; float* xo_ctx; float* xo_lat; const float* g_ctx; const float* g_lat;
    __device__ __forceinline__ void store_rows4(int row, int col0, const f32x4 (&a)[2][4][2]) const {
        const bool ic = row < CTX; const size_t off = (size_t)(ic ? row : row - CTX) * D + col0;
        const float* xs = (ic ? xs_ctx : xs_lat) + off; float* xo = (ic ? xo_ctx : xo_lat) + off; const float* g = (ic ? g_ctx : g_lat) + col0;
        f32x4 xv[4][2][2];
#pragma unroll
        for (int m = 0; m < 4; ++m)
#pragma unroll
            for (int bj = 0; bj < 2; ++bj)
#pragma unroll
                for (int n = 0; n < 2; ++n) xv[m][bj][n] = *(const f32x4*)(xs + (size_t)m * 16 * D + bj * 128 + n * 4);
#pragma unroll
        for (int bj = 0; bj < 2; ++bj)
#pragma unroll
            for (int n = 0; n < 2; ++n) { const f32x4 gg = *(const f32x4*)(g + bj * 128 + n * 4);
#pragma unroll
                for (int m = 0; m < 4; ++m) *(f32x4*)(xo + (size_t)m * 16 * D + bj * 128 + n * 4) = xv[m][bj][n] + gg * a[bj][m][n]; } }
    __device__ __forceinline__ void store_row(int row, int col0, f32x4 v00, f32x4 v01, f32x4 v10, f32x4 v11) const {
        const bool ic = row < CTX; const size_t off = (size_t)(ic ? row : row - CTX) * D + col0;
        const float* xs = (ic ? xs_ctx : xs_lat) + off; float* xo = (ic ? xo_ctx : xo_lat) + off; const float* g = (ic ? g_ctx : g_lat) + col0;
        *(f32x4*)xo = *(const f32x4*)xs + *(const f32x4*)g * v00; *(f32x4*)(xo + 4) = *(const f32x4*)(xs + 4) + *(const f32x4*)(g + 4) * v01;
        *(f32x4*)(xo + 128) = *(const f32x4*)(xs + 128) + *(const f32x4*)(g + 128) * v10; *(f32x4*)(xo + 132) = *(const f32x4*)(xs + 132) + *(const f32x4*)(g + 132) * v11; } };
__device__ __forceinline__ EpiResid make_resid(const Ctx& c, int gate_off, bool from_in) {
    EpiResid e; float* hc = c.W<float>(WS_HCTX);
    e.xs_ctx = (from_in && c.l == 0) ? c.in(I_CTX) : hc; e.xs_lat = (from_in && c.l == 0) ? c.in(I_X) : c.out;
    e.xo_ctx = hc; e.xo_lat = c.out;
    e.g_ctx = c.W<float>(WS_MODS) + ((size_t)c.l * 2 + 1) * 6144 + gate_off; e.g_lat = c.W<float>(WS_MODS) + ((size_t)c.l * 2) * 6144 + gate_off; return e; }

namespace pg8 {
#define PG8_LAS __attribute__((address_space(3)))
constexpr int BM = 256, BK = 64, HALF = 128, HTB = HALF * BK * 2, STAGE_BYTES = 8 * HTB, NXCD = 8, WGM = 8;
__device__ __forceinline__ int lds_byte(int r, int c) { const int st = (r >> 4) * 2 + (c >> 5), rr = r & 15, cc = c & 31, ob = rr * 64 + cc * 2; return st * 1024 + (ob ^ (((ob >> 9) & 1) << 5)); }
__device__ __forceinline__ void stage_rc(int b, int& R, int& C) { const int st = b / 1024, sb = b % 1024, swz = sb ^ (((sb >> 9) & 1) << 5); R = (st >> 1) * 16 + swz / 64; C = (st & 1) * 32 + (swz % 64) / 2; }
struct Unit { int pm, pn; };
__device__ __forceinline__ bool static_next(int i, int G, int c, int nM, int nN, Unit& u) {
    const int nwg = nM * nN; const long L = (long)i * G + c; if (L >= nwg) return false;
    int wgid = (int)L; { const int q = nwg / NXCD, r = nwg % NXCD, xcd = wgid % NXCD, off = wgid / NXCD; wgid = (xcd < r ? xcd * (q + 1) : r * (q + 1) + (xcd - r) * q) + off; }
    const int nig = WGM * nN, gid = wgid / nig, fm = gid * WGM, gsz = (nM - fm) < WGM ? (nM - fm) : WGM;
    u.pm = fm + ((wgid % nig) % gsz); u.pn = (wgid % nig) / gsz; return true;
}
template <class Epi, class Sched>
__device__ __forceinline__ void gemm_phase(PG8_LAS unsigned char* lds, const int K, const Sched& S, const Epi& E) {
    const int tid = tidx(), wid = __builtin_amdgcn_readfirstlane(tid >> 6), lane = tid & 63, wr = wid >> 2, wc = wid & 3, fr = lane & 15, fq = lane >> 4;
    int sR[2], sC[2];
#pragma unroll
    for (int i = 0; i < 2; ++i) { int R, C; stage_rc(tid * 16 + i * 8192, R, C); sR[i] = R; sC[i] = C; }
    const size_t kstep = (size_t)(BK * 2);
    const unsigned ldsw = (unsigned)wid * 1024u;
    const int aoff = lds_byte(wr * 64 + fr, fq * 8), boff = lds_byte(wc * 32 + fr, fq * 8);
#define PG8_SA(b, h) (((b) * 2 + (h)) * HTB)
#define PG8_SB(b, h) ((4 + (b) * 2 + (h)) * HTB)
#define PG8_STAGE(bufoff, gbase, voff) do { _Pragma("unroll") for (int _i = 0; _i < 2; ++_i) \
        __builtin_amdgcn_global_load_lds((const unsigned*)((const char*)(gbase) + (voff)[_i]), (PG8_LAS unsigned*)(lds + (bufoff) + ldsw + _i * 8192), 16, 0, 0); } while (0)
#define PG8_LDA(dst, b, h) do { _Pragma("unroll") for (int m = 0; m < 4; ++m) _Pragma("unroll") for (int k = 0; k < 2; ++k) dst[m][k] = *(const PG8_LAS bf16x8*)(lds + PG8_SA(b, h) + aoff + m * 2048 + k * 1024); } while (0)
#define PG8_LDB(dst, b, h) do { _Pragma("unroll") for (int n = 0; n < 2; ++n) _Pragma("unroll") for (int k = 0; k < 2; ++k) dst[n][k] = *(const PG8_LAS bf16x8*)(lds + PG8_SB(b, h) + boff + n * 2048 + k * 1024); } while (0)
#define PG8_MMA(ai, bj, At, Bt) do { __builtin_amdgcn_s_setprio(1); _Pragma("unroll") for (int m = 0; m < 4; ++m) _Pragma("unroll") for (int n = 0; n < 2; ++n) _Pragma("unroll") for (int k = 0; k < 2; ++k) \
        acc[ai][bj][m][n] = __builtin_amdgcn_mfma_f32_16x16x32_bf16(Bt[n][k], At[m][k], acc[ai][bj][m][n], 0, 0, 0); __builtin_amdgcn_s_setprio(0); } while (0)
#define PG8_WAIT_V(n) asm volatile("s_waitcnt vmcnt(" #n ")" ::: "memory")
#define PG8_WAIT_L(n) asm volatile("s_waitcnt lgkmcnt(" #n ")" ::: "memory")
#define PG8_BAR __builtin_amdgcn_s_barrier()
#define PG8_SCHED __builtin_amdgcn_sched_barrier(0)
    Unit cur, nxt; int ui = 0;
    if (!S.next(0, cur)) return;
    int Kc = Sched::HETERO ? S.Kof(cur) : K, nt = Kc / BK; const int ldb0 = Sched::HETERO ? S.ldbof(cur) : K;
    unsigned voffB[2], voffBn[2]; size_t hstepB = (size_t)HALF * ldb0 * 2, hstepBn = hstepB;
#pragma unroll
    for (int i = 0; i < 2; ++i) { voffB[i] = (unsigned)(sR[i] * ldb0 + sC[i]) * 2u; voffBn[i] = voffB[i]; }
    f32x4 acc[2][2][4][2];
#pragma unroll
    for (int a = 0; a < 2; ++a)
#pragma unroll
        for (int b = 0; b < 2; ++b)
#pragma unroll
            for (int m = 0; m < 4; ++m)
#pragma unroll
                for (int n = 0; n < 2; ++n) acc[a][b][m][n] = (f32x4){0.f, 0.f, 0.f, 0.f};
    bf16x8 At[4][2], B0[2][2], B1[2][2];
    unsigned oc0[2], oc1[2], on0[2], on1[2];
#pragma unroll
    for (int i = 0; i < 2; ++i) { oc0[i] = S.aoff(cur, 0, sR[i], sC[i]); oc1[i] = S.aoff(cur, 1, sR[i], sC[i]); }
    const char* cA = S.abase(cur); const char* cB = S.bbase(cur);
    PG8_STAGE(PG8_SB(0, 0), cB, voffB); PG8_STAGE(PG8_SB(0, 1), cB + hstepB, voffB); PG8_STAGE(PG8_SA(0, 0), cA, oc0); PG8_STAGE(PG8_SA(0, 1), cA, oc1);
    if (wr == 1) PG8_BAR;
    PG8_WAIT_V(2); PG8_BAR;
    PG8_STAGE(PG8_SB(1, 0), cB + kstep, voffB); PG8_STAGE(PG8_SA(1, 0), cA + kstep, oc0); PG8_STAGE(PG8_SB(1, 1), cB + hstepB + kstep, voffB);
    PG8_WAIT_V(6); PG8_BAR;
    for (;;) {
        const bool has_next = S.next(ui + 1, nxt);
        const char* nA = has_next ? S.abase(nxt) : cA; const char* nB = has_next ? S.bbase(nxt) : cB;
        int Kn = Kc;
        if (Sched::HETERO) { Kn = has_next ? S.Kof(nxt) : Kc; const int ldbn = has_next ? S.ldbof(nxt) : (int)(hstepB / (HALF * 2)); hstepBn = (size_t)HALF * ldbn * 2;
#pragma unroll
            for (int i = 0; i < 2; ++i) voffBn[i] = (unsigned)(sR[i] * ldbn + sC[i]) * 2u; }
#pragma unroll
        for (int i = 0; i < 2; ++i) { if (Sched::AMAP) { on0[i] = has_next ? S.aoff(nxt, 0, sR[i], sC[i]) : oc0[i]; on1[i] = has_next ? S.aoff(nxt, 1, sR[i], sC[i]) : oc1[i]; } else { on0[i] = oc0[i]; on1[i] = oc1[i]; } }
        for (int t = 0; t < nt; t += 2) {
            const bool last = (t == nt - 2);
            const char* a1 = cA + (size_t)(t + 1) * kstep;
            const char* a2 = last ? nA : cA + (size_t)(t + 2) * kstep; const char* b2 = last ? nB : cB + (size_t)(t + 2) * kstep;
            const char* a3 = a2 + kstep; const char* b3 = b2 + kstep;
            unsigned o20[2], o21[2];
#pragma unroll
            for (int i = 0; i < 2; ++i) { o20[i] = last ? on0[i] : oc0[i]; o21[i] = last ? on1[i] : oc1[i]; }
            unsigned vb2[2]; size_t hs2 = hstepB;
#pragma unroll
            for (int i = 0; i < 2; ++i) vb2[i] = (Sched::HETERO && last) ? voffBn[i] : voffB[i];
            if (Sched::HETERO && last) hs2 = hstepBn;
            PG8_LDB(B0, 0, 0); PG8_LDB(B1, 0, 1); PG8_SCHED; PG8_LDA(At, 0, 0); PG8_STAGE(PG8_SA(1, 1), a1, oc1);
            PG8_WAIT_V(8); PG8_WAIT_L(0); PG8_BAR; PG8_MMA(0, 0, At, B0); PG8_MMA(0, 1, At, B1); PG8_BAR; PG8_SCHED;
            PG8_LDA(At, 0, 1); PG8_STAGE(PG8_SB(0, 0), b2, vb2); PG8_STAGE(PG8_SB(0, 1), b2 + hs2, vb2); PG8_STAGE(PG8_SA(0, 0), a2, o20);
            PG8_WAIT_V(8); PG8_WAIT_L(0); PG8_BAR; PG8_MMA(1, 0, At, B0); PG8_MMA(1, 1, At, B1); PG8_BAR; PG8_SCHED;
            PG8_LDB(B0, 1, 0); PG8_LDB(B1, 1, 1); PG8_SCHED; PG8_LDA(At, 1, 0); PG8_STAGE(PG8_SA(0, 1), a2, o21);
            PG8_WAIT_V(8); PG8_WAIT_L(0); PG8_BAR; PG8_MMA(0, 0, At, B0); PG8_MMA(0, 1, At, B1); PG8_BAR; PG8_SCHED;
            PG8_LDA(At, 1, 1); PG8_STAGE(PG8_SB(1, 0), b3, vb2); PG8_STAGE(PG8_SB(1, 1), b3 + hs2, vb2); PG8_STAGE(PG8_SA(1, 0), a3, o20);
            PG8_WAIT_V(8); PG8_WAIT_L(0); PG8_BAR; PG8_MMA(1, 0, At, B0); PG8_MMA(1, 1, At, B1); PG8_BAR; PG8_SCHED;
        }
        if (wr == 0) PG8_BAR;
        E(acc, cur, wr, wc, fr, fq);
        if (!has_next) break;
#pragma unroll
        for (int a = 0; a < 2; ++a)
#pragma unroll
            for (int b = 0; b < 2; ++b)
#pragma unroll
                for (int m = 0; m < 4; ++m)
#pragma unroll
                    for (int n = 0; n < 2; ++n) acc[a][b][m][n] = (f32x4){0.f, 0.f, 0.f, 0.f};
        cur = nxt; cA = nA; cB = nB; ++ui;
        if (Sched::HETERO) { Kc = Kn; nt = Kc / BK; hstepB = hstepBn;
#pragma unroll
            for (int i = 0; i < 2; ++i) voffB[i] = voffBn[i]; }
        if (wr == 1) PG8_BAR;
#pragma unroll
        for (int i = 0; i < 2; ++i) { oc0[i] = on0[i]; oc1[i] = on1[i]; }
    }
    PG8_WAIT_V(0);
    PG8_BAR;
#undef PG8_SA
#undef PG8_SB
#undef PG8_STAGE
#undef PG8_LDA
#undef PG8_LDB
#undef PG8_MMA
#undef PG8_WAIT_V
#undef PG8_WAIT_L
#undef PG8_BAR
#undef PG8_SCHED
}
struct SchedLin { static constexpr bool AMAP = false, HETERO = false; __device__ __forceinline__ int Kof(const Unit&) const { return K; } __device__ __forceinline__ int ldbof(const Unit&) const { return K; }
    const bf16* A; const bf16* Bt; int lda, K, row0, nM, nN, G, c;
    __device__ __forceinline__ bool next(int i, Unit& u) const { return static_next(i, G, c, nM, nN, u); }
    __device__ __forceinline__ const char* abase(const Unit& u) const { return (const char*)(A + (size_t)(row0 + BM * u.pm) * lda); }
    __device__ __forceinline__ const char* bbase(const Unit& u) const { return (const char*)(Bt + (size_t)BM * u.pn * K); }
    __device__ __forceinline__ unsigned aoff(const Unit&, int h, int R, int C) const { return (unsigned)((h * HALF + R) * lda + C) * 2u; }
};
template <class F> struct EpiLin { F f; int row0;
    __device__ __forceinline__ void operator()(const f32x4 (&acc)[2][2][4][2], const Unit& u, int wr, int wc, int fr, int fq) const {
        const int col0 = u.pn * BM + wc * 32 + 8 * fq;
#pragma unroll
        for (int ai = 0; ai < 2; ++ai) {
            if constexpr (F::BATCH4) {
                f.store_rows4(row0 + u.pm * BM + ai * HALF + wr * 64 + fr, col0, acc[ai]);
                asm volatile("" ::: "memory");
            } else {
#pragma unroll
                for (int m = 0; m < 4; ++m) { const int row = row0 + u.pm * BM + ai * HALF + wr * 64 + m * 16 + fr;
                    f.store_row(row, col0, acc[ai][0][m][0], acc[ai][0][m][1], acc[ai][1][m][0], acc[ai][1][m][1]);
                    asm volatile("" ::: "memory"); }
            } }
    } };
struct SchedRes { static constexpr bool AMAP = false, HETERO = true; const bf16* A; const bf16* Bt; int lda, K, nks, G, c;
    __device__ __forceinline__ bool next(int i, Unit& u) const {
        if (i == 0) { Unit v; if (!static_next(0, G, c, 64, 4, v)) return false; u.pm = v.pm + 1; u.pn = v.pn; return true; }
        if (i == 1 && c < 4 * nks) { u.pm = 0; u.pn = (c & 3) | ((c >> 2) << 2) | 64; return true; }
        return false; }
    __device__ __forceinline__ int Kof(const Unit& u) const { return (u.pn & 64) ? 256 : K; }
    __device__ __forceinline__ int ldbof(const Unit&) const { return K; }
    __device__ __forceinline__ const char* abase(const Unit& u) const { return (u.pn & 64) ? (const char*)(A + ((u.pn >> 2) & 15) * 256) : (const char*)(A + (size_t)(BM * u.pm) * lda); }
    __device__ __forceinline__ const char* bbase(const Unit& u) const { return (u.pn & 64) ? (const char*)(Bt + (size_t)BM * (u.pn & 3) * K + ((u.pn >> 2) & 15) * 256) : (const char*)(Bt + (size_t)BM * u.pn * K); }
    __device__ __forceinline__ unsigned aoff(const Unit&, int h, int R, int C) const { return (unsigned)((h * HALF + R) * lda + C) * 2u; } };
template <class F> struct EpiRes { F f; float* slab;
    __device__ __forceinline__ void operator()(const f32x4 (&acc)[2][2][4][2], const Unit& u, int wr, int wc, int fr, int fq) const {
        if (u.pn & 64) { float* sp = slab + ((size_t)((u.pn >> 2) & 15) * CTX + wr * 64 + fr) * D + (u.pn & 3) * BM + wc * 32 + 8 * fq;
#pragma unroll
            for (int ai = 0; ai < 2; ++ai)
#pragma unroll
                for (int m = 0; m < 4; ++m)
#pragma unroll
                    for (int bj = 0; bj < 2; ++bj)
#pragma unroll
                        for (int n = 0; n < 2; ++n) *(f32x4*)(sp + (size_t)(ai * HALF + m * 16) * D + bj * HALF + n * 4) = acc[ai][bj][m][n];
        } else { const int col0 = u.pn * BM + wc * 32 + 8 * fq;
#pragma unroll
            for (int ai = 0; ai < 2; ++ai) { f.store_rows4(u.pm * BM + ai * HALF + wr * 64 + fr, col0, acc[ai]); asm volatile("" ::: "memory"); } }
    } };
}
template <class F>
__device__ __forceinline__ void gemm_lin(const bf16* A, int lda, const bf16* Bt, int row0, int nrows, int N, int K, const F& f, float* lds) {
    pg8::SchedLin S{A, Bt, lda, K, row0, nrows / 256, N / 256, (int)gridDim.x, (int)blockIdx.x};
    pg8::EpiLin<F> E{f, row0};
    pg8::gemm_phase(( __attribute__((address_space(3))) unsigned char*)lds, K, S, E);
}

template <class F>
__device__ __forceinline__ void gemm_res_l0(const bf16* A, int lda, const bf16* Bt, int K, int nks, const F& f, float* slab, float* lds) {
    pg8::SchedRes S{A, Bt, lda, K, nks, (int)gridDim.x, (int)blockIdx.x};
    pg8::EpiRes<F> E{f, slab};
    pg8::gemm_phase((__attribute__((address_space(3))) unsigned char*)lds, K, S, E);
}
namespace pg8 {
struct MergeGeo { int mode, G, c;
    __device__ __forceinline__ bool decode(int i, Unit& u) const {
        if (mode == 2) { const int idx = c - 64; if (idx < 0 || idx >= 12 || i >= 2) return false; u.pm = 0; u.pn = (idx / 3) | ((1 + idx % 3) << 2) | (i << 4) | (1 << 5); return true; }
        if (i < 8) { const int s = c; if (s >= 256) return false; const int sp = (s & 7) * 32 + (s >> 3); u.pm = CTX + (sp >> 2) * 256; u.pn = (sp & 3) | ((i >> 1) << 2) | ((i & 1) << 4); return true; }
        if (mode == 1 && c < 4 && i < 10) { u.pm = 0; u.pn = c | (0 << 2) | ((i & 1) << 4) | (2 << 5); return true; }
        return false; } };
struct SchedPG { static constexpr bool AMAP = false, HETERO = true; const bf16* hn; const bf16* y; const bf16* wg; const bf16* wb; MergeGeo geo;
    __device__ __forceinline__ bool next(int i, Unit& u) const { return geo.decode(i, u); }
    __device__ __forceinline__ int Kof(const Unit& u) const { return (u.pn & 16) ? D : 256; }
    __device__ __forceinline__ int ldbof(const Unit& u) const { return (u.pn & 16) ? D : 256; }
    __device__ __forceinline__ const char* abase(const Unit& u) const { const int n = (u.pn >> 2) & 3;
        return (u.pn & 16) ? (const char*)(hn + (size_t)u.pm * D) : (const char*)(y + (size_t)u.pm * D + n * 256); }
    __device__ __forceinline__ const char* bbase(const Unit& u) const { const int n = (u.pn >> 2) & 3, dt = u.pn & 3;
        return (u.pn & 16) ? (const char*)(wg + ((size_t)n * D + (size_t)dt * BM) * D) : (const char*)(wb + ((size_t)n * D + (size_t)dt * BM) * 256); }
    __device__ __forceinline__ unsigned aoff(const Unit&, int h, int R, int C) const { return (unsigned)((h * HALF + R) * D + C) * 2u; } };
struct EpiPG { unsigned char* scr; unsigned char* parts; bf16* merged;
    __device__ __forceinline__ void operator()(const f32x4 (&acc)[2][2][4][2], const Unit& u, int wr, int wc, int fr, int fq) const {
        const size_t lo = (size_t)tidx() * 16; unsigned char* p = scr + lo;
        const int dt = u.pn & 3, n = (u.pn >> 2) & 3, kind = u.pn >> 5;
        if (!(u.pn & 16)) {
#pragma unroll
            for (int ai = 0; ai < 2; ++ai)
#pragma unroll
                for (int bj = 0; bj < 2; ++bj)
#pragma unroll
                    for (int m = 0; m < 4; ++m) { const u32x2 w0 = pack4(acc[ai][bj][m][0]), w1 = pack4(acc[ai][bj][m][1]);
                        *(u32x4*)(p + ((ai * 2 + bj) * 4 + m) * 8192) = (u32x4){w0.x, w0.y, w1.x, w1.y}; }
        } else {
            const int row0 = u.pm; const bool part = (kind == 1), fin = (kind == 2), first = (n == 0) || part;
            unsigned char* q = parts + (size_t)(dt * 3 + (part ? n - 1 : 0)) * 131072 + lo;
            if (!fin) {
#pragma unroll
                for (int ai = 0; ai < 2; ++ai) {
                    u32x4 pw[2][4], ow[2][4];
                    bf16* mp = merged + (size_t)(row0 + ai * HALF + wr * 64 + fr) * D + dt * BM + wc * 32 + 8 * fq;
#pragma unroll
                    for (int bj = 0; bj < 2; ++bj)
#pragma unroll
                        for (int m = 0; m < 4; ++m) { pw[bj][m] = *(const u32x4*)(p + ((ai * 2 + bj) * 4 + m) * 8192);
                            ow[bj][m] = first ? (u32x4){0u, 0u, 0u, 0u} : *(const u32x4*)(mp + (size_t)m * 16 * D + bj * HALF); }
#pragma unroll
                    for (int bj = 0; bj < 2; ++bj)
#pragma unroll
                        for (int m = 0; m < 4; ++m) { const f32x4 a = acc[ai][bj][m][0], b = acc[ai][bj][m][1]; const u32x4 w = pw[bj][m], o = ow[bj][m]; f32x4 v, u2;
                            v.x = sigmoidf_(a.x) * lo2f(w.x) + lo2f(o.x); v.y = sigmoidf_(a.y) * hi2f(w.x) + hi2f(o.x); v.z = sigmoidf_(a.z) * lo2f(w.y) + lo2f(o.y); v.w = sigmoidf_(a.w) * hi2f(w.y) + hi2f(o.y);
                            u2.x = sigmoidf_(b.x) * lo2f(w.z) + lo2f(o.z); u2.y = sigmoidf_(b.y) * hi2f(w.z) + hi2f(o.z); u2.z = sigmoidf_(b.z) * lo2f(w.w) + lo2f(o.w); u2.w = sigmoidf_(b.w) * hi2f(w.w) + hi2f(o.w);
                            if (part) *(u32x4*)(q + ((ai * 2 + bj) * 4 + m) * 8192) = pack8(v, u2);
                            else *(u32x4*)(mp + (size_t)m * 16 * D + bj * HALF) = pack8(v, u2); }
                    asm volatile("" ::: "memory"); }
            } else {
#pragma unroll
                for (int ai = 0; ai < 2; ++ai)
#pragma unroll
                    for (int bj = 0; bj < 2; ++bj)
#pragma unroll
                        for (int mh = 0; mh < 2; ++mh) {
                            u32x4 pw[2], e0[2], e1[2], e2[2];
                            bf16* mp = merged + (size_t)(row0 + ai * HALF + wr * 64 + mh * 32 + fr) * D + dt * BM + wc * 32 + 8 * fq + bj * HALF;
#pragma unroll
                            for (int m2 = 0; m2 < 2; ++m2) { const int fo = ((ai * 2 + bj) * 4 + mh * 2 + m2) * 8192; pw[m2] = *(const u32x4*)(p + fo);
                                e0[m2] = *(const u32x4*)(q + fo); e1[m2] = *(const u32x4*)(q + 131072 + fo); e2[m2] = *(const u32x4*)(q + 262144 + fo); }
#pragma unroll
                            for (int m2 = 0; m2 < 2; ++m2) { const f32x4 a = acc[ai][bj][mh * 2 + m2][0], b = acc[ai][bj][mh * 2 + m2][1]; const u32x4 w = pw[m2], x0 = e0[m2], x1 = e1[m2], x2 = e2[m2]; f32x4 v, u2;
                                v.x = sigmoidf_(a.x) * lo2f(w.x) + ((lo2f(x0.x) + lo2f(x1.x)) + lo2f(x2.x)); v.y = sigmoidf_(a.y) * hi2f(w.x) + ((hi2f(x0.x) + hi2f(x1.x)) + hi2f(x2.x));
                                v.z = sigmoidf_(a.z) * lo2f(w.y) + ((lo2f(x0.y) + lo2f(x1.y)) + lo2f(x2.y)); v.w = sigmoidf_(a.w) * hi2f(w.y) + ((hi2f(x0.y) + hi2f(x1.y)) + hi2f(x2.y));
                                u2.x = sigmoidf_(b.x) * lo2f(w.z) + ((lo2f(x0.z) + lo2f(x1.z)) + lo2f(x2.z)); u2.y = sigmoidf_(b.y) * hi2f(w.z) + ((hi2f(x0.z) + hi2f(x1.z)) + hi2f(x2.z));
                                u2.z = sigmoidf_(b.z) * lo2f(w.w) + ((lo2f(x0.w) + lo2f(x1.w)) + lo2f(x2.w)); u2.w = sigmoidf_(b.w) * hi2f(w.w) + ((hi2f(x0.w) + hi2f(x1.w)) + hi2f(x2.w));
                                *(u32x4*)(mp + (size_t)m2 * 16 * D) = pack8(v, u2); }
                            asm volatile("" ::: "memory"); }
            }
        }
    } };
struct SchedUp { static constexpr bool AMAP = true, HETERO = false; __device__ __forceinline__ int Kof(const Unit&) const { return D; } __device__ __forceinline__ int ldbof(const Unit&) const { return D; } const bf16* hn; const bf16* Bt; int nctxu, nM, nN, G, c;
    __device__ __forceinline__ bool next(int i, Unit& u) const { return static_next(i, G, c, nM, nN, u); }
    __device__ __forceinline__ const char* abase(const Unit&) const { return (const char*)hn; }
    __device__ __forceinline__ const char* bbase(const Unit& u) const { return (const char*)(Bt + (size_t)BM * u.pn * D); }
    __device__ __forceinline__ unsigned aoff(const Unit& u, int h, int R, int C) const {
        const int wr = R >> 6, m = (R >> 4) & 3, fr = R & 15, i = 8 * fr + 4 * h + m; const bool ic = u.pm < nctxu;
        const int run = 2 * (ic ? u.pm : u.pm - nctxu) + wr, seglen = ic ? CTX : SEQ; int t = 126 * run - 1 + i; t = t < 0 ? 0 : (t >= seglen ? seglen - 1 : t);
        return (unsigned)(((ic ? 0 : CTX) + t) * D + C) * 2u; } };
struct EpiUp { bf16* act; const float* cw; const float* cb; int nctxu;
    __device__ __forceinline__ void operator()(const f32x4 (&acc)[2][2][4][2], const Unit& u, int wr, int wc, int fr, int fq) const {
        const bool ic = u.pm < nctxu; const int run = 2 * (ic ? u.pm : u.pm - nctxu) + wr, seglen = ic ? CTX : SEQ, seg0 = ic ? 0 : CTX;
        const int t0 = 126 * run - 1 + 8 * fr;
        const int lane = tidx() & 63;
        u32x2 held[8];
#pragma unroll
        for (int n = 0; n < 2; ++n) {
            const int ch = 128 * u.pn + 32 * wc + 8 * fq + 4 * n;
            const f32x4 w0 = *(const f32x4*)(cw + ch), w1 = *(const f32x4*)(cw + DFF + ch), w2 = *(const f32x4*)(cw + 2 * DFF + ch), bb = *(const f32x4*)(cb + ch);
            f32x4 g[8];
#pragma unroll
            for (int j = 0; j < 8; ++j) { const int t = t0 + j; const bool ok = t >= 0 && t < seglen; g[j] = ok ? acc[j >> 2][1][j & 3][n] : (f32x4){0.f, 0.f, 0.f, 0.f}; }
            f32x4 prev, next;
            prev.x = __shfl(g[7].x, lane - 1); prev.y = __shfl(g[7].y, lane - 1); prev.z = __shfl(g[7].z, lane - 1); prev.w = __shfl(g[7].w, lane - 1);
            next.x = __shfl(g[0].x, lane + 1); next.y = __shfl(g[0].y, lane + 1); next.z = __shfl(g[0].z, lane + 1); next.w = __shfl(g[0].w, lane + 1);
#pragma unroll
            for (int j = 0; j < 8; ++j) { const int i = 8 * fr + j, t = t0 + j;
                const f32x4 gm = (j == 0) ? prev : g[j == 0 ? 0 : j - 1], gp = (j == 7) ? next : g[j == 7 ? 7 : j + 1];
                const f32x4 cv = w0 * gm + w1 * g[j] + w2 * gp + bb; const f32x4 a = acc[j >> 2][0][j & 3][n]; f32x4 o;
                o.x = gelu_tanh(cv.x) * a.x; o.y = gelu_tanh(cv.y) * a.y; o.z = gelu_tanh(cv.z) * a.z; o.w = gelu_tanh(cv.w) * a.w;
                const u32x2 pk = pack4(o);
                if (n == 0) held[j] = pk;
                else if (i >= 1 && i <= 126 && t >= 0 && t < seglen) *(u32x4*)(act + (size_t)(seg0 + t) * DFF + ch - 4) = (u32x4){held[j].x, held[j].y, pk.x, pk.y}; }
        }
    } };
}
constexpr size_t WS_MERGED = WS_S5END;
static_assert(WS_END - WS_S5END >= (size_t)ROWS * D * 2, "merged alias does not fit");
__device__ __forceinline__ void phase_merge_pg(const Ctx& c, const int mode) {
    pg8::MergeGeo geo{mode, (int)gridDim.x, (int)blockIdx.x};
    pg8::SchedPG S{c.W<bf16>(WS_HN), c.W<bf16>(WS_Y), c.W<bf16>(WS_WGT), c.W<bf16>(WS_WBRT), geo};
    pg8::EpiPG E{c.W<unsigned char>(WS_Z) + (size_t)blockIdx.x * 131072, c.W<unsigned char>(WS_Z) + (size_t)256 * 131072, c.W<bf16>(WS_MERGED)};
    pg8::gemm_phase((__attribute__((address_space(3))) unsigned char*)c.lds, D, S, E);
}
__device__ __forceinline__ void phase_ffn_up_pg(const Ctx& c) {
    const int nctxu = (c.l == DEPTH - 1) ? 0 : 2, nM = nctxu + 66;
    pg8::SchedUp S{c.W<bf16>(WS_HN), c.W<bf16>(WS_WUPT), nctxu, nM, DFF * 2 / 256, (int)gridDim.x, (int)blockIdx.x};
    pg8::EpiUp E{c.W<bf16>(WS_Z), c.in(I_FCW) + (size_t)c.l * 3 * DFF, c.in(I_FCB) + (size_t)c.l * DFF, nctxu};
    pg8::gemm_phase((__attribute__((address_space(3))) unsigned char*)c.lds, D, S, E);
}

__device__ __forceinline__ void da_prep(const Ctx& c, const int bid, const int nb) {
    const int wave = tidx() >> 6, lane = tidx() & 63, vec = lane >> 2, sub = lane & 3;
    const bool isq = vec < 8;
    const float* gain = c.in(isq ? I_DQN : I_DKN) + (size_t)c.l * 32 + sub * 8;
    const float qscale = 0.17677669529663687f * 1.4426950408889634f;
    bf16* z = c.W<bf16>(WS_Z);
    for (int row = bid * 8 + wave; row < ROWS; row += nb * 8) {
        bf16* pz = z + (size_t)row * NZ + (isq ? ZC_DAQ : ZC_DAK) + (vec & 7) * 32 + sub * 8;
        const u32x4 raw = *(const u32x4*)pz;
        float x[8] = {lo2f(raw.x), hi2f(raw.x), lo2f(raw.y), hi2f(raw.y), lo2f(raw.z), hi2f(raw.z), lo2f(raw.w), hi2f(raw.w)};
        float ss = 0.f;
#pragma unroll
        for (int e = 0; e < 8; ++e) ss += x[e] * x[e];
        ss += __shfl_xor(ss, 1); ss += __shfl_xor(ss, 2);
        const float rstd = rsqrtf(ss * (1.0f / 32.0f) + 1e-6f);
#pragma unroll
        for (int e = 0; e < 8; ++e) x[e] = x[e] * rstd * gain[e];
        if (row >= CTX) {
            const int tok = row - CTX; const float* rt = c.W<float>(WS_ROPE) + ((sub < 2) ? (tok >> 6) : (tok & 63)) * 16;
#pragma unroll
            for (int e = 0; e < 8; ++e) { const float cs = rt[e * 2], sn = rt[e * 2 + 1]; const float other = __shfl_xor(x[e], 1);
                x[e] = (sub & 1) ? (other * sn + x[e] * cs) : (x[e] * cs - other * sn); }
        }
        if (isq) {
#pragma unroll
            for (int e = 0; e < 8; ++e) x[e] *= qscale; }
        u32x4 w; w.x = pack2(x[0], x[1]); w.y = pack2(x[2], x[3]); w.z = pack2(x[4], x[5]); w.w = pack2(x[6], x[7]);
        *(u32x4*)pz = w;
    }
}

__device__ __forceinline__ void s5_mfma(const Ctx& c, const bool final_pass) {
    const int tid = tidx(), wave = tid >> 6, lane = tid & 63, r = lane & 31, hh = lane >> 5, cq = lane & 15, q4 = lane >> 4;
    unsigned char* hb = (unsigned char*)c.lds + wave * 8704;
    const bf16* z = c.W<bf16>(WS_Z);
    const int c0 = (final_pass && c.l == DEPTH - 1) ? 4 : 0;
    for (int task = c0 * 2 + blockIdx.x; task < NCHUNK * 2; task += gridDim.x) {
        const int ch = task >> 1, g = wave + 8 * (task & 1);
        f32x4 yacc[4];
        if (final_pass) { const float dsk = c.in(I_SD)[(size_t)c.l * 256 + g * 16 + cq];
#pragma unroll
            for (int tb = 0; tb < 4; ++tb)
#pragma unroll
                for (int rg = 0; rg < 4; ++rg) yacc[tb][rg] = bf2f(z[(size_t)(ch * 64 + tb * 16 + 4 * q4 + rg) * NZ + ZC_SSM + g * 16 + cq]) * dsk; }
        for (int d = 0; d < 2; ++d) {
            const int sib = ((c.l * 2 + d) * 16 + g) * 64;
            float lbr[2], lbi[2], hr[2], hi[2]; bf16x8 cmB[4];
#pragma unroll
            for (int j = 0; j < 2; ++j) { const int si = sib + j * 32 + r; lbr[j] = c.W<float>(WS_S5LB)[si * 2]; lbi[j] = c.W<float>(WS_S5LB)[si * 2 + 1];
                if (final_pass) { const float* st = c.W<float>(WS_S5START) + ((size_t)(ch * 2 + d) * 16 + g) * 128 + (j * 32 + r) * 2; hr[j] = st[0]; hi[j] = st[1]; } else { hr[j] = 0.f; hi[j] = 0.f; } }
            if (final_pass) { const size_t cix = ((size_t)((c.l * 2 + d) * 16 + g) * 16 + cq) * 64;
#pragma unroll
                for (int s4 = 0; s4 < 4; ++s4) { const f32x4 re = *(const f32x4*)(c.in(I_SCRE) + cix + 16 * s4 + 4 * q4), im = *(const f32x4*)(c.in(I_SCIM) + cix + 16 * s4 + 4 * q4);
                    cmB[s4] = __builtin_bit_cast(bf16x8, __builtin_convertvector((f32x8){re.x, -im.x, re.y, -im.y, re.z, -im.z, re.w, -im.w}, bf16v8)); } }
#pragma unroll
            for (int mbi = 0; mbi < 2; ++mbi) { const int mb = d ? 1 - mbi : mbi;
                f32x16 X0, X1, X2, X3;
#pragma unroll
                for (int i = 0; i < 16; ++i) { X0[i] = 0.f; X1[i] = 0.f; X2[i] = 0.f; X3[i] = 0.f; }
                { int zo = 0; asm volatile("" : "+v"(zo));
                  const bf16x8 afm = *(const bf16x8*)(z + (size_t)(ch * 64 + mb * 32 + r) * NZ + ZC_SSM + g * 16 + 8 * hh + zo); bf16x8 bfr[4];
#pragma unroll
                  for (int nb = 0; nb < 4; ++nb) { const float* pb = c.W<float>(WS_S5BB) + (size_t)(sib + (nb & 1) * 32 + r) * 32 + (nb >> 1) * 16 + 8 * hh + zo; const f32x4 b0 = *(const f32x4*)pb, b1 = *(const f32x4*)(pb + 4);
                      bfr[nb] = __builtin_bit_cast(bf16x8, __builtin_convertvector((f32x8){b0.x, b0.y, b0.z, b0.w, b1.x, b1.y, b1.z, b1.w}, bf16v8)); }
                  X0 = MFMA32(afm, bfr[0], X0); X1 = MFMA32(afm, bfr[1], X1); X2 = MFMA32(afm, bfr[2], X2); X3 = MFMA32(afm, bfr[3], X3); }
#define S5_SEG(XR, XI, J, G, FIRST_HH, K0, K1, K2, K3) do { \
                    const float ar = lbr[J], ai = lbi[J]; \
                    const float tr0 = ar * hr[J] - ai * hi[J] + XR[4 * (G) + K0], ti0 = ar * hi[J] + ai * hr[J] + XI[4 * (G) + K0]; \
                    const float tr1 = ar * tr0 - ai * ti0 + XR[4 * (G) + K1], ti1 = ar * ti0 + ai * tr0 + XI[4 * (G) + K1]; \
                    const float tr2 = ar * tr1 - ai * ti1 + XR[4 * (G) + K2], ti2 = ar * ti1 + ai * tr1 + XI[4 * (G) + K2]; \
                    const float tr3 = ar * tr2 - ai * ti2 + XR[4 * (G) + K3], ti3 = ar * ti2 + ai * tr2 + XI[4 * (G) + K3]; \
                    const float pr_ = __shfl_xor(tr3, 32), pi_ = __shfl_xor(ti3, 32); \
                    const float ur0 = ar * pr_ - ai * pi_ + XR[4 * (G) + K0], ui0 = ar * pi_ + ai * pr_ + XI[4 * (G) + K0]; \
                    const float ur1 = ar * ur0 - ai * ui0 + XR[4 * (G) + K1], ui1 = ar * ui0 + ai * ur0 + XI[4 * (G) + K1]; \
                    const float ur2 = ar * ur1 - ai * ui1 + XR[4 * (G) + K2], ui2 = ar * ui1 + ai * ur1 + XI[4 * (G) + K2]; \
                    const float ur3 = ar * ur2 - ai * ui2 + XR[4 * (G) + K3], ui3 = ar * ui2 + ai * ur2 + XI[4 * (G) + K3]; \
                    const bool fst = (hh == (FIRST_HH)); \
                    XR[4 * (G) + K0] = fst ? tr0 : ur0; XI[4 * (G) + K0] = fst ? ti0 : ui0; XR[4 * (G) + K1] = fst ? tr1 : ur1; XI[4 * (G) + K1] = fst ? ti1 : ui1; \
                    XR[4 * (G) + K2] = fst ? tr2 : ur2; XI[4 * (G) + K2] = fst ? ti2 : ui2; XR[4 * (G) + K3] = fst ? tr3 : ur3; XI[4 * (G) + K3] = fst ? ti3 : ui3; \
                    const float qr_ = __shfl_xor(ur3, 32), qi_ = __shfl_xor(ui3, 32); hr[J] = fst ? qr_ : ur3; hi[J] = fst ? qi_ : ui3; } while (0)
                if (d == 0) { S5_SEG(X0, X2, 0, 0, 0, 0, 1, 2, 3); S5_SEG(X1, X3, 1, 0, 0, 0, 1, 2, 3); S5_SEG(X0, X2, 0, 1, 0, 0, 1, 2, 3); S5_SEG(X1, X3, 1, 1, 0, 0, 1, 2, 3);
                              S5_SEG(X0, X2, 0, 2, 0, 0, 1, 2, 3); S5_SEG(X1, X3, 1, 2, 0, 0, 1, 2, 3); S5_SEG(X0, X2, 0, 3, 0, 0, 1, 2, 3); S5_SEG(X1, X3, 1, 3, 0, 0, 1, 2, 3); }
                else        { S5_SEG(X0, X2, 0, 3, 1, 3, 2, 1, 0); S5_SEG(X1, X3, 1, 3, 1, 3, 2, 1, 0); S5_SEG(X0, X2, 0, 2, 1, 3, 2, 1, 0); S5_SEG(X1, X3, 1, 2, 1, 3, 2, 1, 0);
                              S5_SEG(X0, X2, 0, 1, 1, 3, 2, 1, 0); S5_SEG(X1, X3, 1, 1, 1, 3, 2, 1, 0); S5_SEG(X0, X2, 0, 0, 1, 3, 2, 1, 0); S5_SEG(X1, X3, 1, 0, 1, 3, 2, 1, 0); }
#undef S5_SEG
                if (final_pass) {
#pragma unroll
                    for (int i = 0; i < 16; ++i) { const int tl = (i & 3) + 8 * (i >> 2) + 4 * hh;
                        *(unsigned*)(hb + tl * 272 + r * 4) = pack2(X0[i], X2[i]); *(unsigned*)(hb + tl * 272 + (32 + r) * 4) = pack2(X1[i], X3[i]); }
#pragma unroll
                    for (int tb2 = 0; tb2 < 2; ++tb2)
#pragma unroll
                        for (int s4 = 0; s4 < 4; ++s4) { const bf16x8 a16 = *(const bf16x8*)(hb + (tb2 * 16 + cq) * 272 + (32 * s4 + 8 * q4) * 2);
                            if (mb == 0) yacc[tb2] = __builtin_amdgcn_mfma_f32_16x16x32_bf16(a16, cmB[s4], yacc[tb2], 0, 0, 0);
                            else yacc[2 + tb2] = __builtin_amdgcn_mfma_f32_16x16x32_bf16(a16, cmB[s4], yacc[2 + tb2], 0, 0, 0); } } }
            if (!final_pass) {
#pragma unroll
                for (int j = 0; j < 2; ++j) if (hh == 0) { float* e = c.W<float>(WS_S5END) + ((size_t)(ch * 2 + d) * 16 + g) * 128 + (j * 32 + r) * 2; e[0] = hr[j]; e[1] = hi[j]; } }
        }
        if (final_pass) { int q4o = q4; asm volatile("" : "+v"(q4o));
#pragma unroll
            for (int tb = 0; tb < 4; ++tb)
#pragma unroll
                for (int rg = 0; rg < 4; ++rg) c.W<bf16>(WS_YS5)[(size_t)(ch * 64 + tb * 16 + 4 * q4o + rg) * 256 + g * 16 + cq] = f2bf(gelu_tanh(yacc[tb][rg])); }
    }
}

__device__ __forceinline__ void lru_mfma(const Ctx& c, const bool final_pass) {
    const int tid = tidx(), wave = tid >> 6, lane = tid & 63, r = lane & 31, hh = lane >> 5, chn = wave * 32 + r;
    unsigned char* L = (unsigned char*)c.lds;
    bf16* xt = (bf16*)L;
    unsigned char* xcb = L + 34816;
    float* xcf = (float*)(L + 68608);
    const bf16* z = c.W<bf16>(WS_Z);
    const int sg = tid & 31;
    const int c0 = (final_pass && c.l == DEPTH - 1) ? 4 : 0;
    for (int ch = c0 + rot_bid(8); ch < NCHUNK; ch += gridDim.x) {
        const int segb = ch < 4 ? 0 : CTX, sege = ch < 4 ? CTX : ROWS;
        __syncthreads();
        { u32x4 v[5];
#pragma unroll
          for (int q = 0; q < 5; ++q) { const int pc = tid + q * NT, rr = pc >> 5, row = ch * 64 - 2 + rr;
              v[q] = (pc < 67 * 32 && row >= segb && row < sege) ? *(const u32x4*)(z + (size_t)row * NZ + ZC_LRUX + (pc & 31) * 8) : (u32x4){0u, 0u, 0u, 0u}; }
#pragma unroll
          for (int q = 0; q < 5; ++q) { const int pc = tid + q * NT; if (pc < 67 * 32) *(u32x4*)(xt + (size_t)pc * 8) = v[q]; } }
        __syncthreads();
        { int zo = 0; asm volatile("" : "+v"(zo));
          float cwv[4][8], cbv8[8];
#pragma unroll
          for (int e = 0; e < 8; ++e) { cbv8[e] = c.in(I_LCB)[(size_t)c.l * 256 + sg * 8 + e + zo];
#pragma unroll
              for (int k = 0; k < 4; ++k) cwv[k][e] = c.in(I_LCW)[(size_t)c.l * 1024 + k * 256 + sg * 8 + e + zo]; }
#pragma unroll
        for (int q = 0; q < 4; ++q) { const int i = (tid >> 5) + q * 16; float o[8];
#pragma unroll
            for (int e = 0; e < 8; ++e) o[e] = cbv8[e];
#pragma unroll
            for (int k = 0; k < 4; ++k) { const u32x4 xv = *(const u32x4*)(xt + (size_t)(i + k) * 256 + sg * 8);
                o[0] += cwv[k][0] * lo2f(xv.x); o[1] += cwv[k][1] * hi2f(xv.x); o[2] += cwv[k][2] * lo2f(xv.y); o[3] += cwv[k][3] * hi2f(xv.y);
                o[4] += cwv[k][4] * lo2f(xv.z); o[5] += cwv[k][5] * hi2f(xv.z); o[6] += cwv[k][6] * lo2f(xv.w); o[7] += cwv[k][7] * hi2f(xv.w); }
            *(f32x4*)(xcf + i * 256 + sg * 8) = (f32x4){o[0], o[1], o[2], o[3]}; *(f32x4*)(xcf + i * 256 + sg * 8 + 4) = (f32x4){o[4], o[5], o[6], o[7]};
            u32x4 w; w.x = pack2(o[0], o[1]); w.y = pack2(o[2], o[3]); w.z = pack2(o[4], o[5]); w.w = pack2(o[6], o[7]); *(u32x4*)(xcb + i * 528 + sg * 16) = w; } }
        __syncthreads();
        bf16x8 af[2][2]; float xv[2][16], hs[2][16];
#pragma unroll
        for (int mb = 0; mb < 2; ++mb) {
#pragma unroll
            for (int s2 = 0; s2 < 2; ++s2) af[mb][s2] = *(const bf16x8*)(xcb + (mb * 32 + r) * 528 + (wave * 32 + 16 * s2 + 8 * hh) * 2);
#pragma unroll
            for (int i = 0; i < 16; ++i) xv[mb][i] = xcf[(mb * 32 + (i & 3) + 8 * (i >> 2) + 4 * hh) * 256 + chn]; }
#pragma unroll
        for (int d = 0; d < 2; ++d) {
            int zo = 0; asm volatile("" : "+v"(zo));
            bf16x8 wrf[2], wif[2]; const size_t base = ((size_t)(c.l * 2 + d) * 8 + wave) * 1024 + r + zo;
            const float brv = c.in(I_LBR)[(size_t)(c.l * 2 + d) * 256 + chn + zo], biv = c.in(I_LBI)[(size_t)(c.l * 2 + d) * 256 + chn + zo], lsv = 8.0f * logsigmoidf_(c.in(I_LLAM)[(size_t)(c.l * 2 + d) * 256 + chn + zo]);
#pragma unroll
            for (int s2 = 0; s2 < 2; ++s2) { const float* pr_ = c.in(I_LWR) + base + (size_t)(16 * s2 + 8 * hh) * 32; const float* pi_ = c.in(I_LWI) + base + (size_t)(16 * s2 + 8 * hh) * 32;
                wrf[s2] = __builtin_bit_cast(bf16x8, __builtin_convertvector((f32x8){pr_[0], pr_[32], pr_[64], pr_[96], pr_[128], pr_[160], pr_[192], pr_[224]}, bf16v8));
                wif[s2] = __builtin_bit_cast(bf16x8, __builtin_convertvector((f32x8){pi_[0], pi_[32], pi_[64], pi_[96], pi_[128], pi_[160], pi_[192], pi_[224]}, bf16v8)); }
            float av[2][16], bv[2][16];
#pragma unroll
            for (int mb = 0; mb < 2; ++mb) { f32x16 ra, ia;
#pragma unroll
                for (int i = 0; i < 16; ++i) { ra[i] = brv; ia[i] = biv; }
#pragma unroll
                for (int s2 = 0; s2 < 2; ++s2) { ra = MFMA32(af[mb][s2], wrf[s2], ra); ia = MFMA32(af[mb][s2], wif[s2], ia); }
#pragma unroll
                for (int i = 0; i < 16; ++i) { const float rg = sigmoidf_(ra[i]), ig = sigmoidf_(ia[i]), a = __expf(rg * lsv);
                    av[mb][i] = a; bv[mb][i] = sqrtf(fmaxf(1.0f - a * a, 0.f)) * (ig * xv[mb][i]); } }
            float h = final_pass ? c.W<float>(WS_LRUSTART)[(size_t)(ch * 2 + d) * 256 + chn] : 0.f;
#define LRU_SEG(MB, G, FIRST_HH, K0, K1, K2, K3) do { \
                float t0 = av[MB][4 * (G) + K0] * h + bv[MB][4 * (G) + K0], t1 = av[MB][4 * (G) + K1] * t0 + bv[MB][4 * (G) + K1], t2 = av[MB][4 * (G) + K2] * t1 + bv[MB][4 * (G) + K2], t3 = av[MB][4 * (G) + K3] * t2 + bv[MB][4 * (G) + K3]; \
                const float hin = __shfl_xor(t3, 32); \
                const float u0 = av[MB][4 * (G) + K0] * hin + bv[MB][4 * (G) + K0], u1 = av[MB][4 * (G) + K1] * u0 + bv[MB][4 * (G) + K1], u2 = av[MB][4 * (G) + K2] * u1 + bv[MB][4 * (G) + K2], u3 = av[MB][4 * (G) + K3] * u2 + bv[MB][4 * (G) + K3]; \
                const bool fst = (hh == (FIRST_HH)); \
                bv[MB][4 * (G) + K0] = fst ? t0 : u0; bv[MB][4 * (G) + K1] = fst ? t1 : u1; bv[MB][4 * (G) + K2] = fst ? t2 : u2; bv[MB][4 * (G) + K3] = fst ? t3 : u3; \
                const float ho = __shfl_xor(u3, 32); h = fst ? ho : u3; } while (0)
            if (d == 0) { LRU_SEG(0, 0, 0, 0, 1, 2, 3); LRU_SEG(0, 1, 0, 0, 1, 2, 3); LRU_SEG(0, 2, 0, 0, 1, 2, 3); LRU_SEG(0, 3, 0, 0, 1, 2, 3);
                          LRU_SEG(1, 0, 0, 0, 1, 2, 3); LRU_SEG(1, 1, 0, 0, 1, 2, 3); LRU_SEG(1, 2, 0, 0, 1, 2, 3); LRU_SEG(1, 3, 0, 0, 1, 2, 3); }
            else        { LRU_SEG(1, 3, 1, 3, 2, 1, 0); LRU_SEG(1, 2, 1, 3, 2, 1, 0); LRU_SEG(1, 1, 1, 3, 2, 1, 0); LRU_SEG(1, 0, 1, 3, 2, 1, 0);
                          LRU_SEG(0, 3, 1, 3, 2, 1, 0); LRU_SEG(0, 2, 1, 3, 2, 1, 0); LRU_SEG(0, 1, 1, 3, 2, 1, 0); LRU_SEG(0, 0, 1, 3, 2, 1, 0); }
#undef LRU_SEG
            if (!final_pass) { float A = 1.f;
#pragma unroll
                for (int mb = 0; mb < 2; ++mb)
#pragma unroll
                    for (int i = 0; i < 16; ++i) A *= av[mb][i];
                A *= __shfl_xor(A, 32);
                if (hh == 0) { float* e = c.W<float>(WS_LRUEND) + ((size_t)(ch * 2 + d) * 256 + chn) * 2; e[0] = A; e[1] = h; } }
            else {
#pragma unroll
                for (int mb = 0; mb < 2; ++mb)
#pragma unroll
                    for (int i = 0; i < 16; ++i) hs[mb][i] = d == 0 ? bv[mb][i] : hs[mb][i] + bv[mb][i]; }
        }
        if (final_pass) {
#pragma unroll
            for (int mb = 0; mb < 2; ++mb)
#pragma unroll
                for (int i = 0; i < 16; ++i) xcf[(mb * 32 + (i & 3) + 8 * (i >> 2) + 4 * hh) * 256 + chn] = hs[mb][i];
            __syncthreads();
            u32x4 yv[4];
#pragma unroll
            for (int q = 0; q < 4; ++q) { const int pc = tid + q * NT; yv[q] = *(const u32x4*)(z + (size_t)(ch * 64 + (pc >> 5)) * NZ + ZC_LRUY + (pc & 31) * 8); }
#pragma unroll
            for (int q = 0; q < 4; ++q) { const int pc = tid + q * NT, rr = pc >> 5; const float* hp = xcf + rr * 256 + (pc & 31) * 8; u32x4 w;
                w.x = pack2(hp[0] * gelu_tanh(lo2f(yv[q].x)), hp[1] * gelu_tanh(hi2f(yv[q].x))); w.y = pack2(hp[2] * gelu_tanh(lo2f(yv[q].y)), hp[3] * gelu_tanh(hi2f(yv[q].y)));
                w.z = pack2(hp[4] * gelu_tanh(lo2f(yv[q].z)), hp[5] * gelu_tanh(hi2f(yv[q].z))); w.w = pack2(hp[6] * gelu_tanh(lo2f(yv[q].w)), hp[7] * gelu_tanh(hi2f(yv[q].w)));
                *(u32x4*)(c.W<bf16>(WS_Y) + (size_t)(ch * 64 + rr) * D + 256 + (pc & 31) * 8) = w; } }
    }
}

__device__ __forceinline__ float logsig_fast(float x) { return fminf(x, 0.f) - __logf(1.0f + __expf(-fabsf(x))); }
__device__ __forceinline__ void gla_mfma(const Ctx& c, const bool final_pass) {
    const int tid = tidx(), wave = tid >> 6, lane = tid & 63, r = lane & 31, hh = lane >> 5, hd = wave >> 1, d = wave & 1;
    unsigned char* L = (unsigned char*)c.lds;
    unsigned char* QE = L + wave * 10240; unsigned char* KE = QE + 5120;
    unsigned char* VT = L + 81920 + hd * 9216;
    float* zt = (float*)(L + 118784);
    float* ex = (float*)(L + (wave & ~1) * 10240);
    const bf16* z = c.W<bf16>(WS_Z); const float* za = c.W<float>(WS_ZA);
    const int pr = (r & 19) | ((r & 4) << 1) | ((r & 8) >> 1);
    const int c0 = (final_pass && c.l == DEPTH - 1) ? 4 : 0;
    for (int ch = c0 + rot_bid(12); ch < NCHUNK; ch += gridDim.x) {
        __syncthreads();
        { const f32x4 zv = *(const f32x4*)(za + (size_t)(ch * 64 + (tid >> 3)) * 32 + (tid & 7) * 4); u32x4 vv[4];
#pragma unroll
          for (int q = 0; q < 4; ++q) { const int pc = tid + q * NT; vv[q] = *(const u32x4*)(z + (size_t)(ch * 64 + (pc >> 5)) * NZ + ZC_GV + (pc & 31) * 8); }
          *(f32x4*)(zt + (tid >> 3) * 32 + (tid & 7) * 4) = zv;
#pragma unroll
          for (int q = 0; q < 4; ++q) { const int pc = tid + q * NT, j = pc >> 5, sg = pc & 31; bf16* dst = (bf16*)(L + 81920 + (sg >> 3) * 9216 + ((sg & 7) * 8) * 144 + j * 2);
              dst[0] = (bf16)(vv[q].x & 0xffff); dst[72] = (bf16)(vv[q].x >> 16); dst[144] = (bf16)(vv[q].y & 0xffff); dst[216] = (bf16)(vv[q].y >> 16);
              dst[288] = (bf16)(vv[q].z & 0xffff); dst[360] = (bf16)(vv[q].z >> 16); dst[432] = (bf16)(vv[q].w & 0xffff); dst[504] = (bf16)(vv[q].w >> 16); } }
        __syncthreads();
        int zo = 0; asm volatile("" : "+v"(zo));
        float w2[16];
#pragma unroll
        for (int k = 0; k < 16; ++k) w2[k] = c.in(I_GWA2)[(size_t)(c.l * 2 + d) * 16 * 128 + k * 128 + hd * 32 + r + zo];
        const float bav = c.in(I_GBA)[(size_t)(c.l * 2 + d) * 128 + hd * 32 + r + zo];
        float lav[32]; float run = 0.f;
#pragma unroll
        for (int i = 0; i < 32; ++i) { const int tok = hh * 32 + (d ? 31 - i : i); const float* a = zt + tok * 32 + d * 16; float zz = bav;
            const f32x4 a0 = *(const f32x4*)a, a1 = *(const f32x4*)(a + 4), a2 = *(const f32x4*)(a + 8), a3 = *(const f32x4*)(a + 12);
            zz += (a0.x * w2[0] + a0.y * w2[1]) + (a0.z * w2[2] + a0.w * w2[3]) + (a1.x * w2[4] + a1.y * w2[5]) + (a1.z * w2[6] + a1.w * w2[7])
                + (a2.x * w2[8] + a2.y * w2[9]) + (a2.z * w2[10] + a2.w * w2[11]) + (a3.x * w2[12] + a3.y * w2[13]) + (a3.z * w2[14] + a3.w * w2[15]);
            run += logsig_fast(zz) * (1.0f / 16.0f); lav[i] = run; }
        const float other = __shfl_xor(run, 32), tot = run + other, add = ((d == 0) == (hh == 1)) ? other : 0.f;
        int koff = 0, hq = hh; asm volatile("" : "+v"(hq));
        const bf16* pq = z + (size_t)(ch * 64) * NZ + ZC_GQ + hd * 32 + r; const bf16* pk = z + (size_t)(ch * 64) * NZ + ZC_GK + hd * 32 + r;
        if (final_pass) {
#pragma unroll
            for (int i = 0; i < 32; ++i) { if ((i & 7) == 0) asm volatile("" : "+v"(koff) :: "memory");
                const int tok = hq * 32 + (d ? 31 - i : i); const float b = lav[i] + add;
                const float qv = bf2f(pq[(size_t)tok * NZ + koff]) * 0.17677669529663687f, kv = bf2f(pk[(size_t)tok * NZ + koff]);
                *(bf16*)(QE + tok * 80 + r * 2) = f2bf(qv * __expf(b)); *(bf16*)(KE + tok * 80 + r * 2) = f2bf(kv * __expf(-b));
                }
        } else {
#pragma unroll
            for (int i = 0; i < 32; ++i) { if ((i & 7) == 0) asm volatile("" : "+v"(koff) :: "memory");
                const int tok = hq * 32 + (d ? 31 - i : i); const float b = lav[i] + add; const float kv = bf2f(pk[(size_t)tok * NZ + koff]);
                *(bf16*)(QE + r * 144 + tok * 2) = f2bf(kv * __expf(tot - b));
                }
            if (hh == 0) c.W<float>(WS_GLADEC)[((size_t)(ch * 2 + d) * 4 + hd) * 32 + r] = __expf(tot);
        }
        if (!final_pass) {
            f32x16 kvt[2];
#pragma unroll
            for (int db = 0; db < 2; ++db)
#pragma unroll
                for (int i = 0; i < 16; ++i) kvt[db][i] = 0.f;
#pragma unroll
            for (int s4 = 0; s4 < 4; ++s4) { const bf16x8 bf = *(const bf16x8*)(QE + r * 144 + (16 * s4 + 8 * hh) * 2);
#pragma unroll
                for (int db = 0; db < 2; ++db) { const bf16x8 af = *(const bf16x8*)(VT + (db * 32 + r) * 144 + (16 * s4 + 8 * hh) * 2); kvt[db] = MFMA32(af, bf, kvt[db]); } }
            float* kvp = c.W<float>(WS_GLAKV) + ((size_t)(ch * 2 + d) * 4 + hd) * 2048 + r;
#pragma unroll
            for (int db = 0; db < 2; ++db)
#pragma unroll
                for (int i = 0; i < 16; ++i) kvp[(db * 32 + (i & 3) + 8 * (i >> 2) + 4 * hh) * 32] = kvt[db][i];
            continue;
        }
        f32x16 o[2][2];
#pragma unroll
        for (int db = 0; db < 2; ++db)
#pragma unroll
            for (int ib = 0; ib < 2; ++ib)
#pragma unroll
                for (int i = 0; i < 16; ++i) o[db][ib][i] = 0.f;
        bf16x8 qb[2][2];
#pragma unroll
        for (int ib = 0; ib < 2; ++ib)
#pragma unroll
            for (int s2 = 0; s2 < 2; ++s2) qb[ib][s2] = *(const bf16x8*)(QE + (ib * 32 + r) * 80 + s2 * 32 + hh * 16);
        { const bf16* s0t = c.W<bf16>(WS_GLAS0) + ((size_t)(ch * 2 + d) * 4 + hd) * 2048;
#pragma unroll
          for (int db = 0; db < 2; ++db)
#pragma unroll
              for (int s2 = 0; s2 < 2; ++s2) { const bf16x8 sf = *(const bf16x8*)(s0t + (db * 32 + r) * 32 + 16 * s2 + 8 * hh);
#pragma unroll
                  for (int ib = 0; ib < 2; ++ib) o[db][ib] = MFMA32(sf, qb[ib][s2], o[db][ib]); } }
#define GLA_BLOCK(JB, IB, MASKED) do { f32x16 x; _Pragma("unroll") for (int i = 0; i < 16; ++i) x[i] = 0.f; \
        _Pragma("unroll") for (int s2 = 0; s2 < 2; ++s2) { const bf16x8 kf = *(const bf16x8*)(KE + ((JB) * 32 + pr) * 80 + s2 * 32 + hh * 16); x = MFMA32(kf, qb[IB][s2], x); } \
        if (MASKED) { _Pragma("unroll") for (int i = 0; i < 16; ++i) { const int jl = (i & 3) + 4 * ((i >> 2) & 1) + 8 * hh + 16 * (i >> 3); const bool keep = d ? (jl >= r) : (jl <= r); x[i] = keep ? x[i] : 0.f; } } \
        _Pragma("unroll") for (int s2 = 0; s2 < 2; ++s2) { \
            const bf16x8 pb = __builtin_bit_cast(bf16x8, __builtin_convertvector((f32x8){x[8 * s2], x[8 * s2 + 1], x[8 * s2 + 2], x[8 * s2 + 3], x[8 * s2 + 4], x[8 * s2 + 5], x[8 * s2 + 6], x[8 * s2 + 7]}, bf16v8)); \
            _Pragma("unroll") for (int db = 0; db < 2; ++db) { const bf16x8 vf = *(const bf16x8*)(VT + (db * 32 + r) * 144 + ((JB) * 32 + s2 * 16 + hh * 8) * 2); o[db][IB] = MFMA32(vf, pb, o[db][IB]); } } } while (0)
        GLA_BLOCK(0, 0, true); GLA_BLOCK(1, 1, true);
        if (d == 0) GLA_BLOCK(0, 1, false); else GLA_BLOCK(1, 0, false);
#undef GLA_BLOCK
        __syncthreads();
        if (d == 1) {
#pragma unroll
            for (int db = 0; db < 2; ++db)
#pragma unroll
                for (int ib = 0; ib < 2; ++ib)
#pragma unroll
                    for (int i = 0; i < 16; ++i) ex[((db * 2 + ib) * 16 + i) * 64 + lane] = o[db][ib][i]; }
        __syncthreads();
        if (d == 0) {
            const float* gon = c.in(I_GON) + (size_t)c.l * 64;
#pragma unroll
            for (int ib = 0; ib < 2; ++ib) { float ss = 0.f;
#pragma unroll
                for (int db = 0; db < 2; ++db)
#pragma unroll
                    for (int i = 0; i < 16; ++i) { const float v = o[db][ib][i] + ex[((db * 2 + ib) * 16 + i) * 64 + lane]; o[db][ib][i] = v; ss += v * v; }
                ss += __shfl_xor(ss, 32);
                const float rstd = rsqrtf(ss * (1.0f / 64.0f) + 1e-6f); const int row = ch * 64 + ib * 32 + r;
#pragma unroll
                for (int db = 0; db < 2; ++db)
#pragma unroll
                    for (int g4 = 0; g4 < 4; ++g4) { const int dv0 = db * 32 + 8 * g4 + 4 * hh; const u32x2 gw = *(const u32x2*)(z + (size_t)row * NZ + ZC_GG + hd * 64 + dv0); const f32x4 gn = *(const f32x4*)(gon + dv0);
                        u32x2 w; w.x = pack2(o[db][ib][4 * g4] * rstd * gn.x * siluf_(lo2f(gw.x)), o[db][ib][4 * g4 + 1] * rstd * gn.y * siluf_(hi2f(gw.x)));
                        w.y = pack2(o[db][ib][4 * g4 + 2] * rstd * gn.z * siluf_(lo2f(gw.y)), o[db][ib][4 * g4 + 3] * rstd * gn.w * siluf_(hi2f(gw.y)));
                        *(u32x2*)(c.W<bf16>(WS_Y) + (size_t)row * D + 768 + hd * 64 + dv0) = w; } } }
    }
}

__device__ __forceinline__ void phase_carry(const Ctx& c) {
    const int b = blockIdx.x, t = tidx();
    constexpr int NB = 13, NBATCH = NCHUNK / NB;
    if (b < 4) {
        const int i = b * NT + t, d = i >> 10, gp = i & 1023; const int si = (c.l * 2 + d) * 1024 + gp;
        float ar = c.W<float>(WS_S5LB)[si * 2], ai = c.W<float>(WS_S5LB)[si * 2 + 1];
        for (int q = 0; q < 6; ++q) { const float nr = ar * ar - ai * ai, ni = 2.f * ar * ai; ar = nr; ai = ni; }
        float hr = 0.f, hi = 0.f;
        const f32x2* E = c.W<f32x2>(WS_S5END); f32x2* S = c.W<f32x2>(WS_S5START);
        f32x2 ea[NB], eb[NB];
#define S5C_LOAD(dst, s0) _Pragma("unroll") for (int j = 0; j < NB; ++j) dst[j] = E[(size_t)(chunk_of((s0) + j, d) * 2 + d) * 1024 + gp]
#define S5C_USE(src, s0) _Pragma("unroll") for (int j = 0; j < NB; ++j) { S[(size_t)(chunk_of((s0) + j, d) * 2 + d) * 1024 + gp] = (f32x2){hr, hi}; \
            const float nr = ar * hr - ai * hi + src[j].x, ni = ar * hi + ai * hr + src[j].y; hr = nr; hi = ni; }
        S5C_LOAD(ea, 0);
        for (int bt = 0; bt < NBATCH; bt += 2) { S5C_LOAD(eb, (bt + 1) * NB); S5C_USE(ea, bt * NB); if (bt + 2 < NBATCH) S5C_LOAD(ea, (bt + 2) * NB); S5C_USE(eb, (bt + 1) * NB); }
#undef S5C_LOAD
#undef S5C_USE
    } else if (b == 4) {
        const int d = t >> 8, chn = t & 255; float h = 0.f;
        const f32x2* E = c.W<f32x2>(WS_LRUEND); float* S = c.W<float>(WS_LRUSTART);
        f32x2 ea[NB], eb[NB];
#define LRC_LOAD(dst, s0) _Pragma("unroll") for (int j = 0; j < NB; ++j) dst[j] = E[(size_t)(chunk_of((s0) + j, d) * 2 + d) * 256 + chn]
#define LRC_USE(src, s0) _Pragma("unroll") for (int j = 0; j < NB; ++j) { S[(size_t)(chunk_of((s0) + j, d) * 2 + d) * 256 + chn] = h; h = src[j].x * h + src[j].y; }
        LRC_LOAD(ea, 0);
        for (int bt = 0; bt < NBATCH; bt += 2) { LRC_LOAD(eb, (bt + 1) * NB); LRC_USE(ea, bt * NB); if (bt + 2 < NBATCH) LRC_LOAD(ea, (bt + 2) * NB); LRC_USE(eb, (bt + 1) * NB); }
#undef LRC_LOAD
#undef LRC_USE
    } else if (b >= 8 && b < 40) {
        const int i = (b - 8) * NT + t, d = i >> 13, hd = (i >> 11) & 3, e = i & 2047, dk = e & 31; float S = 0.f;
        const float* KV = c.W<float>(WS_GLAKV); const float* DC = c.W<float>(WS_GLADEC); bf16* S0 = c.W<bf16>(WS_GLAS0);
        float ka[NB], da[NB], kb[NB], db[NB];
#define GLC_LOAD(kd, dd, s0) _Pragma("unroll") for (int j = 0; j < NB; ++j) { const size_t cb = (size_t)(chunk_of((s0) + j, d) * 2 + d) * 4 + hd; kd[j] = KV[cb * 2048 + e]; dd[j] = DC[cb * 32 + dk]; }
#define GLC_USE(kd, dd, s0) _Pragma("unroll") for (int j = 0; j < NB; ++j) { const size_t cb = (size_t)(chunk_of((s0) + j, d) * 2 + d) * 4 + hd; S0[cb * 2048 + e] = f2bf(S); S = dd[j] * S + kd[j]; }
        GLC_LOAD(ka, da, 0);
        for (int bt = 0; bt < NBATCH; bt += 2) { GLC_LOAD(kb, db, (bt + 1) * NB); GLC_USE(ka, da, bt * NB); if (bt + 2 < NBATCH) GLC_LOAD(ka, da, (bt + 2) * NB); GLC_USE(kb, db, (bt + 1) * NB); }
#undef GLC_LOAD
#undef GLC_USE
    }
}

__device__ __forceinline__ void v_transpose(const Ctx& c, const int bid, const int nb) {
    const int t = tidx(); bf16* sm = (bf16*)c.lds;
    const bf16* z = c.W<bf16>(WS_Z); bf16* vT = c.W<bf16>(WS_VT);
    for (int task = bid; task < NCHUNK * 4; task += nb) {
        const int kt = task >> 2, hd = task & 3, key = t >> 3, seg = t & 7;
        const u32x4 v = *(const u32x4*)(z + (size_t)(kt * 64 + key) * NZ + ZC_DAV + hd * 64 + seg * 8);
        __syncthreads();
        bf16* d = sm + (seg * 8) * 72 + key;
        d[0] = (bf16)(v.x & 0xffff); d[72] = (bf16)(v.x >> 16); d[144] = (bf16)(v.y & 0xffff); d[216] = (bf16)(v.y >> 16);
        d[288] = (bf16)(v.z & 0xffff); d[360] = (bf16)(v.z >> 16); d[432] = (bf16)(v.w & 0xffff); d[504] = (bf16)(v.w >> 16);
        __syncthreads();
        *(u32x4*)(vT + (size_t)(hd * 64 + key) * ROWS + kt * 64 + seg * 8) = *(const u32x4*)(sm + key * 72 + seg * 8);
    }
}
template <bool SHIFT>
__device__ __forceinline__ void attn_mfma_body(const Ctx& c) {
    const int tid = tidx(), wave = tid >> 6, lane = tid & 63, r = lane & 31, hh = lane >> 5;
    constexpr int KS = 144, VOFF = 64 * KS, BUF = 2 * 64 * KS;
    unsigned char* L = (unsigned char*)c.lds;
    const bf16* z = c.W<bf16>(WS_Z); const bf16* vT = c.W<bf16>(WS_VT);
    const float li = lam_init_of(c.l);
    float lam; { const float* lp = c.in(I_DLAM) + (size_t)c.l * 128; float s0 = 0.f, s1 = 0.f; for (int k = 0; k < 32; ++k) { s0 += lp[k] * lp[32 + k]; s1 += lp[64 + k] * lp[96 + k]; } lam = expf(s0) - expf(s1) + li; }
    float gq = 0.f, gk = 0.f; for (int k = 0; k < 32; ++k) { gq = fmaxf(gq, fabsf(c.in(I_DQN)[(size_t)c.l * 32 + k])); gk = fmaxf(gk, fabsf(c.in(I_DKN)[(size_t)c.l * 32 + k])); }
    const float mb = 32.0f * gq * gk * (0.17677669529663687f * 1.4426950408889634f) * 1.02f;
    const int pr = (r & 19) | ((r & 4) << 1) | ((r & 8) >> 1);
    const int skey = tid >> 3, sseg = tid & 7, lw = skey * KS + sseg * 16;
    const int qb0 = (c.l == DEPTH - 1) ? 1 : 0;
    for (int task = qb0 * 4 + blockIdx.x; task < 65 * 4; task += gridDim.x) {
        const int qb = task >> 2, hd = task & 3, nt = (qb == 0 ? CTX : ROWS) / 64; const int row = qb * 256 + wave * 32 + r;
        bf16x8 qf[2][2];
        { const bf16* pq = z + (size_t)row * NZ + ZC_DAQ + hd * 64 + hh * 8;
#pragma unroll
          for (int cc = 0; cc < 2; ++cc)
#pragma unroll
              for (int s2 = 0; s2 < 2; ++s2) qf[cc][s2] = *(const bf16x8*)(pq + cc * 32 + s2 * 16); }
        f32x16 o[2][2];
#pragma unroll
        for (int cc = 0; cc < 2; ++cc)
#pragma unroll
            for (int db = 0; db < 2; ++db)
#pragma unroll
                for (int i = 0; i < 16; ++i) o[cc][db][i] = 0.f;
        float ls0 = 0.f, ls1 = 0.f;
        const bf16* gk_ = z + (size_t)skey * NZ + ZC_DAK + hd * 64 + sseg * 8;
        const bf16* gv_ = vT + (size_t)(hd * 64 + skey) * ROWS + sseg * 8;
        u32x4 kr = *(const u32x4*)gk_, vr = *(const u32x4*)gv_;
        __syncthreads();
        *(u32x4*)(L + lw) = kr; *(u32x4*)(L + VOFF + lw) = vr;
        __syncthreads();
        for (int t = 0; t < nt; ++t) {
            const unsigned char* cur = L + (t & 1) * BUF;
            if (t + 1 < nt) { kr = *(const u32x4*)(gk_ + (size_t)(t + 1) * 64 * NZ); vr = *(const u32x4*)(gv_ + (t + 1) * 64); }
#pragma unroll
            for (int kb = 0; kb < 2; ++kb) {
                bf16x8 vf[2][2];
#pragma unroll
                for (int db = 0; db < 2; ++db)
#pragma unroll
                    for (int s2 = 0; s2 < 2; ++s2) vf[db][s2] = *(const bf16x8*)(cur + VOFF + (db * 32 + r) * KS + (kb * 32 + s2 * 16 + hh * 8) * 2);
#pragma unroll
                for (int cc = 0; cc < 2; ++cc) {
                    f32x16 sa;
#pragma unroll
                    for (int i = 0; i < 16; ++i) sa[i] = SHIFT ? -mb : 0.f;
#pragma unroll
                    for (int s2 = 0; s2 < 2; ++s2) { const bf16x8 kf = *(const bf16x8*)(cur + (kb * 32 + pr) * KS + cc * 64 + s2 * 32 + hh * 16); sa = MFMA32(kf, qf[cc][s2], sa); }
                    float p[16];
#pragma unroll
                    for (int i = 0; i < 16; ++i) p[i] = __builtin_amdgcn_exp2f(sa[i]);
                    const float ps = ((p[0] + p[1]) + (p[2] + p[3])) + ((p[4] + p[5]) + (p[6] + p[7])) + (((p[8] + p[9]) + (p[10] + p[11])) + ((p[12] + p[13]) + (p[14] + p[15])));
                    if (cc == 0) ls0 += ps; else ls1 += ps;
#pragma unroll
                    for (int s2 = 0; s2 < 2; ++s2) {
                        const bf16x8 pb = __builtin_bit_cast(bf16x8, __builtin_convertvector((f32x8){p[8 * s2], p[8 * s2 + 1], p[8 * s2 + 2], p[8 * s2 + 3], p[8 * s2 + 4], p[8 * s2 + 5], p[8 * s2 + 6], p[8 * s2 + 7]}, bf16v8));
#pragma unroll
                        for (int db = 0; db < 2; ++db) o[cc][db] = MFMA32(vf[db][s2], pb, o[cc][db]);
                    }
                }
            }
            if (t + 1 < nt) { unsigned char* nb = L + ((t + 1) & 1) * BUF; *(u32x4*)(nb + lw) = kr; *(u32x4*)(nb + VOFF + lw) = vr; }
            __syncthreads();
        }
        ls0 += __shfl_xor(ls0, 32); ls1 += __shfl_xor(ls1, 32);
        const float il0 = 1.0f / ls0, il1 = lam / ls1; float ss = 0.f;
#pragma unroll
        for (int db = 0; db < 2; ++db)
#pragma unroll
            for (int i = 0; i < 16; ++i) { const float v = o[0][db][i] * il0 - o[1][db][i] * il1; o[0][db][i] = v; ss += v * v; }
        ss += __shfl_xor(ss, 32);
        const float rstd = rsqrtf(ss * (1.0f / 64.0f) + 1e-6f) * (1.0f - li);
        bf16* po = c.W<bf16>(WS_Y) + (size_t)row * D + 512 + hd * 64 + 4 * hh; const float* gn = c.in(I_DON) + (size_t)c.l * 64 + 4 * hh;
#pragma unroll
        for (int db = 0; db < 2; ++db)
#pragma unroll
            for (int g = 0; g < 4; ++g) { const int dv0 = db * 32 + 8 * g; const f32x4 gg = *(const f32x4*)(gn + dv0);
                u32x2 w; w.x = pack2(o[0][db][4 * g] * rstd * gg.x, o[0][db][4 * g + 1] * rstd * gg.y); w.y = pack2(o[0][db][4 * g + 2] * rstd * gg.z, o[0][db][4 * g + 3] * rstd * gg.w);
                *(u32x2*)(po + dv0) = w; }
    }
}


__device__ __forceinline__ void attn_mfma(const Ctx& c) {
    float gq = 0.f, gk = 0.f; for (int k = 0; k < 32; ++k) { gq = fmaxf(gq, fabsf(c.in(I_DQN)[(size_t)c.l * 32 + k])); gk = fmaxf(gk, fabsf(c.in(I_DKN)[(size_t)c.l * 32 + k])); }
    const float mb = 32.0f * gq * gk * (0.17677669529663687f * 1.4426950408889634f) * 1.02f;
    if (mb > 64.0f) attn_mfma_body<true>(c); else attn_mfma_body<false>(c);
}

#define XB_TMO      128
#define XB_XCNT(j)  (256  + 64 * (j))
#define XB_XSUB(j)  (1280 + 64 * (j))
#define XB_XGEN(j)  (2304 + 64 * (j))
#define XB_TOP      3328
#define XB_TOPGEN   3392
#define XCD_BAR_WORDS 3456
#define XB_SPIN_CAP (1u << 18)
#define LAS __attribute__((address_space(3)))
__device__ __forceinline__ unsigned xb_ld(unsigned* p)              { return __hip_atomic_load(p, __ATOMIC_RELAXED, __HIP_MEMORY_SCOPE_AGENT); }
__device__ __forceinline__ unsigned xb_add(unsigned* p, unsigned v) { return __hip_atomic_fetch_add(p, v, __ATOMIC_RELAXED, __HIP_MEMORY_SCOPE_AGENT); }
__device__ __forceinline__ unsigned xb_xcc_id() { return (unsigned)__builtin_amdgcn_s_getreg((3 << 11) | 20) & 0xFu; }
#define XB_SPIN(cond, bar) do { unsigned _sp = 0; while (cond) { __builtin_amdgcn_s_sleep(1); \
    if ((++_sp & 255u) == 0u) { if (xb_ld(&(bar)[XB_TMO])) break; if (_sp > XB_SPIN_CAP) { atomicAdd(&(bar)[XB_TMO], 1u); break; } } } } while (0)
struct XcdBarrier { unsigned* bar; unsigned x; volatile LAS unsigned* st; };
__device__ __forceinline__ XcdBarrier xcd_barrier_post(unsigned* bar, volatile LAS unsigned* st) {
    XcdBarrier b; b.bar = bar; b.x = xb_xcc_id(); b.st = st;
    if (threadIdx.x == 0) (void)xb_add(&bar[XB_XCNT(b.x)], 1u);
    return b;
}
__device__ __forceinline__ void xcd_barrier_complete(unsigned* bar, unsigned x, unsigned& nloc, unsigned& nx) {
    const unsigned G = gridDim.x * gridDim.y * gridDim.z;
    unsigned sum, cnt, mine, sp = 0u;
    for (;;) {
        sum = 0u; cnt = 0u; mine = 0u;
#pragma unroll
        for (unsigned j = 0; j < 16; ++j) { const unsigned c = xb_ld(&bar[XB_XCNT(j)]); sum += c; cnt += (c > 0u) ? 1u : 0u; mine = (j == x) ? c : mine; }
        if (sum == G) break;
        __builtin_amdgcn_s_sleep(1);
        if ((++sp & 255u) == 0u) { if (xb_ld(&bar[XB_TMO])) break; if (sp > XB_SPIN_CAP) { atomicAdd(&bar[XB_TMO], 1u); break; } }
    }
    nloc = mine > 0u ? mine : 1u; nx = cnt > 0u ? cnt : 1u;
}
__device__ __forceinline__ void xcd_barrier(const XcdBarrier& b) {
    asm volatile("s_waitcnt vmcnt(0)" ::: "memory");
    __syncthreads();
    if (threadIdx.x == 0) {
        unsigned* bar = b.bar;
        __builtin_amdgcn_s_waitcnt(0);
        unsigned nloc = b.st[0], nx = b.st[1];
        if (nloc == 0u) { xcd_barrier_complete(bar, b.x, nloc, nx); b.st[0] = nloc; b.st[1] = nx; }
        const unsigned old = xb_add(&bar[XB_XSUB(b.x)], 1u);
        const unsigned gen = old / nloc;
        if (old + 1u == (gen + 1u) * nloc) {
            __builtin_amdgcn_fence(__ATOMIC_RELEASE, "agent");
            asm volatile("s_waitcnt vmcnt(0)" ::: "memory");
            const unsigned og = xb_add(&bar[XB_TOP], 1u);
            const unsigned tg = og / nx;
            if (og + 1u == (tg + 1u) * nx) xb_add(&bar[XB_TOPGEN], 1u);
            else XB_SPIN(xb_ld(&bar[XB_TOPGEN]) == tg, bar);
            __builtin_amdgcn_fence(__ATOMIC_ACQUIRE, "agent");
            xb_add(&bar[XB_XGEN(b.x)], 1u);
            asm volatile("s_waitcnt vmcnt(0)" ::: "memory");
        } else {
            XB_SPIN(xb_ld(&bar[XB_XGEN(b.x)]) == gen, bar);
            __builtin_amdgcn_fence(__ATOMIC_ACQUIRE, "agent");
            asm volatile("s_waitcnt vmcnt(0)" ::: "memory");
        }
    }
    __syncthreads();
}

enum { PH_PREP = 0, PH_NORM1, PH_INPROJ, PH_MIX1, PH_CARRY, PH_MIX3, PH_GLU, PH_MERGE, PH_WOUT, PH_NORM2, PH_FFNUP, PH_FFNDN, PH_COUNT };

__device__ __forceinline__ void run_phase(const int l, const int ph, float* lds, const bool rep = false) {
    KParams* pp = (KParams*)__builtin_amdgcn_kernarg_segment_ptr();
    asm volatile("" : "+s"(pp));
    Ctx c(pp, l, lds);
    switch (ph) {
    case PH_PREP: phase_prep(c); break;
    case PH_NORM1: phase_norm(c, 0); break;
    case PH_INPROJ: { EpiInproj e{c.W<bf16>(WS_Z), c.W<float>(WS_ZA)}; gemm_lin(c.W<bf16>(WS_HN), D, c.W<bf16>(WS_WINT), 0, ROWS, NZP, D, e, lds); } break;
    case PH_MIX1: s5_mfma(c, false); lru_mfma(c, false); gla_mfma(c, false); break;
    case PH_CARRY: phase_carry(c);
        if (blockIdx.x >= 40) { if (!rep) da_prep(c, (int)blockIdx.x - 40, (int)gridDim.x - 40); v_transpose(c, (int)blockIdx.x - 40, (int)gridDim.x - 40); } break;
    #ifndef PROBE_SUB
#define PROBE_SUB 15
#endif
    case PH_MIX3: if (!rep || (PROBE_SUB & 1)) attn_mfma(c); if (!rep || (PROBE_SUB & 2)) s5_mfma(c, true); if (!rep || (PROBE_SUB & 4)) lru_mfma(c, true); if (!rep || (PROBE_SUB & 8)) gla_mfma(c, true); break;
    case PH_GLU: { EpiGlu e{c.W<bf16>(WS_YS5), c.W<bf16>(WS_Y)}; const int r0 = c.row_begin(); gemm_lin(c.W<bf16>(WS_YS5), 256, c.W<bf16>(WS_WGLUT), r0, ROWS - r0, 256, 256, e, lds);
        if (c.l != DEPTH - 1) phase_merge_pg(c, 2); } break;
    case PH_MERGE: phase_merge_pg(c, c.l == DEPTH - 1 ? 0 : 1); break;
    case PH_WOUT: { const EpiResid e = make_resid(c, 2 * D, true);
        if (c.l == 0) gemm_res_l0(c.W<bf16>(WS_MERGED), D, c.W<bf16>(WS_WOUTT), D, 4, e, c.W<float>(WS_SLABW), lds);
        else gemm_lin(c.W<bf16>(WS_MERGED), D, c.W<bf16>(WS_WOUTT), CTX, ROWS - CTX, D, D, e, lds); } break;
    case PH_NORM2: phase_norm(c, 1); break;
    case PH_FFNUP: phase_ffn_up_pg(c); break;
    case PH_FFNDN: { const EpiResid e = make_resid(c, 5 * D, false);
        if (c.l == 0) gemm_res_l0(c.W<bf16>(WS_Z), DFF, c.W<bf16>(WS_WDNT), DFF, 11, e, c.W<float>(WS_SLABF), lds);
        else gemm_lin(c.W<bf16>(WS_Z), DFF, c.W<bf16>(WS_WDNT), CTX, ROWS - CTX, D, DFF, e, lds); } break;
    default: break;
    }
}

__global__ void __launch_bounds__(NT) k_mega(Params p) {
    extern __shared__ __attribute__((aligned(16))) float lds[];
    cooperative_groups::grid_group grid = cooperative_groups::this_grid();
    volatile LAS unsigned* st = (volatile LAS unsigned*)((LAS unsigned char*)lds + LDS_TOTAL - 16);
    if (threadIdx.x == 0) { st[0] = 0u; st[1] = 0u; st[2] = 0u; st[3] = 0u; }
    __syncthreads();
    const XcdBarrier bar = xcd_barrier_post((unsigned*)(p.ws + WS_CTL), st);
#ifndef PROBE_PH
#define PROBE_PH -1
#endif
#define PHASE(l, ph) do { run_phase(l, ph, lds); xcd_barrier(bar); if (PROBE_PH == (ph)) { run_phase(l, ph, lds, true); xcd_barrier(bar); } } while (0)
#define LAYER(l) PHASE(l, PH_NORM1); PHASE(l, PH_INPROJ); PHASE(l, PH_MIX1); PHASE(l, PH_CARRY); PHASE(l, PH_MIX3); PHASE(l, PH_GLU); \
    PHASE(l, PH_MERGE); PHASE(l, PH_WOUT); PHASE(l, PH_NORM2); PHASE(l, PH_FFNUP)
    run_phase(0, PH_PREP, lds);
    grid.sync();
    if (threadIdx.x == 0) __builtin_amdgcn_fence(__ATOMIC_ACQUIRE, "agent");
    __syncthreads();
    LAYER(0); PHASE(0, PH_FFNDN);
    run_phase(1, PH_PREP, lds); LAYER(1); run_phase(1, PH_FFNDN, lds);
#undef LAYER
#undef PHASE
}


extern "C" void kernel_launch(void* const* d_in, const int* in_sizes, int n_in, void* d_out, int out_size, void* d_ws, size_t ws_size, hipStream_t stream) {
    static int grid_blocks = 0;
    if (!grid_blocks) {
        if (n_in != N_IN || ws_size < WS_END) { fprintf(stderr, "kernel_launch: unexpected n_in %d or ws_size %zu (need %zu)\n", n_in, ws_size, (size_t)WS_END); grid_blocks = -1; return; }
        if (hipFuncSetAttribute((const void*)k_mega, hipFuncAttributeMaxDynamicSharedMemorySize, LDS_BYTES) != hipSuccess) { fprintf(stderr, "kernel_launch: hipFuncSetAttribute failed\n"); grid_blocks = -1; return; }
        int dev = 0, cus = 0, per_cu = 0;
        hipGetDevice(&dev);
        hipDeviceGetAttribute(&cus, hipDeviceAttributeMultiprocessorCount, dev);
        if (hipOccupancyMaxActiveBlocksPerMultiprocessor(&per_cu, (const void*)k_mega, NT, LDS_BYTES) != hipSuccess || per_cu < 1) { fprintf(stderr, "kernel_launch: occupancy query failed (%d)\n", per_cu); grid_blocks = -1; return; }
        grid_blocks = cus;
    }
    if (grid_blocks < 0) return;
    Params p{};
    for (int i = 0; i < N_IN; ++i) p.in[i] = (const float*)d_in[i];
    p.out = (float*)d_out; p.ws = (unsigned char*)d_ws;
    if (hipMemsetAsync((char*)d_ws + WS_CTL, 0, XCD_BAR_WORDS * 4, stream) != hipSuccess) { fprintf(stderr, "kernel_launch: memset of the barrier words failed\n"); return; }
    void* args[] = {&p};
    hipError_t e = hipLaunchCooperativeKernel((const void*)k_mega, dim3(grid_blocks), dim3(NT), args, LDS_BYTES, stream);
    if (e != hipSuccess) fprintf(stderr, "cooperative launch failed: %s (grid %d)\n", hipGetErrorString(e), grid_blocks);
}
```

```cpp
#include <hip/hip_runtime.h>
#include <hip/hip_cooperative_groups.h>
#include <cstdio>
#include <cstdint>

typedef unsigned short bf16;
typedef float f32x4 __attribute__((ext_vector_type(4)));
typedef unsigned u32x4 __attribute__((ext_vector_type(4)));
typedef unsigned u32x2 __attribute__((ext_vector_type(2)));
typedef short bf16x8 __attribute__((ext_vector_type(8)));
typedef float f32x16 __attribute__((ext_vector_type(16)));
typedef float f32x8 __attribute__((ext_vector_type(8)));
typedef __bf16 bf16v8 __attribute__((ext_vector_type(8)));
#define MFMA32(a, b, c) __builtin_amdgcn_mfma_f32_32x32x16_bf16((a), (b), (c), 0, 0, 0)

constexpr int D = 1024, SEQ = 16384, CTX = 256, ROWS = SEQ + CTX, DEPTH = 2;
constexpr int IN_TOTAL = 6432, NZ = 2304, NZP = 2560, GATE0 = 2336, DFF = 2816;
constexpr int NCHUNK = ROWS / 64;
constexpr int NT = 512;
constexpr int ZC_SSM = 0, ZC_LRUX = 256, ZC_LRUY = 512, ZC_DAQ = 768, ZC_DAK = 1024, ZC_DAV = 1280, ZC_GQ = 1536, ZC_GK = 1664, ZC_GV = 1792, ZC_GG = 2048;

enum { I_X = 0, I_C, I_CTX, I_CCTX, I_WADA, I_BADA, I_N1G, I_N2G, I_WIN, I_SLRE, I_SLIM, I_SLOG, I_SBRE, I_SBIM, I_SCRE, I_SCIM, I_SD, I_SWGLU,
       I_LCW, I_LCB, I_LWR, I_LBR, I_LWI, I_LBI, I_LLAM, I_DQN, I_DKN, I_DLAM, I_DON, I_GWA2, I_GBA, I_GON, I_WBR, I_WOUT, I_WUP, I_FCW, I_FCB, I_WDN, N_IN };

constexpr size_t al256(size_t x) { return (x + 255) & ~(size_t)255; }
constexpr size_t WS_CTL = 0;
constexpr size_t WS_ROPE = 32768;
constexpr size_t WS_MODS = 65536;
constexpr size_t WS_S5LB = WS_MODS + al256((size_t)2 * 2 * 6144 * 4);
constexpr size_t WS_S5BB = WS_S5LB + al256((size_t)4096 * 2 * 4);
constexpr size_t WS_HCTX = WS_S5BB + al256((size_t)4096 * 32 * 4);
constexpr size_t WS_WINT = WS_HCTX + al256((size_t)CTX * D * 4);
constexpr size_t WS_WGT = WS_WINT + al256((size_t)NZP * D * 2);
constexpr size_t WS_WBRT = WS_WGT + al256((size_t)4096 * D * 2);
constexpr size_t WS_WOUTT = WS_WBRT + al256((size_t)4 * D * 256 * 2);
constexpr size_t WS_WUPT = WS_WOUTT + al256((size_t)D * D * 2);
constexpr size_t WS_WDNT = WS_WUPT + al256((size_t)2 * DFF * D * 2);
constexpr size_t WS_WGLUT = WS_WDNT + al256((size_t)D * DFF * 2);
constexpr size_t WS_HN = WS_WGLUT + al256((size_t)256 * 256 * 2);
constexpr size_t WS_Z = WS_HN + al256((size_t)(ROWS + 256) * D * 2);
constexpr size_t WS_ZA = WS_Z + al256((size_t)ROWS * DFF * 2);
constexpr size_t WS_Y = WS_ZA + al256((size_t)ROWS * 32 * 4);
constexpr size_t WS_YS5 = WS_Y + al256((size_t)ROWS * D * 2);
constexpr size_t WS_S5END = WS_YS5 + al256((size_t)ROWS * 256 * 2);
constexpr size_t WS_S5START = WS_S5END + al256((size_t)NCHUNK * 2 * 16 * 64 * 2 * 4);
constexpr size_t WS_LRUEND = WS_S5START + al256((size_t)NCHUNK * 2 * 16 * 64 * 2 * 4);
constexpr size_t WS_LRUSTART = WS_LRUEND + al256((size_t)NCHUNK * 2 * 256 * 2 * 4);
constexpr size_t WS_GLAKV = WS_LRUSTART + al256((size_t)NCHUNK * 2 * 256 * 4);
constexpr size_t WS_GLAS0 = WS_GLAKV + al256((size_t)NCHUNK * 2 * 4 * 32 * 64 * 4);
constexpr size_t WS_GLADEC = WS_GLAS0 + al256((size_t)NCHUNK * 2 * 4 * 32 * 64 * 4);
constexpr size_t WS_VT = WS_GLADEC + al256((size_t)NCHUNK * 2 * 4 * 32 * 4);
constexpr size_t WS_END = WS_VT + al256((size_t)256 * ROWS * 2);
constexpr size_t WS_SLABW = WS_Z + (size_t)48 * 1024 * 1024;
constexpr size_t WS_SLABF = WS_Y;
static_assert(WS_END <= (size_t)256 * 1024 * 1024, "workspace map exceeds 256 MiB");

constexpr int LDS_TOTAL = 144 * 1024;
constexpr int LDS_BYTES = LDS_TOTAL;
struct Params { const float* in[N_IN]; float* out; unsigned char* ws; int phase; int layer; };

__device__ __forceinline__ int tidx() { int t = threadIdx.x; asm volatile("" : "+v"(t)); return t; }
__device__ __forceinline__ float bf2f(bf16 b) { return __uint_as_float(((unsigned)b) << 16); }
__device__ __forceinline__ bf16 f2bf(float f) { unsigned u = __float_as_uint(f); u += 0x7FFFu + ((u >> 16) & 1u); return (bf16)(u >> 16); }
typedef __bf16 bf16v2 __attribute__((ext_vector_type(2)));
typedef float f32x2 __attribute__((ext_vector_type(2)));
__device__ __forceinline__ unsigned pack2(float lo, float hi) { return __builtin_bit_cast(unsigned, __builtin_convertvector((f32x2){lo, hi}, bf16v2)); }
__device__ __forceinline__ float lo2f(unsigned w) { return __uint_as_float(w << 16); }
__device__ __forceinline__ float hi2f(unsigned w) { return __uint_as_float(w & 0xFFFF0000u); }
__device__ __forceinline__ float sigmoidf_(float x) { return __builtin_amdgcn_rcpf(1.0f + __expf(-x)); }
__device__ __forceinline__ float siluf_(float x) { return x * sigmoidf_(x); }
__device__ __forceinline__ float gelu_tanh(float x) { const float u = 0.7978845608028654f * (x + 0.044715f * x * x * x); return x * sigmoidf_(2.0f * u); }
__device__ __forceinline__ float logsigmoidf_(float x) { return x >= 0.f ? -log1pf(expf(-x)) : x - log1pf(expf(x)); }
__device__ __forceinline__ int rot_bid(int k) { return (int)((blockIdx.x + gridDim.x - k) % gridDim.x); }
__device__ __forceinline__ int chunk_of(int s, int d) { return d == 0 ? s : (s < 4 ? 3 - s : 263 - s); }
__device__ __forceinline__ float lam_init_of(int l) { return 0.8f - 0.6f * expf(-0.3f * (float)l); }

typedef const __attribute__((address_space(4))) Params KParams;
struct Ctx {
    const KParams* pp; int l; unsigned char* ws; float* lds; float* out;
    __device__ Ctx(const KParams* p_, int l_, float* lds_) : pp(p_), l(l_), ws(p_->ws), lds(lds_), out(p_->out) {}
    template <class T> __device__ __forceinline__ T* W(size_t off) const { return (T*)(ws + off); }
    __device__ __forceinline__ const float* in(int i) const { return pp->in[i]; }
    __device__ __forceinline__ const float* xin_row(int row) const {
        if (l == 0) return row < CTX ? pp->in[I_CTX] + (size_t)row * D : pp->in[I_X] + (size_t)(row - CTX) * D;
        return row < CTX ? W<float>(WS_HCTX) + (size_t)row * D : out + (size_t)(row - CTX) * D; }
    __device__ __forceinline__ float* xout_row(int row) const { return row < CTX ? W<float>(WS_HCTX) + (size_t)row * D : out + (size_t)(row - CTX) * D; }
    __device__ __forceinline__ const float* mods(int row) const { return W<float>(WS_MODS) + ((size_t)l * 2 + (row < CTX ? 1 : 0)) * 6144; }
    __device__ __forceinline__ int row_begin() const { return l == DEPTH - 1 ? CTX : 0; }
};

struct ConvDesc { const float* src; bf16* dst; int ld, col0, nvalid, K, drow0, k0; };
__device__ __forceinline__ ConvDesc conv_decode(const Ctx& c, int ti) {
    const int l = c.l; ConvDesc d;
    constexpr int T0 = 640, T1 = T0 + 1024, T2 = T1 + 256, T3 = T2 + 256, T4 = T3 + 1408, T5 = T4 + 704;
    if (ti < T0) { const int jt = ti >> 4, kt = ti & 15; int nv = GATE0 - jt * 64; nv = nv < 0 ? 0 : (nv > 64 ? 64 : nv);
        d = ConvDesc{c.in(I_WIN) + (size_t)l * D * IN_TOTAL, c.W<bf16>(WS_WINT), IN_TOTAL, jt * 64, nv, D, jt * 64, kt * 64}; }
    else if (ti < T1) { const int u = ti - T0, jt = u >> 4, kt = u & 15;
        d = ConvDesc{c.in(I_WIN) + (size_t)l * D * IN_TOTAL, c.W<bf16>(WS_WGT), IN_TOTAL, GATE0 + jt * 64, 64, D, jt * 64, kt * 64}; }
    else if (ti < T2) { const int u = ti - T1, n = u >> 6, jt = (u >> 2) & 15, kt = u & 3;
        d = ConvDesc{c.in(I_WBR) + ((size_t)l * 4 + n) * 256 * D, c.W<bf16>(WS_WBRT) + (size_t)n * D * 256, D, jt * 64, 64, 256, jt * 64, kt * 64}; }
    else if (ti < T3) { const int u = ti - T2, jt = u >> 4, kt = u & 15;
        d = ConvDesc{c.in(I_WOUT) + (size_t)l * D * D, c.W<bf16>(WS_WOUTT), D, jt * 64, 64, D, jt * 64, kt * 64}; }
    else if (ti < T4) { const int u = ti - T3, jt = u >> 4, kt = u & 15; const int r0 = jt * 64, pn = r0 >> 8, bj = (r0 >> 7) & 1, cc = r0 & 127;
        d = ConvDesc{c.in(I_WUP) + (size_t)l * D * 2 * DFF, c.W<bf16>(WS_WUPT), 2 * DFF, bj * DFF + 128 * pn + cc, 64, D, r0, kt * 64}; }
    else if (ti < T5) { const int u = ti - T4, jt = u / 44, kt = u % 44;
        d = ConvDesc{c.in(I_WDN) + (size_t)l * DFF * D, c.W<bf16>(WS_WDNT), D, jt * 64, 64, DFF, jt * 64, kt * 64}; }
    else { const int u = ti - T5, jt = u >> 2, kt = u & 3;
        d = ConvDesc{c.in(I_SWGLU) + (size_t)l * 256 * 256, c.W<bf16>(WS_WGLUT), 256, jt * 64, 64, 256, jt * 64, kt * 64}; }
    return d;
}
__device__ __forceinline__ void phase_prep(const Ctx& c) {
    const int l = c.l, t = tidx();
    constexpr int T6 = 640 + 1024 + 256 + 256 + 1408 + 704 + 16;
    { int ti = blockIdx.x; float v[8]; ConvDesc d;
      if (ti < T6) { d = conv_decode(c, ti);
#pragma unroll
          for (int q = 0; q < 8; ++q) { const int i = t + q * NT, kk = i >> 6, j = i & 63; v[q] = (j < d.nvalid) ? d.src[(size_t)(d.k0 + kk) * d.ld + d.col0 + j] : 0.f; } }
      while (ti < T6) {
          const int nti = ti + gridDim.x; float nv[8]; ConvDesc nd = d;
          if (nti < T6) { nd = conv_decode(c, nti);
#pragma unroll
              for (int q = 0; q < 8; ++q) { const int i = t + q * NT, kk = i >> 6, j = i & 63; nv[q] = (j < nd.nvalid) ? nd.src[(size_t)(nd.k0 + kk) * nd.ld + nd.col0 + j] : 0.f; } }
          else {
#pragma unroll
              for (int q = 0; q < 8; ++q) nv[q] = 0.f; }
          __syncthreads();
#pragma unroll
          for (int q = 0; q < 8; ++q) { const int i = t + q * NT; c.lds[(i >> 6) * 65 + (i & 63)] = v[q]; }
          __syncthreads();
          { const int j = t >> 3, kq = t & 7;
            const int js = (j & 32) | (((j >> 2) & 3) << 3) | (((j >> 4) & 1) << 2) | (j & 3);
            const float* lp = c.lds + (kq * 8) * 65 + js; u32x4 w;
            w.x = pack2(lp[0], lp[65]); w.y = pack2(lp[130], lp[195]); w.z = pack2(lp[260], lp[325]); w.w = pack2(lp[390], lp[455]);
            *(u32x4*)(d.dst + (size_t)(d.drow0 + j) * d.K + d.k0 + kq * 8) = w; }
          d = nd; ti = nti;
#pragma unroll
          for (int q = 0; q < 8; ++q) v[q] = nv[q];
      } }
    __syncthreads();
    if (l != 0) return;
    for (int task = blockIdx.x; task < 192; task += gridDim.x) {
        const int ll = task / 96, cb = task % 96, t = tidx(), kq = t >> 6, j = t & 63;
        const float* w = c.in(I_WADA) + (size_t)ll * D * 6144 + cb * 64 + j;
        float a0 = 0.f, a1 = 0.f;
#pragma unroll 16
        for (int k = kq * 128; k < kq * 128 + 128; ++k) { const float wv = w[(size_t)k * 6144]; a0 += siluf_(c.in(I_C)[k]) * wv; a1 += siluf_(c.in(I_CCTX)[k]) * wv; }
        c.lds[t] = a0; c.lds[512 + t] = a1;
        __syncthreads();
        if (t < 128) { const int s = t >> 6, jj = t & 63; float v = 0.f; for (int q = 0; q < 8; ++q) v += c.lds[s * 512 + q * 64 + jj];
            c.W<float>(WS_MODS)[((size_t)ll * 2 + s) * 6144 + cb * 64 + jj] = v + c.in(I_BADA)[(size_t)ll * 6144 + cb * 64 + jj]; }
        __syncthreads();
    }
    for (int i = blockIdx.x * NT + tidx(); i < 2048; i += gridDim.x * NT) { const int pos = i >> 3, e = i & 7; const float ang = (float)pos * (1.0f / powf(10000.0f, (float)(2 * e) / 16.0f));
        c.W<float>(WS_ROPE)[i * 2] = cosf(ang); c.W<float>(WS_ROPE)[i * 2 + 1] = sinf(ang); }
    for (int i = blockIdx.x * NT + tidx(); i < 4096; i += gridDim.x * NT) {
        const int g = (i >> 6) & 15;
        const float lre = c.in(I_SLRE)[i], lim = c.in(I_SLIM)[i], dt = expf(c.in(I_SLOG)[(i >> 6)]);
        (void)g;
        const float mag = expf(lre * dt), lbr = mag * cosf(lim * dt), lbi = mag * sinf(lim * dt);
        const float nr = lbr - 1.0f, ni = lbi, den = lre * lre + lim * lim;
        const float kr = (nr * lre + ni * lim) / den, ki = (ni * lre - nr * lim) / den;
        c.W<float>(WS_S5LB)[i * 2] = lbr; c.W<float>(WS_S5LB)[i * 2 + 1] = lbi;
        for (int cc = 0; cc < 16; ++cc) { const float br = c.in(I_SBRE)[(size_t)i * 16 + cc], bi = c.in(I_SBIM)[(size_t)i * 16 + cc];
            c.W<float>(WS_S5BB)[(size_t)i * 32 + cc] = kr * br - ki * bi; c.W<float>(WS_S5BB)[(size_t)i * 32 + 16 + cc] = kr * bi + ki * br; }
    }
}

__device__ __forceinline__ u32x4 pack8(f32x4 a, f32x4 b) { u32x4 w; w.x = pack2(a.x, a.y); w.y = pack2(a.z, a.w); w.z = pack2(b.x, b.y); w.w = pack2(b.z, b.w); return w; }
__device__ __forceinline__ void phase_norm(const Ctx& c, int which) {
    const int wave = tidx() >> 6, lane = tidx() & 63;
    const float* g = c.in(which == 0 ? I_N1G : I_N2G) + (size_t)c.l * D;
    const int r0 = which == 0 ? 0 : c.row_begin();
    for (int row = r0 + blockIdx.x * 8 + wave; row < ROWS; row += gridDim.x * 8) {
        const float* x = which == 0 ? c.xin_row(row) : c.xout_row(row);
        const float* m = c.mods(row) + (which == 0 ? 0 : 3 * D);
        f32x4 v[4]; float ss = 0.f;
        const int nsl = (row >= CTX) ? 0 : ((c.l == 0 && which == 1) ? 4 : ((c.l == 1 && which == 0) ? 11 : 0));
        if (nsl) { const float* slab = (c.l == 0) ? c.W<float>(WS_SLABW) : c.W<float>(WS_SLABF); const float* gate = c.W<float>(WS_MODS) + 6144 + (c.l == 0 ? 2 : 5) * D;
            const float* xb = (c.l == 0) ? c.in(I_CTX) + (size_t)row * D : c.W<float>(WS_HCTX) + (size_t)row * D;
#pragma unroll
            for (int i = 0; i < 4; ++i) { const int col = (i >> 1) * 512 + lane * 8 + (i & 1) * 4; f32x4 a = (f32x4){0.f, 0.f, 0.f, 0.f};
                for (int k = 0; k < nsl; ++k) a += *(const f32x4*)(slab + ((size_t)k * CTX + row) * D + col);
                v[i] = *(const f32x4*)(xb + col) + *(const f32x4*)(gate + col) * a;
                if (c.l == 0) *(f32x4*)(c.W<float>(WS_HCTX) + (size_t)row * D + col) = v[i];
                ss += v[i].x * v[i].x + v[i].y * v[i].y + v[i].z * v[i].z + v[i].w * v[i].w; } }
        else {
#pragma unroll
            for (int i = 0; i < 4; ++i) { v[i] = *(const f32x4*)(x + (i >> 1) * 512 + lane * 8 + (i & 1) * 4); ss += v[i].x * v[i].x + v[i].y * v[i].y + v[i].z * v[i].z + v[i].w * v[i].w; } }
#pragma unroll
        for (int o = 32; o >= 1; o >>= 1) ss += __shfl_xor(ss, o);
        const float rstd = rsqrtf(ss * (1.0f / D) + 1e-6f);
        bf16* o = c.W<bf16>(WS_HN) + (size_t)row * D;
#pragma unroll
        for (int h = 0; h < 2; ++h) { f32x4 y[2];
#pragma unroll
            for (int e = 0; e < 2; ++e) { const int col = h * 512 + lane * 8 + e * 4; const f32x4 gg = *(const f32x4*)(g + col), sh = *(const f32x4*)(m + col), sc = *(const f32x4*)(m + D + col);
                y[e] = (v[h * 2 + e] * rstd * gg) * (1.0f + sc) + sh; }
            *(u32x4*)(o + h * 512 + lane * 8) = pack8(y[0], y[1]); }
    }
}

__device__ __forceinline__ u32x2 pack4(f32x4 v) { u32x2 w; w.x = pack2(v.x, v.y); w.y = pack2(v.z, v.w); return w; }
struct EpiInproj { static constexpr bool BATCH4 = false; bf16* z; float* za;
    __device__ __forceinline__ void store_row(int row, int col0, f32x4 v00, f32x4 v01, f32x4 v10, f32x4 v11) const {
        if (col0 < NZ) { bf16* p = z + (size_t)row * NZ + col0; *(u32x4*)p = pack8(v00, v01); *(u32x4*)(p + 128) = pack8(v10, v11); }
        else if (col0 < NZ + 32) { float* p = za + (size_t)row * 32 + (col0 - NZ); *(f32x4*)p = v00; *(f32x4*)(p + 4) = v01; } } };
struct EpiGlu { static constexpr bool BATCH4 = false; const bf16* ys5; bf16* y;
    __device__ __forceinline__ u32x4 one(const bf16* pz, f32x4 v, f32x4 u) const { const u32x4 zz = *(const u32x4*)pz; f32x4 o, q;
        o.x = lo2f(zz.x) * sigmoidf_(v.x); o.y = hi2f(zz.x) * sigmoidf_(v.y); o.z = lo2f(zz.y) * sigmoidf_(v.z); o.w = hi2f(zz.y) * sigmoidf_(v.w);
        q.x = lo2f(zz.z) * sigmoidf_(u.x); q.y = hi2f(zz.z) * sigmoidf_(u.y); q.z = lo2f(zz.w) * sigmoidf_(u.z); q.w = hi2f(zz.w) * sigmoidf_(u.w); return pack8(o, q); }
    __device__ __forceinline__ void store_row(int row, int col0, f32x4 v00, f32x4 v01, f32x4 v10, f32x4 v11) const {
        const bf16* pz = ys5 + (size_t)row * 256 + col0; bf16* py = y + (size_t)row * D + col0;
        *(u32x4*)py = one(pz, v00, v01); *(u32x4*)(py + 128) = one(pz + 128, v10, v11); } };
struct EpiResid { static constexpr bool BATCH4 = true; const float* xs_ctx; const float* xs_lat; float* xo_ctx; float* xo_lat; const float* g_ctx; const float* g_lat;
    __device__ __forceinline__ void store_rows4(int row, int col0, const f32x4 (&a)[2][4][2]) const {
        const bool ic = row < CTX; const size_t off = (size_t)(ic ? row : row - CTX) * D + col0;
        const float* xs = (ic ? xs_ctx : xs_lat) + off; float* xo = (ic ? xo_ctx : xo_lat) + off; const float* g = (ic ? g_ctx : g_lat) + col0;
        f32x4 xv[4][2][2];
#pragma unroll
        for (int m = 0; m < 4; ++m)
#pragma unroll
            for (int bj = 0; bj < 2; ++bj)
#pragma unroll
                for (int n = 0; n < 2; ++n) xv[m][bj][n] = *(const f32x4*)(xs + (size_t)m * 16 * D + bj * 128 + n * 4);
#pragma unroll
        for (int bj = 0; bj < 2; ++bj)
#pragma unroll
            for (int n = 0; n < 2; ++n) { const f32x4 gg = *(const f32x4*)(g + bj * 128 + n * 4);
#pragma unroll
                for (int m = 0; m < 4; ++m) *(f32x4*)(xo + (size_t)m * 16 * D + bj * 128 + n * 4) = xv[m][bj][n] + gg * a[bj][m][n]; } }
    __device__ __forceinline__ void store_row(int row, int col0, f32x4 v00, f32x4 v01, f32x4 v10, f32x4 v11) const {
        const bool ic = row < CTX; const size_t off = (size_t)(ic ? row : row - CTX) * D + col0;
        const float* xs = (ic ? xs_ctx : xs_lat) + off; float* xo = (ic ? xo_ctx : xo_lat) + off; const float* g = (ic ? g_ctx : g_lat) + col0;
        *(f32x4*)xo = *(const f32x4*)xs + *(const f32x4*)g * v00; *(f32x4*)(xo + 4) = *(const f32x4*)(xs + 4) + *(const f32x4*)(g + 4) * v01;
        *(f32x4*)(xo + 128) = *(const f32x4*)(xs + 128) + *(const f32x4*)(g + 128) * v10; *(f32x4*)(xo + 132) = *(const f32x4*)(xs + 132) + *(const f32x4*)(g + 132) * v11; } };
__device__ __forceinline__ EpiResid make_resid(const Ctx& c, int gate_off, bool from_in) {
    EpiResid e; float* hc = c.W<float>(WS_HCTX);
    e.xs_ctx = (from_in && c.l == 0) ? c.in(I_CTX) : hc; e.xs_lat = (from_in && c.l == 0) ? c.in(I_X) : c.out;
    e.xo_ctx = hc; e.xo_lat = c.out;
    e.g_ctx = c.W<float>(WS_MODS) + ((size_t)c.l * 2 + 1) * 6144 + gate_off; e.g_lat = c.W<float>(WS_MODS) + ((size_t)c.l * 2) * 6144 + gate_off; return e; }

namespace pg8 {
#define PG8_LAS __attribute__((address_space(3)))
constexpr int BM = 256, BK = 64, HALF = 128, HTB = HALF * BK * 2, STAGE_BYTES = 8 * HTB, NXCD = 8, WGM = 8;
__device__ __forceinline__ int lds_byte(int r, int c) { const int st = (r >> 4) * 2 + (c >> 5), rr = r & 15, cc = c & 31, ob = rr * 64 + cc * 2; return st * 1024 + (ob ^ (((ob >> 9) & 1) << 5)); }
__device__ __forceinline__ void stage_rc(int b, int& R, int& C) { const int st = b / 1024, sb = b % 1024, swz = sb ^ (((sb >> 9) & 1) << 5); R = (st >> 1) * 16 + swz / 64; C = (st & 1) * 32 + (swz % 64) / 2; }
struct Unit { int pm, pn; };
__device__ __forceinline__ bool static_next(int i, int G, int c, int nM, int nN, Unit& u) {
    const int nwg = nM * nN; const long L = (long)i * G + c; if (L >= nwg) return false;
    int wgid = (int)L; { const int q = nwg / NXCD, r = nwg % NXCD, xcd = wgid % NXCD, off = wgid / NXCD; wgid = (xcd < r ? xcd * (q + 1) : r * (q + 1) + (xcd - r) * q) + off; }
    const int nig = WGM * nN, gid = wgid / nig, fm = gid * WGM, gsz = (nM - fm) < WGM ? (nM - fm) : WGM;
    u.pm = fm + ((wgid % nig) % gsz); u.pn = (wgid % nig) / gsz; return true;
}
template <class Epi, class Sched>
__device__ __forceinline__ void gemm_phase(PG8_LAS unsigned char* lds, const int K, const Sched& S, const Epi& E) {
    const int tid = tidx(), wid = __builtin_amdgcn_readfirstlane(tid >> 6), lane = tid & 63, wr = wid >> 2, wc = wid & 3, fr = lane & 15, fq = lane >> 4;
    int sR[2], sC[2];
#pragma unroll
    for (int i = 0; i < 2; ++i) { int R, C; stage_rc(tid * 16 + i * 8192, R, C); sR[i] = R; sC[i] = C; }
    const size_t kstep = (size_t)(BK * 2);
    const unsigned ldsw = (unsigned)wid * 1024u;
    const int aoff = lds_byte(wr * 64 + fr, fq * 8), boff = lds_byte(wc * 32 + fr, fq * 8);
#define PG8_SA(b, h) (((b) * 2 + (h)) * HTB)
#define PG8_SB(b, h) ((4 + (b) * 2 + (h)) * HTB)
#define PG8_STAGE(bufoff, gbase, voff) do { _Pragma("unroll") for (int _i = 0; _i < 2; ++_i) \
        __builtin_amdgcn_global_load_lds((const unsigned*)((const char*)(gbase) + (voff)[_i]), (PG8_LAS unsigned*)(lds + (bufoff) + ldsw + _i * 8192), 16, 0, 0); } while (0)
#define PG8_LDA(dst, b, h) do { _Pragma("unroll") for (int m = 0; m < 4; ++m) _Pragma("unroll") for (int k = 0; k < 2; ++k) dst[m][k] = *(const PG8_LAS bf16x8*)(lds + PG8_SA(b, h) + aoff + m * 2048 + k * 1024); } while (0)
#define PG8_LDB(dst, b, h) do { _Pragma("unroll") for (int n = 0; n < 2; ++n) _Pragma("unroll") for (int k = 0; k < 2; ++k) dst[n][k] = *(const PG8_LAS bf16x8*)(lds + PG8_SB(b, h) + boff + n * 2048 + k * 1024); } while (0)
#define PG8_MMA(ai, bj, At, Bt) do { __builtin_amdgcn_s_setprio(1); _Pragma("unroll") for (int m = 0; m < 4; ++m) _Pragma("unroll") for (int n = 0; n < 2; ++n) _Pragma("unroll") for (int k = 0; k < 2; ++k) \
        acc[ai][bj][m][n] = __builtin_amdgcn_mfma_f32_16x16x32_bf16(Bt[n][k], At[m][k], acc[ai][bj][m][n], 0, 0, 0); __builtin_amdgcn_s_setprio(0); } while (0)
#define PG8_WAIT_V(n) asm volatile("s_waitcnt vmcnt(" #n ")" ::: "memory")
#define PG8_WAIT_L(n) asm volatile("s_waitcnt lgkmcnt(" #n ")" ::: "memory")
#define PG8_BAR __builtin_amdgcn_s_barrier()
#define PG8_SCHED __builtin_amdgcn_sched_barrier(0)
    Unit cur, nxt; int ui = 0;
    if (!S.next(0, cur)) return;
    int Kc = Sched::HETERO ? S.Kof(cur) : K, nt = Kc / BK; const int ldb0 = Sched::HETERO ? S.ldbof(cur) : K;
    unsigned voffB[2], voffBn[2]; size_t hstepB = (size_t)HALF * ldb0 * 2, hstepBn = hstepB;
#pragma unroll
    for (int i = 0; i < 2; ++i) { voffB[i] = (unsigned)(sR[i] * ldb0 + sC[i]) * 2u; voffBn[i] = voffB[i]; }
    f32x4 acc[2][2][4][2];
#pragma unroll
    for (int a = 0; a < 2; ++a)
#pragma unroll
        for (int b = 0; b < 2; ++b)
#pragma unroll
            for (int m = 0; m < 4; ++m)
#pragma unroll
                for (int n = 0; n < 2; ++n) acc[a][b][m][n] = (f32x4){0.f, 0.f, 0.f, 0.f};
    bf16x8 At[4][2], B0[2][2], B1[2][2];
    unsigned oc0[2], oc1[2], on0[2], on1[2];
#pragma unroll
    for (int i = 0; i < 2; ++i) { oc0[i] = S.aoff(cur, 0, sR[i], sC[i]); oc1[i] = S.aoff(cur, 1, sR[i], sC[i]); }
    const char* cA = S.abase(cur); const char* cB = S.bbase(cur);
    PG8_STAGE(PG8_SB(0, 0), cB, voffB); PG8_STAGE(PG8_SB(0, 1), cB + hstepB, voffB); PG8_STAGE(PG8_SA(0, 0), cA, oc0); PG8_STAGE(PG8_SA(0, 1), cA, oc1);
    if (wr == 1) PG8_BAR;
    PG8_WAIT_V(2); PG8_BAR;
    PG8_STAGE(PG8_SB(1, 0), cB + kstep, voffB); PG8_STAGE(PG8_SA(1, 0), cA + kstep, oc0); PG8_STAGE(PG8_SB(1, 1), cB + hstepB + kstep, voffB);
    PG8_WAIT_V(6); PG8_BAR;
    for (;;) {
        const bool has_next = S.next(ui + 1, nxt);
        const char* nA = has_next ? S.abase(nxt) : cA; const char* nB = has_next ? S.bbase(nxt) : cB;
        int Kn = Kc;
        if (Sched::HETERO) { Kn = has_next ? S.Kof(nxt) : Kc; const int ldbn = has_next ? S.ldbof(nxt) : (int)(hstepB / (HALF * 2)); hstepBn = (size_t)HALF * ldbn * 2;
#pragma unroll
            for (int i = 0; i < 2; ++i) voffBn[i] = (unsigned)(sR[i] * ldbn + sC[i]) * 2u; }
#pragma unroll
        for (int i = 0; i < 2; ++i) { if (Sched::AMAP) { on0[i] = has_next ? S.aoff(nxt, 0, sR[i], sC[i]) : oc0[i]; on1[i] = has_next ? S.aoff(nxt, 1, sR[i], sC[i]) : oc1[i]; } else { on0[i] = oc0[i]; on1[i] = oc1[i]; } }
        for (int t = 0; t < nt; t += 2) {
            const bool last = (t == nt - 2);
            const char* a1 = cA + (size_t)(t + 1) * kstep;
            const char* a2 = last ? nA : cA + (size_t)(t + 2) * kstep; const char* b2 = last ? nB : cB + (size_t)(t + 2) * kstep;
            const char* a3 = a2 + kstep; const char* b3 = b2 + kstep;
            unsigned o20[2], o21[2];
#pragma unroll
            for (int i = 0; i < 2; ++i) { o20[i] = last ? on0[i] : oc0[i]; o21[i] = last ? on1[i] : oc1[i]; }
            unsigned vb2[2]; size_t hs2 = hstepB;
#pragma unroll
            for (int i = 0; i < 2; ++i) vb2[i] = (Sched::HETERO && last) ? voffBn[i] : voffB[i];
            if (Sched::HETERO && last) hs2 = hstepBn;
            PG8_LDB(B0, 0, 0); PG8_LDB(B1, 0, 1); PG8_SCHED; PG8_LDA(At, 0, 0); PG8_STAGE(PG8_SA(1, 1), a1, oc1);
            PG8_WAIT_V(8); PG8_WAIT_L(0); PG8_BAR; PG8_MMA(0, 0, At, B0); PG8_MMA(0, 1, At, B1); PG8_BAR; PG8_SCHED;
            PG8_LDA(At, 0, 1); PG8_STAGE(PG8_SB(0, 0), b2, vb2); PG8_STAGE(PG8_SB(0, 1), b2 + hs2, vb2); PG8_STAGE(PG8_SA(0, 0), a2, o20);
            PG8_WAIT_V(8); PG8_WAIT_L(0); PG8_BAR; PG8_MMA(1, 0, At, B0); PG8_MMA(1, 1, At, B1); PG8_BAR; PG8_SCHED;
            PG8_LDB(B0, 1, 0); PG8_LDB(B1, 1, 1); PG8_SCHED; PG8_LDA(At, 1, 0); PG8_STAGE(PG8_SA(0, 1), a2, o21);
            PG8_WAIT_V(8); PG8_WAIT_L(0); PG8_BAR; PG8_MMA(0, 0, At, B0); PG8_MMA(0, 1, At, B1); PG8_BAR; PG8_SCHED;
            PG8_LDA(At, 1, 1); PG8_STAGE(PG8_SB(1, 0), b3, vb2); PG8_STAGE(PG8_SB(1, 1), b3 + hs2, vb2); PG8_STAGE(PG8_SA(1, 0), a3, o20);
            PG8_WAIT_V(8); PG8_WAIT_L(0); PG8_BAR; PG8_MMA(1, 0, At, B0); PG8_MMA(1, 1, At, B1); PG8_BAR; PG8_SCHED;
        }
        if (wr == 0) PG8_BAR;
        E(acc, cur, wr, wc, fr, fq);
        if (!has_next) break;
#pragma unroll
        for (int a = 0; a < 2; ++a)
#pragma unroll
            for (int b = 0; b < 2; ++b)
#pragma unroll
                for (int m = 0; m < 4; ++m)
#pragma unroll
                    for (int n = 0; n < 2; ++n) acc[a][b][m][n] = (f32x4){0.f, 0.f, 0.f, 0.f};
        cur = nxt; cA = nA; cB = nB; ++ui;
        if (Sched::HETERO) { Kc = Kn; nt = Kc / BK; hstepB = hstepBn;
#pragma unroll
            for (int i = 0; i < 2; ++i) voffB[i] = voffBn[i]; }
        if (wr == 1) PG8_BAR;
#pragma unroll
        for (int i = 0; i < 2; ++i) { oc0[i] = on0[i]; oc1[i] = on1[i]; }
    }
    PG8_WAIT_V(0);
    PG8_BAR;
#undef PG8_SA
#undef PG8_SB
#undef PG8_STAGE
#undef PG8_LDA
#undef PG8_LDB
#undef PG8_MMA
#undef PG8_WAIT_V
#undef PG8_WAIT_L
#undef PG8_BAR
#undef PG8_SCHED
}
struct SchedLin { static constexpr bool AMAP = false, HETERO = false; __device__ __forceinline__ int Kof(const Unit&) const { return K; } __device__ __forceinline__ int ldbof(const Unit&) const { return K; }
    const bf16* A; const bf16* Bt; int lda, K, row0, nM, nN, G, c;
    __device__ __forceinline__ bool next(int i, Unit& u) const { return static_next(i, G, c, nM, nN, u); }
    __device__ __forceinline__ const char* abase(const Unit& u) const { return (const char*)(A + (size_t)(row0 + BM * u.pm) * lda); }
    __device__ __forceinline__ const char* bbase(const Unit& u) const { return (const char*)(Bt + (size_t)BM * u.pn * K); }
    __device__ __forceinline__ unsigned aoff(const Unit&, int h, int R, int C) const { return (unsigned)((h * HALF + R) * lda + C) * 2u; }
};
template <class F> struct EpiLin { F f; int row0;
    __device__ __forceinline__ void operator()(const f32x4 (&acc)[2][2][4][2], const Unit& u, int wr, int wc, int fr, int fq) const {
        const int col0 = u.pn * BM + wc * 32 + 8 * fq;
#pragma unroll
        for (int ai = 0; ai < 2; ++ai) {
            if constexpr (F::BATCH4) {
                f.store_rows4(row0 + u.pm * BM + ai * HALF + wr * 64 + fr, col0, acc[ai]);
                asm volatile("" ::: "memory");
            } else {
#pragma unroll
                for (int m = 0; m < 4; ++m) { const int row = row0 + u.pm * BM + ai * HALF + wr * 64 + m * 16 + fr;
                    f.store_row(row, col0, acc[ai][0][m][0], acc[ai][0][m][1], acc[ai][1][m][0], acc[ai][1][m][1]);
                    asm volatile("" ::: "memory"); }
            } }
    } };
struct SchedRes { static constexpr bool AMAP = false, HETERO = true; const bf16* A; const bf16* Bt; int lda, K, nks, G, c;
    __device__ __forceinline__ bool next(int i, Unit& u) const {
        if (i == 0) { Unit v; if (!static_next(0, G, c, 64, 4, v)) return false; u.pm = v.pm + 1; u.pn = v.pn; return true; }
        if (i == 1 && c < 4 * nks) { u.pm = 0; u.pn = (c & 3) | ((c >> 2) << 2) | 64; return true; }
        return false; }
    __device__ __forceinline__ int Kof(const Unit& u) const { return (u.pn & 64) ? 256 : K; }
    __device__ __forceinline__ int ldbof(const Unit&) const { return K; }
    __device__ __forceinline__ const char* abase(const Unit& u) const { return (u.pn & 64) ? (const char*)(A + ((u.pn >> 2) & 15) * 256) : (const char*)(A + (size_t)(BM * u.pm) * lda); }
    __device__ __forceinline__ const char* bbase(const Unit& u) const { return (u.pn & 64) ? (const char*)(Bt + (size_t)BM * (u.pn & 3) * K + ((u.pn >> 2) & 15) * 256) : (const char*)(Bt + (size_t)BM * u.pn * K); }
    __device__ __forceinline__ unsigned aoff(const Unit&, int h, int R, int C) const { return (unsigned)((h * HALF + R) * lda + C) * 2u; } };
template <class F> struct EpiRes { F f; float* slab;
    __device__ __forceinline__ void operator()(const f32x4 (&acc)[2][2][4][2], const Unit& u, int wr, int wc, int fr, int fq) const {
        if (u.pn & 64) { float* sp = slab + ((size_t)((u.pn >> 2) & 15) * CTX + wr * 64 + fr) * D + (u.pn & 3) * BM + wc * 32 + 8 * fq;
#pragma unroll
            for (int ai = 0; ai < 2; ++ai)
#pragma unroll
                for (int m = 0; m < 4; ++m)
#pragma unroll
                    for (int bj = 0; bj < 2; ++bj)
#pragma unroll
                        for (int n = 0; n < 2; ++n) *(f32x4*)(sp + (size_t)(ai * HALF + m * 16) * D + bj * HALF + n * 4) = acc[ai][bj][m][n];
        } else { const int col0 = u.pn * BM + wc * 32 + 8 * fq;
#pragma unroll
            for (int ai = 0; ai < 2; ++ai) { f.store_rows4(u.pm * BM + ai * HALF + wr * 64 + fr, col0, acc[ai]); asm volatile("" ::: "memory"); } }
    } };
}
template <class F>
__device__ __forceinline__ void gemm_lin(const bf16* A, int lda, const bf16* Bt, int row0, int nrows, int N, int K, const F& f, float* lds) {
    pg8::SchedLin S{A, Bt, lda, K, row0, nrows / 256, N / 256, (int)gridDim.x, (int)blockIdx.x};
    pg8::EpiLin<F> E{f, row0};
    pg8::gemm_phase(( __attribute__((address_space(3))) unsigned char*)lds, K, S, E);
}

template <class F>
__device__ __forceinline__ void gemm_res_l0(const bf16* A, int lda, const bf16* Bt, int K, int nks, const F& f, float* slab, float* lds) {
    pg8::SchedRes S{A, Bt, lda, K, nks, (int)gridDim.x, (int)blockIdx.x};
    pg8::EpiRes<F> E{f, slab};
    pg8::gemm_phase((__attribute__((address_space(3))) unsigned char*)lds, K, S, E);
}
namespace pg8 {
struct MergeGeo { int mode, G, c;
    __device__ __forceinline__ bool decode(int i, Unit& u) const {
        if (mode == 2) { const int idx = c - 64; if (idx < 0 || idx >= 12 || i >= 2) return false; u.pm = 0; u.pn = (idx / 3) | ((1 + idx % 3) << 2) | (i << 4) | (1 << 5); return true; }
        if (i < 8) { const int s = c; if (s >= 256) return false; const int sp = (s & 7) * 32 + (s >> 3); u.pm = CTX + (sp >> 2) * 256; u.pn = (sp & 3) | ((i >> 1) << 2) | ((i & 1) << 4); return true; }
        if (mode == 1 && c < 4 && i < 10) { u.pm = 0; u.pn = c | (0 << 2) | ((i & 1) << 4) | (2 << 5); return true; }
        return false; } };
struct SchedPG { static constexpr bool AMAP = false, HETERO = true; const bf16* hn; const bf16* y; const bf16* wg; const bf16* wb; MergeGeo geo;
    __device__ __forceinline__ bool next(int i, Unit& u) const { return geo.decode(i, u); }
    __device__ __forceinline__ int Kof(const Unit& u) const { return (u.pn & 16) ? D : 256; }
    __device__ __forceinline__ int ldbof(const Unit& u) const { return (u.pn & 16) ? D : 256; }
    __device__ __forceinline__ const char* abase(const Unit& u) const { const int n = (u.pn >> 2) & 3;
        return (u.pn & 16) ? (const char*)(hn + (size_t)u.pm * D) : (const char*)(y + (size_t)u.pm * D + n * 256); }
    __device__ __forceinline__ const char* bbase(const Unit& u) const { const int n = (u.pn >> 2) & 3, dt = u.pn & 3;
        return (u.pn & 16) ? (const char*)(wg + ((size_t)n * D + (size_t)dt * BM) * D) : (const char*)(wb + ((size_t)n * D + (size_t)dt * BM) * 256); }
    __device__ __forceinline__ unsigned aoff(const Unit&, int h, int R, int C) const { return (unsigned)((h * HALF + R) * D + C) * 2u; } };
struct EpiPG { unsigned char* scr; unsigned char* parts; bf16* merged;
    __device__ __forceinline__ void operator()(const f32x4 (&acc)[2][2][4][2], const Unit& u, int wr, int wc, int fr, int fq) const {
        const size_t lo = (size_t)tidx() * 16; unsigned char* p = scr + lo;
        const int dt = u.pn & 3, n = (u.pn >> 2) & 3, kind = u.pn >> 5;
        if (!(u.pn & 16)) {
#pragma unroll
            for (int ai = 0; ai < 2; ++ai)
#pragma unroll
                for (int bj = 0; bj < 2; ++bj)
#pragma unroll
                    for (int m = 0; m < 4; ++m) { const u32x2 w0 = pack4(acc[ai][bj][m][0]), w1 = pack4(acc[ai][bj][m][1]);
                        *(u32x4*)(p + ((ai * 2 + bj) * 4 + m) * 8192) = (u32x4){w0.x, w0.y, w1.x, w1.y}; }
        } else {
            const int row0 = u.pm; const bool part = (kind == 1), fin = (kind == 2), first = (n == 0) || part;
            unsigned char* q = parts + (size_t)(dt * 3 + (part ? n - 1 : 0)) * 131072 + lo;
            if (!fin) {
#pragma unroll
                for (int ai = 0; ai < 2; ++ai) {
                    u32x4 pw[2][4], ow[2][4];
                    bf16* mp = merged + (size_t)(row0 + ai * HALF + wr * 64 + fr) * D + dt * BM + wc * 32 + 8 * fq;
#pragma unroll
                    for (int bj = 0; bj < 2; ++bj)
#pragma unroll
                        for (int m = 0; m < 4; ++m) { pw[bj][m] = *(const u32x4*)(p + ((ai * 2 + bj) * 4 + m) * 8192);
                            ow[bj][m] = first ? (u32x4){0u, 0u, 0u, 0u} : *(const u32x4*)(mp + (size_t)m * 16 * D + bj * HALF); }
#pragma unroll
                    for (int bj = 0; bj < 2; ++bj)
#pragma unroll
                        for (int m = 0; m < 4; ++m) { const f32x4 a = acc[ai][bj][m][0], b = acc[ai][bj][m][1]; const u32x4 w = pw[bj][m], o = ow[bj][m]; f32x4 v, u2;
                            v.x = sigmoidf_(a.x) * lo2f(w.x) + lo2f(o.x); v.y = sigmoidf_(a.y) * hi2f(w.x) + hi2f(o.x); v.z = sigmoidf_(a.z) * lo2f(w.y) + lo2f(o.y); v.w = sigmoidf_(a.w) * hi2f(w.y) + hi2f(o.y);
                            u2.x = sigmoidf_(b.x) * lo2f(w.z) + lo2f(o.z); u2.y = sigmoidf_(b.y) * hi2f(w.z) + hi2f(o.z); u2.z = sigmoidf_(b.z) * lo2f(w.w) + lo2f(o.w); u2.w = sigmoidf_(b.w) * hi2f(w.w) + hi2f(o.w);
                            if (part) *(u32x4*)(q + ((ai * 2 + bj) * 4 + m) * 8192) = pack8(v, u2);
                            else *(u32x4*)(mp + (size_t)m * 16 * D + bj * HALF) = pack8(v, u2); }
                    asm volatile("" ::: "memory"); }
            } else {
#pragma unroll
                for (int ai = 0; ai < 2; ++ai)
#pragma unroll
                    for (int bj = 0; bj < 2; ++bj)
#pragma unroll
                        for (int mh = 0; mh < 2; ++mh) {
                            u32x4 pw[2], e0[2], e1[2], e2[2];
                            bf16* mp = merged + (size_t)(row0 + ai * HALF + wr * 64 + mh * 32 + fr) * D + dt * BM + wc * 32 + 8 * fq + bj * HALF;
#pragma unroll
                            for (int m2 = 0; m2 < 2; ++m2) { const int fo = ((ai * 2 + bj) * 4 + mh * 2 + m2) * 8192; pw[m2] = *(const u32x4*)(p + fo);
                                e0[m2] = *(const u32x4*)(q + fo); e1[m2] = *(const u32x4*)(q + 131072 + fo); e2[m2] = *(const u32x4*)(q + 262144 + fo); }
#pragma unroll
                            for (int m2 = 0; m2 < 2; ++m2) { const f32x4 a = acc[ai][bj][mh * 2 + m2][0], b = acc[ai][bj][mh * 2 + m2][1]; const u32x4 w = pw[m2], x0 = e0[m2], x1 = e1[m2], x2 = e2[m2]; f32x4 v, u2;
                                v.x = sigmoidf_(a.x) * lo2f(w.x) + ((lo2f(x0.x) + lo2f(x1.x)) + lo2f(x2.x)); v.y = sigmoidf_(a.y) * hi2f(w.x) + ((hi2f(x0.x) + hi2f(x1.x)) + hi2f(x2.x));
                                v.z = sigmoidf_(a.z) * lo2f(w.y) + ((lo2f(x0.y) + lo2f(x1.y)) + lo2f(x2.y)); v.w = sigmoidf_(a.w) * hi2f(w.y) + ((hi2f(x0.y) + hi2f(x1.y)) + hi2f(x2.y));
                                u2.x = sigmoidf_(b.x) * lo2f(w.z) + ((lo2f(x0.z) + lo2f(x1.z)) + lo2f(x2.z)); u2.y = sigmoidf_(b.y) * hi2f(w.z) + ((hi2f(x0.z) + hi2f(x1.z)) + hi2f(x2.z));
                                u2.z = sigmoidf_(b.z) * lo2f(w.w) + ((lo2f(x0.w) + lo2f(x1.w)) + lo2f(x2.w)); u2.w = sigmoidf_(b.w) * hi2f(w.w) + ((hi2f(x0.w) + hi2f(x1.w)) + hi2f(x2.w));
                                *(u32x4*)(mp + (size_t)m2 * 16 * D) = pack8(v, u2); }
                            asm volatile("" ::: "memory"); }
            }
        }
    } };
struct SchedUp { static constexpr bool AMAP = true, HETERO = false; __device__ __forceinline__ int Kof(const Unit&) const { return D; } __device__ __forceinline__ int ldbof(const Unit&) const { return D; } const bf16* hn; const bf16* Bt; int nctxu, nM, nN, G, c;
    __device__ __forceinline__ bool next(int i, Unit& u) const { return static_next(i, G, c, nM, nN, u); }
    __device__ __forceinline__ const char* abase(const Unit&) const { return (const char*)hn; }
    __device__ __forceinline__ const char* bbase(const Unit& u) const { return (const char*)(Bt + (size_t)BM * u.pn * D); }
    __device__ __forceinline__ unsigned aoff(const Unit& u, int h, int R, int C) const {
        const int wr = R >> 6, m = (R >> 4) & 3, fr = R & 15, i = 8 * fr + 4 * h + m; const bool ic = u.pm < nctxu;
        const int run = 2 * (ic ? u.pm : u.pm - nctxu) + wr, seglen = ic ? CTX : SEQ; int t = 126 * run - 1 + i; t = t < 0 ? 0 : (t >= seglen ? seglen - 1 : t);
        return (unsigned)(((ic ? 0 : CTX) + t) * D + C) * 2u; } };
struct EpiUp { bf16* act; const float* cw; const float* cb; int nctxu;
    __device__ __forceinline__ void operator()(const f32x4 (&acc)[2][2][4][2], const Unit& u, int wr, int wc, int fr, int fq) const {
        const bool ic = u.pm < nctxu; const int run = 2 * (ic ? u.pm : u.pm - nctxu) + wr, seglen = ic ? CTX : SEQ, seg0 = ic ? 0 : CTX;
        const int t0 = 126 * run - 1 + 8 * fr;
        const int lane = tidx() & 63;
        u32x2 held[8];
#pragma unroll
        for (int n = 0; n < 2; ++n) {
            const int ch = 128 * u.pn + 32 * wc + 8 * fq + 4 * n;
            const f32x4 w0 = *(const f32x4*)(cw + ch), w1 = *(const f32x4*)(cw + DFF + ch), w2 = *(const f32x4*)(cw + 2 * DFF + ch), bb = *(const f32x4*)(cb + ch);
            f32x4 g[8];
#pragma unroll
            for (int j = 0; j < 8; ++j) { const int t = t0 + j; const bool ok = t >= 0 && t < seglen; g[j] = ok ? acc[j >> 2][1][j & 3][n] : (f32x4){0.f, 0.f, 0.f, 0.f}; }
            f32x4 prev, next;
            prev.x = __shfl(g[7].x, lane - 1); prev.y = __shfl(g[7].y, lane - 1); prev.z = __shfl(g[7].z, lane - 1); prev.w = __shfl(g[7].w, lane - 1);
            next.x = __shfl(g[0].x, lane + 1); next.y = __shfl(g[0].y, lane + 1); next.z = __shfl(g[0].z, lane + 1); next.w = __shfl(g[0].w, lane + 1);
#pragma unroll
            for (int j = 0; j < 8; ++j) { const int i = 8 * fr + j, t = t0 + j;
                const f32x4 gm = (j == 0) ? prev : g[j == 0 ? 0 : j - 1], gp = (j == 7) ? next : g[j == 7 ? 7 : j + 1];
                const f32x4 cv = w0 * gm + w1 * g[j] + w2 * gp + bb; const f32x4 a = acc[j >> 2][0][j & 3][n]; f32x4 o;
                o.x = gelu_tanh(cv.x) * a.x; o.y = gelu_tanh(cv.y) * a.y; o.z = gelu_tanh(cv.z) * a.z; o.w = gelu_tanh(cv.w) * a.w;
                const u32x2 pk = pack4(o);
                if (n == 0) held[j] = pk;
                else if (i >= 1 && i <= 126 && t >= 0 && t < seglen) *(u32x4*)(act + (size_t)(seg0 + t) * DFF + ch - 4) = (u32x4){held[j].x, held[j].y, pk.x, pk.y}; }
        }
    } };
}
constexpr size_t WS_MERGED = WS_S5END;
static_assert(WS_END - WS_S5END >= (size_t)ROWS * D * 2, "merged alias does not fit");
__device__ __forceinline__ void phase_merge_pg(const Ctx& c, const int mode) {
    pg8::MergeGeo geo{mode, (int)gridDim.x, (int)blockIdx.x};
    pg8::SchedPG S{c.W<bf16>(WS_HN), c.W<bf16>(WS_Y), c.W<bf16>(WS_WGT), c.W<bf16>(WS_WBRT), geo};
    pg8::EpiPG E{c.W<unsigned char>(WS_Z) + (size_t)blockIdx.x * 131072, c.W<unsigned char>(WS_Z) + (size_t)256 * 131072, c.W<bf16>(WS_MERGED)};
    pg8::gemm_phase((__attribute__((address_space(3))) unsigned char*)c.lds, D, S, E);
}
__device__ __forceinline__ void phase_ffn_up_pg(const Ctx& c) {
    const int nctxu = (c.l == DEPTH - 1) ? 0 : 2, nM = nctxu + 66;
    pg8::SchedUp S{c.W<bf16>(WS_HN), c.W<bf16>(WS_WUPT), nctxu, nM, DFF * 2 / 256, (int)gridDim.x, (int)blockIdx.x};
    pg8::EpiUp E{c.W<bf16>(WS_Z), c.in(I_FCW) + (size_t)c.l * 3 * DFF, c.in(I_FCB) + (size_t)c.l * DFF, nctxu};
    pg8::gemm_phase((__attribute__((address_space(3))) unsigned char*)c.lds, D, S, E);
}

__device__ __forceinline__ void da_prep(const Ctx& c, const int bid, const int nb) {
    const int wave = tidx() >> 6, lane = tidx() & 63, vec = lane >> 2, sub = lane & 3;
    const bool isq = vec < 8;
    const float* gain = c.in(isq ? I_DQN : I_DKN) + (size_t)c.l * 32 + sub * 8;
    const float qscale = 0.17677669529663687f * 1.4426950408889634f;
    bf16* z = c.W<bf16>(WS_Z);
    for (int row = bid * 8 + wave; row < ROWS; row += nb * 8) {
        bf16* pz = z + (size_t)row * NZ + (isq ? ZC_DAQ : ZC_DAK) + (vec & 7) * 32 + sub * 8;
        const u32x4 raw = *(const u32x4*)pz;
        float x[8] = {lo2f(raw.x), hi2f(raw.x), lo2f(raw.y), hi2f(raw.y), lo2f(raw.z), hi2f(raw.z), lo2f(raw.w), hi2f(raw.w)};
        float ss = 0.f;
#pragma unroll
        for (int e = 0; e < 8; ++e) ss += x[e] * x[e];
        ss += __shfl_xor(ss, 1); ss += __shfl_xor(ss, 2);
        const float rstd = rsqrtf(ss * (1.0f / 32.0f) + 1e-6f);
#pragma unroll
        for (int e = 0; e < 8; ++e) x[e] = x[e] * rstd * gain[e];
        if (row >= CTX) {
            const int tok = row - CTX; const float* rt = c.W<float>(WS_ROPE) + ((sub < 2) ? (tok >> 6) : (tok & 63)) * 16;
#pragma unroll
            for (int e = 0; e < 8; ++e) { const float cs = rt[e * 2], sn = rt[e * 2 + 1]; const float other = __shfl_xor(x[e], 1);
                x[e] = (sub & 1) ? (other * sn + x[e] * cs) : (x[e] * cs - other * sn); }
        }
        if (isq) {
#pragma unroll
            for (int e = 0; e < 8; ++e) x[e] *= qscale; }
        u32x4 w; w.x = pack2(x[0], x[1]); w.y = pack2(x[2], x[3]); w.z = pack2(x[4], x[5]); w.w = pack2(x[6], x[7]);
        *(u32x4*)pz = w;
    }
}

__device__ __forceinline__ void s5_mfma(const Ctx& c, const bool final_pass) {
    const int tid = tidx(), wave = tid >> 6, lane = tid & 63, r = lane & 31, hh = lane >> 5, cq = lane & 15, q4 = lane >> 4;
    unsigned char* hb = (unsigned char*)c.lds + wave * 8704;
    const bf16* z = c.W<bf16>(WS_Z);
    const int c0 = (final_pass && c.l == DEPTH - 1) ? 4 : 0;
    const int g = wave + 8 * ((int)blockIdx.x & 1);
    float lbr2[2][2], lbi2[2][2]; bf16x8 cmB2[2][4];
#pragma unroll
    for (int d = 0; d < 2; ++d) { const int sib = ((c.l * 2 + d) * 16 + g) * 64;
#pragma unroll
        for (int j = 0; j < 2; ++j) { const int si = sib + j * 32 + r; lbr2[d][j] = c.W<float>(WS_S5LB)[si * 2]; lbi2[d][j] = c.W<float>(WS_S5LB)[si * 2 + 1]; }
        if (final_pass) { const size_t cix = ((size_t)((c.l * 2 + d) * 16 + g) * 16 + cq) * 64;
#pragma unroll
            for (int s4 = 0; s4 < 4; ++s4) { const f32x4 re = *(const f32x4*)(c.in(I_SCRE) + cix + 16 * s4 + 4 * q4), im = *(const f32x4*)(c.in(I_SCIM) + cix + 16 * s4 + 4 * q4);
                cmB2[d][s4] = __builtin_bit_cast(bf16x8, __builtin_convertvector((f32x8){re.x, -im.x, re.y, -im.y, re.z, -im.z, re.w, -im.w}, bf16v8)); } } }
    for (int task = c0 * 2 + blockIdx.x; task < NCHUNK * 2; task += gridDim.x) {
        const int ch = task >> 1;
        f32x4 yacc[4];
        if (final_pass) { const float dsk = c.in(I_SD)[(size_t)c.l * 256 + g * 16 + cq];
#pragma unroll
            for (int tb = 0; tb < 4; ++tb)
#pragma unroll
                for (int rg = 0; rg < 4; ++rg) yacc[tb][rg] = bf2f(z[(size_t)(ch * 64 + tb * 16 + 4 * q4 + rg) * NZ + ZC_SSM + g * 16 + cq]) * dsk; }
#pragma unroll
        for (int d = 0; d < 2; ++d) {
            const int sib = ((c.l * 2 + d) * 16 + g) * 64;
            float lbr[2], lbi[2], hr[2], hi[2]; bf16x8 cmB[4];
#pragma unroll
            for (int j = 0; j < 2; ++j) { lbr[j] = lbr2[d][j]; lbi[j] = lbi2[d][j];
                if (final_pass) { const float* st = c.W<float>(WS_S5START) + ((size_t)(ch * 2 + d) * 16 + g) * 128 + (j * 32 + r) * 2; hr[j] = st[0]; hi[j] = st[1]; } else { hr[j] = 0.f; hi[j] = 0.f; } }
            if (final_pass) {
#pragma unroll
                for (int s4 = 0; s4 < 4; ++s4) cmB[s4] = cmB2[d][s4]; }
#pragma unroll
            for (int mbi = 0; mbi < 2; ++mbi) { const int mb = d ? 1 - mbi : mbi;
                f32x16 X0, X1, X2, X3;
#pragma unroll
                for (int i = 0; i < 16; ++i) { X0[i] = 0.f; X1[i] = 0.f; X2[i] = 0.f; X3[i] = 0.f; }
                { int zo = 0; asm volatile("" : "+v"(zo));
                  const bf16x8 afm = *(const bf16x8*)(z + (size_t)(ch * 64 + mb * 32 + r) * NZ + ZC_SSM + g * 16 + 8 * hh + zo); bf16x8 bfr[4];
#pragma unroll
                  for (int nb = 0; nb < 4; ++nb) { const float* pb = c.W<float>(WS_S5BB) + (size_t)(sib + (nb & 1) * 32 + r) * 32 + (nb >> 1) * 16 + 8 * hh + zo; const f32x4 b0 = *(const f32x4*)pb, b1 = *(const f32x4*)(pb + 4);
                      bfr[nb] = __builtin_bit_cast(bf16x8, __builtin_convertvector((f32x8){b0.x, b0.y, b0.z, b0.w, b1.x, b1.y, b1.z, b1.w}, bf16v8)); }
                  X0 = MFMA32(afm, bfr[0], X0); X1 = MFMA32(afm, bfr[1], X1); X2 = MFMA32(afm, bfr[2], X2); X3 = MFMA32(afm, bfr[3], X3); }
#define S5_SEG(XR, XI, J, G, FIRST_HH, K0, K1, K2, K3) do { \
                    const float ar = lbr[J], ai = lbi[J]; \
                    const float tr0 = ar * hr[J] - ai * hi[J] + XR[4 * (G) + K0], ti0 = ar * hi[J] + ai * hr[J] + XI[4 * (G) + K0]; \
                    const float tr1 = ar * tr0 - ai * ti0 + XR[4 * (G) + K1], ti1 = ar * ti0 + ai * tr0 + XI[4 * (G) + K1]; \
                    const float tr2 = ar * tr1 - ai * ti1 + XR[4 * (G) + K2], ti2 = ar * ti1 + ai * tr1 + XI[4 * (G) + K2]; \
                    const float tr3 = ar * tr2 - ai * ti2 + XR[4 * (G) + K3], ti3 = ar * ti2 + ai * tr2 + XI[4 * (G) + K3]; \
                    const float pr_ = __shfl_xor(tr3, 32), pi_ = __shfl_xor(ti3, 32); \
                    const float ur0 = ar * pr_ - ai * pi_ + XR[4 * (G) + K0], ui0 = ar * pi_ + ai * pr_ + XI[4 * (G) + K0]; \
                    const float ur1 = ar * ur0 - ai * ui0 + XR[4 * (G) + K1], ui1 = ar * ui0 + ai * ur0 + XI[4 * (G) + K1]; \
                    const float ur2 = ar * ur1 - ai * ui1 + XR[4 * (G) + K2], ui2 = ar * ui1 + ai * ur1 + XI[4 * (G) + K2]; \
                    const float ur3 = ar * ur2 - ai * ui2 + XR[4 * (G) + K3], ui3 = ar * ui2 + ai * ur2 + XI[4 * (G) + K3]; \
                    const bool fst = (hh == (FIRST_HH)); \
                    XR[4 * (G) + K0] = fst ? tr0 : ur0; XI[4 * (G) + K0] = fst ? ti0 : ui0; XR[4 * (G) + K1] = fst ? tr1 : ur1; XI[4 * (G) + K1] = fst ? ti1 : ui1; \
                    XR[4 * (G) + K2] = fst ? tr2 : ur2; XI[4 * (G) + K2] = fst ? ti2 : ui2; XR[4 * (G) + K3] = fst ? tr3 : ur3; XI[4 * (G) + K3] = fst ? ti3 : ui3; \
                    const float qr_ = __shfl_xor(ur3, 32), qi_ = __shfl_xor(ui3, 32); hr[J] = fst ? qr_ : ur3; hi[J] = fst ? qi_ : ui3; } while (0)
                if (d == 0) { S5_SEG(X0, X2, 0, 0, 0, 0, 1, 2, 3); S5_SEG(X1, X3, 1, 0, 0, 0, 1, 2, 3); S5_SEG(X0, X2, 0, 1, 0, 0, 1, 2, 3); S5_SEG(X1, X3, 1, 1, 0, 0, 1, 2, 3);
                              S5_SEG(X0, X2, 0, 2, 0, 0, 1, 2, 3); S5_SEG(X1, X3, 1, 2, 0, 0, 1, 2, 3); S5_SEG(X0, X2, 0, 3, 0, 0, 1, 2, 3); S5_SEG(X1, X3, 1, 3, 0, 0, 1, 2, 3); }
                else        { S5_SEG(X0, X2, 0, 3, 1, 3, 2, 1, 0); S5_SEG(X1, X3, 1, 3, 1, 3, 2, 1, 0); S5_SEG(X0, X2, 0, 2, 1, 3, 2, 1, 0); S5_SEG(X1, X3, 1, 2, 1, 3, 2, 1, 0);
                              S5_SEG(X0, X2, 0, 1, 1, 3, 2, 1, 0); S5_SEG(X1, X3, 1, 1, 1, 3, 2, 1, 0); S5_SEG(X0, X2, 0, 0, 1, 3, 2, 1, 0); S5_SEG(X1, X3, 1, 0, 1, 3, 2, 1, 0); }
#undef S5_SEG
                if (final_pass) {
#pragma unroll
                    for (int i = 0; i < 16; ++i) { const int tl = (i & 3) + 8 * (i >> 2) + 4 * hh;
                        *(unsigned*)(hb + tl * 272 + r * 4) = pack2(X0[i], X2[i]); *(unsigned*)(hb + tl * 272 + (32 + r) * 4) = pack2(X1[i], X3[i]); }
#pragma unroll
                    for (int tb2 = 0; tb2 < 2; ++tb2)
#pragma unroll
                        for (int s4 = 0; s4 < 4; ++s4) { const bf16x8 a16 = *(const bf16x8*)(hb + (tb2 * 16 + cq) * 272 + (32 * s4 + 8 * q4) * 2);
                            if (mb == 0) yacc[tb2] = __builtin_amdgcn_mfma_f32_16x16x32_bf16(a16, cmB[s4], yacc[tb2], 0, 0, 0);
                            else yacc[2 + tb2] = __builtin_amdgcn_mfma_f32_16x16x32_bf16(a16, cmB[s4], yacc[2 + tb2], 0, 0, 0); } } }
            if (!final_pass) {
#pragma unroll
                for (int j = 0; j < 2; ++j) if (hh == 0) { float* e = c.W<float>(WS_S5END) + ((size_t)(ch * 2 + d) * 16 + g) * 128 + (j * 32 + r) * 2; e[0] = hr[j]; e[1] = hi[j]; } }
        }
        if (final_pass) { int q4o = q4; asm volatile("" : "+v"(q4o));
#pragma unroll
            for (int tb = 0; tb < 4; ++tb)
#pragma unroll
                for (int rg = 0; rg < 4; ++rg) c.W<bf16>(WS_YS5)[(size_t)(ch * 64 + tb * 16 + 4 * q4o + rg) * 256 + g * 16 + cq] = f2bf(gelu_tanh(yacc[tb][rg])); }
    }
}

__device__ __forceinline__ void lru_mfma(const Ctx& c, const bool final_pass) {
    const int tid = tidx(), wave = tid >> 6, lane = tid & 63, r = lane & 31, hh = lane >> 5, chn = wave * 32 + r;
    unsigned char* L = (unsigned char*)c.lds;
    bf16* xt = (bf16*)L;
    unsigned char* xcb = L + 34816;
    float* xcf = (float*)(L + 68608);
    const bf16* z = c.W<bf16>(WS_Z);
    const int sg = tid & 31;
    const int c0 = (final_pass && c.l == DEPTH - 1) ? 4 : 0;
    for (int ch = c0 + rot_bid(8); ch < NCHUNK; ch += gridDim.x) {
        const int segb = ch < 4 ? 0 : CTX, sege = ch < 4 ? CTX : ROWS;
        __syncthreads();
        { u32x4 v[5];
#pragma unroll
          for (int q = 0; q < 5; ++q) { const int pc = tid + q * NT, rr = pc >> 5, row = ch * 64 - 2 + rr;
              v[q] = (pc < 67 * 32 && row >= segb && row < sege) ? *(const u32x4*)(z + (size_t)row * NZ + ZC_LRUX + (pc & 31) * 8) : (u32x4){0u, 0u, 0u, 0u}; }
#pragma unroll
          for (int q = 0; q < 5; ++q) { const int pc = tid + q * NT; if (pc < 67 * 32) *(u32x4*)(xt + (size_t)pc * 8) = v[q]; } }
        __syncthreads();
        { int zo = 0; asm volatile("" : "+v"(zo));
          float cwv[4][8], cbv8[8];
#pragma unroll
          for (int e = 0; e < 8; ++e) { cbv8[e] = c.in(I_LCB)[(size_t)c.l * 256 + sg * 8 + e + zo];
#pragma unroll
              for (int k = 0; k < 4; ++k) cwv[k][e] = c.in(I_LCW)[(size_t)c.l * 1024 + k * 256 + sg * 8 + e + zo]; }
#pragma unroll
        for (int q = 0; q < 4; ++q) { const int i = (tid >> 5) + q * 16; float o[8];
#pragma unroll
            for (int e = 0; e < 8; ++e) o[e] = cbv8[e];
#pragma unroll
            for (int k = 0; k < 4; ++k) { const u32x4 xv = *(const u32x4*)(xt + (size_t)(i + k) * 256 + sg * 8);
                o[0] += cwv[k][0] * lo2f(xv.x); o[1] += cwv[k][1] * hi2f(xv.x); o[2] += cwv[k][2] * lo2f(xv.y); o[3] += cwv[k][3] * hi2f(xv.y);
                o[4] += cwv[k][4] * lo2f(xv.z); o[5] += cwv[k][5] * hi2f(xv.z); o[6] += cwv[k][6] * lo2f(xv.w); o[7] += cwv[k][7] * hi2f(xv.w); }
            *(f32x4*)(xcf + i * 256 + sg * 8) = (f32x4){o[0], o[1], o[2], o[3]}; *(f32x4*)(xcf + i * 256 + sg * 8 + 4) = (f32x4){o[4], o[5], o[6], o[7]};
            u32x4 w; w.x = pack2(o[0], o[1]); w.y = pack2(o[2], o[3]); w.z = pack2(o[4], o[5]); w.w = pack2(o[6], o[7]); *(u32x4*)(xcb + i * 528 + sg * 16) = w; } }
        __syncthreads();
        bf16x8 af[2][2]; float xv[2][16], hs[2][16];
#pragma unroll
        for (int mb = 0; mb < 2; ++mb) {
#pragma unroll
            for (int s2 = 0; s2 < 2; ++s2) af[mb][s2] = *(const bf16x8*)(xcb + (mb * 32 + r) * 528 + (wave * 32 + 16 * s2 + 8 * hh) * 2);
#pragma unroll
            for (int i = 0; i < 16; ++i) xv[mb][i] = xcf[(mb * 32 + (i & 3) + 8 * (i >> 2) + 4 * hh) * 256 + chn]; }
#pragma unroll
        for (int d = 0; d < 2; ++d) {
            int zo = 0; asm volatile("" : "+v"(zo));
            bf16x8 wrf[2], wif[2]; const size_t base = ((size_t)(c.l * 2 + d) * 8 + wave) * 1024 + r + zo;
            const float brv = c.in(I_LBR)[(size_t)(c.l * 2 + d) * 256 + chn + zo], biv = c.in(I_LBI)[(size_t)(c.l * 2 + d) * 256 + chn + zo], lsv = 8.0f * logsigmoidf_(c.in(I_LLAM)[(size_t)(c.l * 2 + d) * 256 + chn + zo]);
#pragma unroll
            for (int s2 = 0; s2 < 2; ++s2) { const float* pr_ = c.in(I_LWR) + base + (size_t)(16 * s2 + 8 * hh) * 32; const float* pi_ = c.in(I_LWI) + base + (size_t)(16 * s2 + 8 * hh) * 32;
                wrf[s2] = __builtin_bit_cast(bf16x8, __builtin_convertvector((f32x8){pr_[0], pr_[32], pr_[64], pr_[96], pr_[128], pr_[160], pr_[192], pr_[224]}, bf16v8));
                wif[s2] = __builtin_bit_cast(bf16x8, __builtin_convertvector((f32x8){pi_[0], pi_[32], pi_[64], pi_[96], pi_[128], pi_[160], pi_[192], pi_[224]}, bf16v8)); }
            float av[2][16], bv[2][16];
#pragma unroll
            for (int mb = 0; mb < 2; ++mb) { f32x16 ra, ia;
#pragma unroll
                for (int i = 0; i < 16; ++i) { ra[i] = brv; ia[i] = biv; }
#pragma unroll
                for (int s2 = 0; s2 < 2; ++s2) { ra = MFMA32(af[mb][s2], wrf[s2], ra); ia = MFMA32(af[mb][s2], wif[s2], ia); }
#pragma unroll
                for (int i = 0; i < 16; ++i) { const float rg = sigmoidf_(ra[i]), ig = sigmoidf_(ia[i]), a = __expf(rg * lsv);
                    av[mb][i] = a; bv[mb][i] = sqrtf(fmaxf(1.0f - a * a, 0.f)) * (ig * xv[mb][i]); } }
            float h = final_pass ? c.W<float>(WS_LRUSTART)[(size_t)(ch * 2 + d) * 256 + chn] : 0.f;
#define LRU_SEG(MB, G, FIRST_HH, K0, K1, K2, K3) do { \
                float t0 = av[MB][4 * (G) + K0] * h + bv[MB][4 * (G) + K0], t1 = av[MB][4 * (G) + K1] * t0 + bv[MB][4 * (G) + K1], t2 = av[MB][4 * (G) + K2] * t1 + bv[MB][4 * (G) + K2], t3 = av[MB][4 * (G) + K3] * t2 + bv[MB][4 * (G) + K3]; \
                const float hin = __shfl_xor(t3, 32); \
                const float u0 = av[MB][4 * (G) + K0] * hin + bv[MB][4 * (G) + K0], u1 = av[MB][4 * (G) + K1] * u0 + bv[MB][4 * (G) + K1], u2 = av[MB][4 * (G) + K2] * u1 + bv[MB][4 * (G) + K2], u3 = av[MB][4 * (G) + K3] * u2 + bv[MB][4 * (G) + K3]; \
                const bool fst = (hh == (FIRST_HH)); \
                bv[MB][4 * (G) + K0] = fst ? t0 : u0; bv[MB][4 * (G) + K1] = fst ? t1 : u1; bv[MB][4 * (G) + K2] = fst ? t2 : u2; bv[MB][4 * (G) + K3] = fst ? t3 : u3; \
                const float ho = __shfl_xor(u3, 32); h = fst ? ho : u3; } while (0)
            if (d == 0) { LRU_SEG(0, 0, 0, 0, 1, 2, 3); LRU_SEG(0, 1, 0, 0, 1, 2, 3); LRU_SEG(0, 2, 0, 0, 1, 2, 3); LRU_SEG(0, 3, 0, 0, 1, 2, 3);
                          LRU_SEG(1, 0, 0, 0, 1, 2, 3); LRU_SEG(1, 1, 0, 0, 1, 2, 3); LRU_SEG(1, 2, 0, 0, 1, 2, 3); LRU_SEG(1, 3, 0, 0, 1, 2, 3); }
            else        { LRU_SEG(1, 3, 1, 3, 2, 1, 0); LRU_SEG(1, 2, 1, 3, 2, 1, 0); LRU_SEG(1, 1, 1, 3, 2, 1, 0); LRU_SEG(1, 0, 1, 3, 2, 1, 0);
                          LRU_SEG(0, 3, 1, 3, 2, 1, 0); LRU_SEG(0, 2, 1, 3, 2, 1, 0); LRU_SEG(0, 1, 1, 3, 2, 1, 0); LRU_SEG(0, 0, 1, 3, 2, 1, 0); }
#undef LRU_SEG
            if (!final_pass) { float A = 1.f;
#pragma unroll
                for (int mb = 0; mb < 2; ++mb)
#pragma unroll
                    for (int i = 0; i < 16; ++i) A *= av[mb][i];
                A *= __shfl_xor(A, 32);
                if (hh == 0) { float* e = c.W<float>(WS_LRUEND) + ((size_t)(ch * 2 + d) * 256 + chn) * 2; e[0] = A; e[1] = h; } }
            else {
#pragma unroll
                for (int mb = 0; mb < 2; ++mb)
#pragma unroll
                    for (int i = 0; i < 16; ++i) hs[mb][i] = d == 0 ? bv[mb][i] : hs[mb][i] + bv[mb][i]; }
        }
        if (final_pass) {
#pragma unroll
            for (int mb = 0; mb < 2; ++mb)
#pragma unroll
                for (int i = 0; i < 16; ++i) xcf[(mb * 32 + (i & 3) + 8 * (i >> 2) + 4 * hh) * 256 + chn] = hs[mb][i];
            __syncthreads();
            u32x4 yv[4];
#pragma unroll
            for (int q = 0; q < 4; ++q) { const int pc = tid + q * NT; yv[q] = *(const u32x4*)(z + (size_t)(ch * 64 + (pc >> 5)) * NZ + ZC_LRUY + (pc & 31) * 8); }
#pragma unroll
            for (int q = 0; q < 4; ++q) { const int pc = tid + q * NT, rr = pc >> 5; const float* hp = xcf + rr * 256 + (pc & 31) * 8; u32x4 w;
                w.x = pack2(hp[0] * gelu_tanh(lo2f(yv[q].x)), hp[1] * gelu_tanh(hi2f(yv[q].x))); w.y = pack2(hp[2] * gelu_tanh(lo2f(yv[q].y)), hp[3] * gelu_tanh(hi2f(yv[q].y)));
                w.z = pack2(hp[4] * gelu_tanh(lo2f(yv[q].z)), hp[5] * gelu_tanh(hi2f(yv[q].z))); w.w = pack2(hp[6] * gelu_tanh(lo2f(yv[q].w)), hp[7] * gelu_tanh(hi2f(yv[q].w)));
                *(u32x4*)(c.W<bf16>(WS_Y) + (size_t)(ch * 64 + rr) * D + 256 + (pc & 31) * 8) = w; } }
    }
}

__device__ __forceinline__ float logsig_fast(float x) { return fminf(x, 0.f) - __logf(1.0f + __expf(-fabsf(x))); }
__device__ __forceinline__ void gla_mfma(const Ctx& c, const bool final_pass) {
    const int tid = tidx(), wave = tid >> 6, lane = tid & 63, r = lane & 31, hh = lane >> 5, hd = wave >> 1, d = wave & 1;
    unsigned char* L = (unsigned char*)c.lds;
    unsigned char* QE = L + wave * 10240; unsigned char* KE = QE + 5120;
    unsigned char* VT = L + 81920 + hd * 9216;
    float* zt = (float*)(L + 118784);
    float* ex = (float*)(L + (wave & ~1) * 10240);
    const bf16* z = c.W<bf16>(WS_Z); const float* za = c.W<float>(WS_ZA);
    const int pr = (r & 19) | ((r & 4) << 1) | ((r & 8) >> 1);
    const int c0 = (final_pass && c.l == DEPTH - 1) ? 4 : 0;
    for (int ch = c0 + rot_bid(12); ch < NCHUNK; ch += gridDim.x) {
        __syncthreads();
        { const f32x4 zv = *(const f32x4*)(za + (size_t)(ch * 64 + (tid >> 3)) * 32 + (tid & 7) * 4); u32x4 vv[4];
#pragma unroll
          for (int q = 0; q < 4; ++q) { const int pc = tid + q * NT; vv[q] = *(const u32x4*)(z + (size_t)(ch * 64 + (pc >> 5)) * NZ + ZC_GV + (pc & 31) * 8); }
          *(f32x4*)(zt + (tid >> 3) * 32 + (tid & 7) * 4) = zv;
#pragma unroll
          for (int q = 0; q < 4; ++q) { const int pc = tid + q * NT, j = pc >> 5, sg = pc & 31; bf16* dst = (bf16*)(L + 81920 + (sg >> 3) * 9216 + ((sg & 7) * 8) * 144 + j * 2);
              dst[0] = (bf16)(vv[q].x & 0xffff); dst[72] = (bf16)(vv[q].x >> 16); dst[144] = (bf16)(vv[q].y & 0xffff); dst[216] = (bf16)(vv[q].y >> 16);
              dst[288] = (bf16)(vv[q].z & 0xffff); dst[360] = (bf16)(vv[q].z >> 16); dst[432] = (bf16)(vv[q].w & 0xffff); dst[504] = (bf16)(vv[q].w >> 16); } }
        __syncthreads();
        int zo = 0; asm volatile("" : "+v"(zo));
        float w2[16];
#pragma unroll
        for (int k = 0; k < 16; ++k) w2[k] = c.in(I_GWA2)[(size_t)(c.l * 2 + d) * 16 * 128 + k * 128 + hd * 32 + r + zo];
        const float bav = c.in(I_GBA)[(size_t)(c.l * 2 + d) * 128 + hd * 32 + r + zo];
        float lav[32]; float run = 0.f;
#pragma unroll
        for (int i = 0; i < 32; ++i) { const int tok = hh * 32 + (d ? 31 - i : i); const float* a = zt + tok * 32 + d * 16; float zz = bav;
            const f32x4 a0 = *(const f32x4*)a, a1 = *(const f32x4*)(a + 4), a2 = *(const f32x4*)(a + 8), a3 = *(const f32x4*)(a + 12);
            zz += (a0.x * w2[0] + a0.y * w2[1]) + (a0.z * w2[2] + a0.w * w2[3]) + (a1.x * w2[4] + a1.y * w2[5]) + (a1.z * w2[6] + a1.w * w2[7])
                + (a2.x * w2[8] + a2.y * w2[9]) + (a2.z * w2[10] + a2.w * w2[11]) + (a3.x * w2[12] + a3.y * w2[13]) + (a3.z * w2[14] + a3.w * w2[15]);
            run += logsig_fast(zz) * (1.0f / 16.0f); lav[i] = run; }
        const float other = __shfl_xor(run, 32), tot = run + other, add = ((d == 0) == (hh == 1)) ? other : 0.f;
        int koff = 0, hq = hh; asm volatile("" : "+v"(hq));
        const bf16* pq = z + (size_t)(ch * 64) * NZ + ZC_GQ + hd * 32 + r; const bf16* pk = z + (size_t)(ch * 64) * NZ + ZC_GK + hd * 32 + r;
        if (final_pass) {
#pragma unroll
            for (int i = 0; i < 32; ++i) { if ((i & 7) == 0) asm volatile("" : "+v"(koff) :: "memory");
                const int tok = hq * 32 + (d ? 31 - i : i); const float b = lav[i] + add;
                const float qv = bf2f(pq[(size_t)tok * NZ + koff]) * 0.17677669529663687f, kv = bf2f(pk[(size_t)tok * NZ + koff]);
                *(bf16*)(QE + tok * 80 + r * 2) = f2bf(qv * __expf(b)); *(bf16*)(KE + tok * 80 + r * 2) = f2bf(kv * __expf(-b));
                }
        } else {
#pragma unroll
            for (int i = 0; i < 32; ++i) { if ((i & 7) == 0) asm volatile("" : "+v"(koff) :: "memory");
                const int tok = hq * 32 + (d ? 31 - i : i); const float b = lav[i] + add; const float kv = bf2f(pk[(size_t)tok * NZ + koff]);
                *(bf16*)(QE + r * 144 + tok * 2) = f2bf(kv * __expf(tot - b));
                }
            if (hh == 0) c.W<float>(WS_GLADEC)[((size_t)(ch * 2 + d) * 4 + hd) * 32 + r] = __expf(tot);
        }
        if (!final_pass) {
            f32x16 kvt[2];
#pragma unroll
            for (int db = 0; db < 2; ++db)
#pragma unroll
                for (int i = 0; i < 16; ++i) kvt[db][i] = 0.f;
#pragma unroll
            for (int s4 = 0; s4 < 4; ++s4) { const bf16x8 bf = *(const bf16x8*)(QE + r * 144 + (16 * s4 + 8 * hh) * 2);
#pragma unroll
                for (int db = 0; db < 2; ++db) { const bf16x8 af = *(const bf16x8*)(VT + (db * 32 + r) * 144 + (16 * s4 + 8 * hh) * 2); kvt[db] = MFMA32(af, bf, kvt[db]); } }
            float* kvp = c.W<float>(WS_GLAKV) + ((size_t)(ch * 2 + d) * 4 + hd) * 2048 + r;
#pragma unroll
            for (int db = 0; db < 2; ++db)
#pragma unroll
                for (int i = 0; i < 16; ++i) kvp[(db * 32 + (i & 3) + 8 * (i >> 2) + 4 * hh) * 32] = kvt[db][i];
            continue;
        }
        f32x16 o[2][2];
#pragma unroll
        for (int db = 0; db < 2; ++db)
#pragma unroll
            for (int ib = 0; ib < 2; ++ib)
#pragma unroll
                for (int i = 0; i < 16; ++i) o[db][ib][i] = 0.f;
        bf16x8 qb[2][2];
#pragma unroll
        for (int ib = 0; ib < 2; ++ib)
#pragma unroll
            for (int s2 = 0; s2 < 2; ++s2) qb[ib][s2] = *(const bf16x8*)(QE + (ib * 32 + r) * 80 + s2 * 32 + hh * 16);
        { const bf16* s0t = c.W<bf16>(WS_GLAS0) + ((size_t)(ch * 2 + d) * 4 + hd) * 2048;
#pragma unroll
          for (int db = 0; db < 2; ++db)
#pragma unroll
              for (int s2 = 0; s2 < 2; ++s2) { const bf16x8 sf = *(const bf16x8*)(s0t + (db * 32 + r) * 32 + 16 * s2 + 8 * hh);
#pragma unroll
                  for (int ib = 0; ib < 2; ++ib) o[db][ib] = MFMA32(sf, qb[ib][s2], o[db][ib]); } }
#define GLA_BLOCK(JB, IB, MASKED) do { f32x16 x; _Pragma("unroll") for (int i = 0; i < 16; ++i) x[i] = 0.f; \
        _Pragma("unroll") for (int s2 = 0; s2 < 2; ++s2) { const bf16x8 kf = *(const bf16x8*)(KE + ((JB) * 32 + pr) * 80 + s2 * 32 + hh * 16); x = MFMA32(kf, qb[IB][s2], x); } \
        if (MASKED) { _Pragma("unroll") for (int i = 0; i < 16; ++i) { const int jl = (i & 3) + 4 * ((i >> 2) & 1) + 8 * hh + 16 * (i >> 3); const bool keep = d ? (jl >= r) : (jl <= r); x[i] = keep ? x[i] : 0.f; } } \
        _Pragma("unroll") for (int s2 = 0; s2 < 2; ++s2) { \
            const bf16x8 pb = __builtin_bit_cast(bf16x8, __builtin_convertvector((f32x8){x[8 * s2], x[8 * s2 + 1], x[8 * s2 + 2], x[8 * s2 + 3], x[8 * s2 + 4], x[8 * s2 + 5], x[8 * s2 + 6], x[8 * s2 + 7]}, bf16v8)); \
            _Pragma("unroll") for (int db = 0; db < 2; ++db) { const bf16x8 vf = *(const bf16x8*)(VT + (db * 32 + r) * 144 + ((JB) * 32 + s2 * 16 + hh * 8) * 2); o[db][IB] = MFMA32(vf, pb, o[db][IB]); } } } while (0)
        GLA_BLOCK(0, 0, true); GLA_BLOCK(1, 1, true);
        if (d == 0) GLA_BLOCK(0, 1, false); else GLA_BLOCK(1, 0, false);
#undef GLA_BLOCK
        __syncthreads();
        if (d == 1) {
#pragma unroll
            for (int db = 0; db < 2; ++db)
#pragma unroll
                for (int ib = 0; ib < 2; ++ib)
#pragma unroll
                    for (int i = 0; i < 16; ++i) ex[((db * 2 + ib) * 16 + i) * 64 + lane] = o[db][ib][i]; }
        __syncthreads();
        if (d == 0) {
            const float* gon = c.in(I_GON) + (size_t)c.l * 64;
#pragma unroll
            for (int ib = 0; ib < 2; ++ib) { float ss = 0.f;
#pragma unroll
                for (int db = 0; db < 2; ++db)
#pragma unroll
                    for (int i = 0; i < 16; ++i) { const float v = o[db][ib][i] + ex[((db * 2 + ib) * 16 + i) * 64 + lane]; o[db][ib][i] = v; ss += v * v; }
                ss += __shfl_xor(ss, 32);
                const float rstd = rsqrtf(ss * (1.0f / 64.0f) + 1e-6f); const int row = ch * 64 + ib * 32 + r;
#pragma unroll
                for (int db = 0; db < 2; ++db)
#pragma unroll
                    for (int g4 = 0; g4 < 4; ++g4) { const int dv0 = db * 32 + 8 * g4 + 4 * hh; const u32x2 gw = *(const u32x2*)(z + (size_t)row * NZ + ZC_GG + hd * 64 + dv0); const f32x4 gn = *(const f32x4*)(gon + dv0);
                        u32x2 w; w.x = pack2(o[db][ib][4 * g4] * rstd * gn.x * siluf_(lo2f(gw.x)), o[db][ib][4 * g4 + 1] * rstd * gn.y * siluf_(hi2f(gw.x)));
                        w.y = pack2(o[db][ib][4 * g4 + 2] * rstd * gn.z * siluf_(lo2f(gw.y)), o[db][ib][4 * g4 + 3] * rstd * gn.w * siluf_(hi2f(gw.y)));
                        *(u32x2*)(c.W<bf16>(WS_Y) + (size_t)row * D + 768 + hd * 64 + dv0) = w; } } }
    }
}

__device__ __forceinline__ void phase_carry(const Ctx& c) {
    const int b = blockIdx.x, t = tidx();
    constexpr int NB = 13, NBATCH = NCHUNK / NB;
    if (b < 4) {
        const int i = b * NT + t, d = i >> 10, gp = i & 1023; const int si = (c.l * 2 + d) * 1024 + gp;
        float ar = c.W<float>(WS_S5LB)[si * 2], ai = c.W<float>(WS_S5LB)[si * 2 + 1];
        for (int q = 0; q < 6; ++q) { const float nr = ar * ar - ai * ai, ni = 2.f * ar * ai; ar = nr; ai = ni; }
        float hr = 0.f, hi = 0.f;
        const f32x2* E = c.W<f32x2>(WS_S5END); f32x2* S = c.W<f32x2>(WS_S5START);
        f32x2 ea[NB], eb[NB];
#define S5C_LOAD(dst, s0) _Pragma("unroll") for (int j = 0; j < NB; ++j) dst[j] = E[(size_t)(chunk_of((s0) + j, d) * 2 + d) * 1024 + gp]
#define S5C_USE(src, s0) _Pragma("unroll") for (int j = 0; j < NB; ++j) { S[(size_t)(chunk_of((s0) + j, d) * 2 + d) * 1024 + gp] = (f32x2){hr, hi}; \
            const float nr = ar * hr - ai * hi + src[j].x, ni = ar * hi + ai * hr + src[j].y; hr = nr; hi = ni; }
        S5C_LOAD(ea, 0);
        for (int bt = 0; bt < NBATCH; bt += 2) { S5C_LOAD(eb, (bt + 1) * NB); S5C_USE(ea, bt * NB); if (bt + 2 < NBATCH) S5C_LOAD(ea, (bt + 2) * NB); S5C_USE(eb, (bt + 1) * NB); }
#undef S5C_LOAD
#undef S5C_USE
    } else if (b == 4) {
        const int d = t >> 8, chn = t & 255; float h = 0.f;
        const f32x2* E = c.W<f32x2>(WS_LRUEND); float* S = c.W<float>(WS_LRUSTART);
        f32x2 ea[NB], eb[NB];
#define LRC_LOAD(dst, s0) _Pragma("unroll") for (int j = 0; j < NB; ++j) dst[j] = E[(size_t)(chunk_of((s0) + j, d) * 2 + d) * 256 + chn]
#define LRC_USE(src, s0) _Pragma("unroll") for (int j = 0; j < NB; ++j) { S[(size_t)(chunk_of((s0) + j, d) * 2 + d) * 256 + chn] = h; h = src[j].x * h + src[j].y; }
        LRC_LOAD(ea, 0);
        for (int bt = 0; bt < NBATCH; bt += 2) { LRC_LOAD(eb, (bt + 1) * NB); LRC_USE(ea, bt * NB); if (bt + 2 < NBATCH) LRC_LOAD(ea, (bt + 2) * NB); LRC_USE(eb, (bt + 1) * NB); }
#undef LRC_LOAD
#undef LRC_USE
    } else if (b >= 8 && b < 40) {
        const int i = (b - 8) * NT + t, d = i >> 13, hd = (i >> 11) & 3, e = i & 2047, dk = e & 31; float S = 0.f;
        const float* KV = c.W<float>(WS_GLAKV); const float* DC = c.W<float>(WS_GLADEC); bf16* S0 = c.W<bf16>(WS_GLAS0);
        float ka[NB], da[NB], kb[NB], db[NB];
#define GLC_LOAD(kd, dd, s0) _Pragma("unroll") for (int j = 0; j < NB; ++j) { const size_t cb = (size_t)(chunk_of((s0) + j, d) * 2 + d) * 4 + hd; kd[j] = KV[cb * 2048 + e]; dd[j] = DC[cb * 32 + dk]; }
#define GLC_USE(kd, dd, s0) _Pragma("unroll") for (int j = 0; j < NB; ++j) { const size_t cb = (size_t)(chunk_of((s0) + j, d) * 2 + d) * 4 + hd; S0[cb * 2048 + e] = f2bf(S); S = dd[j] * S + kd[j]; }
        GLC_LOAD(ka, da, 0);
        for (int bt = 0; bt < NBATCH; bt += 2) { GLC_LOAD(kb, db, (bt + 1) * NB); GLC_USE(ka, da, bt * NB); if (bt + 2 < NBATCH) GLC_LOAD(ka, da, (bt + 2) * NB); GLC_USE(kb, db, (bt + 1) * NB); }
#undef GLC_LOAD
#undef GLC_USE
    }
}

__device__ __forceinline__ void v_transpose(const Ctx& c, const int bid, const int nb) {
    const int t = tidx(); bf16* sm = (bf16*)c.lds;
    const bf16* z = c.W<bf16>(WS_Z); bf16* vT = c.W<bf16>(WS_VT);
    for (int task = bid; task < NCHUNK * 4; task += nb) {
        const int kt = task >> 2, hd = task & 3, key = t >> 3, seg = t & 7;
        const u32x4 v = *(const u32x4*)(z + (size_t)(kt * 64 + key) * NZ + ZC_DAV + hd * 64 + seg * 8);
        __syncthreads();
        bf16* d = sm + (seg * 8) * 72 + key;
        d[0] = (bf16)(v.x & 0xffff); d[72] = (bf16)(v.x >> 16); d[144] = (bf16)(v.y & 0xffff); d[216] = (bf16)(v.y >> 16);
        d[288] = (bf16)(v.z & 0xffff); d[360] = (bf16)(v.z >> 16); d[432] = (bf16)(v.w & 0xffff); d[504] = (bf16)(v.w >> 16);
        __syncthreads();
        *(u32x4*)(vT + (size_t)(hd * 64 + key) * ROWS + kt * 64 + seg * 8) = *(const u32x4*)(sm + key * 72 + seg * 8);
    }
}
template <bool SHIFT>
__device__ __forceinline__ void attn_mfma_body(const Ctx& c) {
    const int tid = tidx(), wave = tid >> 6, lane = tid & 63, r = lane & 31, hh = lane >> 5;
    constexpr int KS = 144, VOFF = 64 * KS, BUF = 2 * 64 * KS;
    unsigned char* L = (unsigned char*)c.lds;
    const bf16* z = c.W<bf16>(WS_Z); const bf16* vT = c.W<bf16>(WS_VT);
    const float li = lam_init_of(c.l);
    float lam; { const float* lp = c.in(I_DLAM) + (size_t)c.l * 128; float s0 = 0.f, s1 = 0.f; for (int k = 0; k < 32; ++k) { s0 += lp[k] * lp[32 + k]; s1 += lp[64 + k] * lp[96 + k]; } lam = expf(s0) - expf(s1) + li; }
    float gq = 0.f, gk = 0.f; for (int k = 0; k < 32; ++k) { gq = fmaxf(gq, fabsf(c.in(I_DQN)[(size_t)c.l * 32 + k])); gk = fmaxf(gk, fabsf(c.in(I_DKN)[(size_t)c.l * 32 + k])); }
    const float mb = 32.0f * gq * gk * (0.17677669529663687f * 1.4426950408889634f) * 1.02f;
    const int pr = (r & 19) | ((r & 4) << 1) | ((r & 8) >> 1);
    const int skey = tid >> 3, sseg = tid & 7, lw = skey * KS + sseg * 16;
    const int qb0 = (c.l == DEPTH - 1) ? 1 : 0;
    for (int task = qb0 * 4 + blockIdx.x; task < 65 * 4; task += gridDim.x) {
        const int qb = task >> 2, hd = task & 3, nt = (qb == 0 ? CTX : ROWS) / 64; const int row = qb * 256 + wave * 32 + r;
        bf16x8 qf[2][2];
        { const bf16* pq = z + (size_t)row * NZ + ZC_DAQ + hd * 64 + hh * 8;
#pragma unroll
          for (int cc = 0; cc < 2; ++cc)
#pragma unroll
              for (int s2 = 0; s2 < 2; ++s2) qf[cc][s2] = *(const bf16x8*)(pq + cc * 32 + s2 * 16); }
        f32x16 o[2][2];
#pragma unroll
        for (int cc = 0; cc < 2; ++cc)
#pragma unroll
            for (int db = 0; db < 2; ++db)
#pragma unroll
                for (int i = 0; i < 16; ++i) o[cc][db][i] = 0.f;
        float ls0 = 0.f, ls1 = 0.f;
        const bf16* gk_ = z + (size_t)skey * NZ + ZC_DAK + hd * 64 + sseg * 8;
        const bf16* gv_ = vT + (size_t)(hd * 64 + skey) * ROWS + sseg * 8;
        u32x4 kr = *(const u32x4*)gk_, vr = *(const u32x4*)gv_;
        __syncthreads();
        *(u32x4*)(L + lw) = kr; *(u32x4*)(L + VOFF + lw) = vr;
        __syncthreads();
        for (int t = 0; t < nt; ++t) {
            const unsigned char* cur = L + (t & 1) * BUF;
            if (t + 1 < nt) { kr = *(const u32x4*)(gk_ + (size_t)(t + 1) * 64 * NZ); vr = *(const u32x4*)(gv_ + (t + 1) * 64); }
#pragma unroll
            for (int kb = 0; kb < 2; ++kb) {
                bf16x8 vf[2][2];
#pragma unroll
                for (int db = 0; db < 2; ++db)
#pragma unroll
                    for (int s2 = 0; s2 < 2; ++s2) vf[db][s2] = *(const bf16x8*)(cur + VOFF + (db * 32 + r) * KS + (kb * 32 + s2 * 16 + hh * 8) * 2);
#pragma unroll
                for (int cc = 0; cc < 2; ++cc) {
                    f32x16 sa;
#pragma unroll
                    for (int i = 0; i < 16; ++i) sa[i] = SHIFT ? -mb : 0.f;
#pragma unroll
                    for (int s2 = 0; s2 < 2; ++s2) { const bf16x8 kf = *(const bf16x8*)(cur + (kb * 32 + pr) * KS + cc * 64 + s2 * 32 + hh * 16); sa = MFMA32(kf, qf[cc][s2], sa); }
                    float p[16];
#pragma unroll
                    for (int i = 0; i < 16; ++i) p[i] = __builtin_amdgcn_exp2f(sa[i]);
                    const float ps = ((p[0] + p[1]) + (p[2] + p[3])) + ((p[4] + p[5]) + (p[6] + p[7])) + (((p[8] + p[9]) + (p[10] + p[11])) + ((p[12] + p[13]) + (p[14] + p[15])));
                    if (cc == 0) ls0 += ps; else ls1 += ps;
#pragma unroll
                    for (int s2 = 0; s2 < 2; ++s2) {
                        const bf16x8 pb = __builtin_bit_cast(bf16x8, __builtin_convertvector((f32x8){p[8 * s2], p[8 * s2 + 1], p[8 * s2 + 2], p[8 * s2 + 3], p[8 * s2 + 4], p[8 * s2 + 5], p[8 * s2 + 6], p[8 * s2 + 7]}, bf16v8));
#pragma unroll
                        for (int db = 0; db < 2; ++db) o[cc][db] = MFMA32(vf[db][s2], pb, o[cc][db]);
                    }
                }
            }
            if (t + 1 < nt) { unsigned char* nb = L + ((t + 1) & 1) * BUF; *(u32x4*)(nb + lw) = kr; *(u32x4*)(nb + VOFF + lw) = vr; }
            __syncthreads();
        }
        ls0 += __shfl_xor(ls0, 32); ls1 += __shfl_xor(ls1, 32);
        const float il0 = 1.0f / ls0, il1 = lam / ls1; float ss = 0.f;
#pragma unroll
        for (int db = 0; db < 2; ++db)
#pragma unroll
            for (int i = 0; i < 16; ++i) { const float v = o[0][db][i] * il0 - o[1][db][i] * il1; o[0][db][i] = v; ss += v * v; }
        ss += __shfl_xor(ss, 32);
        const float rstd = rsqrtf(ss * (1.0f / 64.0f) + 1e-6f) * (1.0f - li);
        bf16* po = c.W<bf16>(WS_Y) + (size_t)row * D + 512 + hd * 64 + 4 * hh; const float* gn = c.in(I_DON) + (size_t)c.l * 64 + 4 * hh;
#pragma unroll
        for (int db = 0; db < 2; ++db)
#pragma unroll
            for (int g = 0; g < 4; ++g) { const int dv0 = db * 32 + 8 * g; const f32x4 gg = *(const f32x4*)(gn + dv0);
                u32x2 w; w.x = pack2(o[0][db][4 * g] * rstd * gg.x, o[0][db][4 * g + 1] * rstd * gg.y); w.y = pack2(o[0][db][4 * g + 2] * rstd * gg.z, o[0][db][4 * g + 3] * rstd * gg.w);
                *(u32x2*)(po + dv0) = w; }
    }
}


__device__ __forceinline__ void attn_mfma(const Ctx& c) {
    float gq = 0.f, gk = 0.f; for (int k = 0; k < 32; ++k) { gq = fmaxf(gq, fabsf(c.in(I_DQN)[(size_t)c.l * 32 + k])); gk = fmaxf(gk, fabsf(c.in(I_DKN)[(size_t)c.l * 32 + k])); }
    const float mb = 32.0f * gq * gk * (0.17677669529663687f * 1.4426950408889634f) * 1.02f;
    if (mb > 64.0f) attn_mfma_body<true>(c); else attn_mfma_body<false>(c);
}

#define XB_TMO      128
#define XB_XCNT(j)  (256  + 64 * (j))
#define XB_XSUB(j)  (1280 + 64 * (j))
#define XB_XGEN(j)  (2304 + 64 * (j))
#define XB_TOP      3328
#define XB_TOPGEN   3392
#define XCD_BAR_WORDS 3456
#define XB_SPIN_CAP (1u << 18)
#define LAS __attribute__((address_space(3)))
__device__ __forceinline__ unsigned xb_ld(unsigned* p)              { return __hip_atomic_load(p, __ATOMIC_RELAXED, __HIP_MEMORY_SCOPE_AGENT); }
__device__ __forceinline__ unsigned xb_add(unsigned* p, unsigned v) { return __hip_atomic_fetch_add(p, v, __ATOMIC_RELAXED, __HIP_MEMORY_SCOPE_AGENT); }
__device__ __forceinline__ unsigned xb_xcc_id() { return (unsigned)__builtin_amdgcn_s_getreg((3 << 11) | 20) & 0xFu; }
#define XB_SPIN(cond, bar) do { unsigned _sp = 0; while (cond) { __builtin_amdgcn_s_sleep(1); \
    if ((++_sp & 255u) == 0u) { if (xb_ld(&(bar)[XB_TMO])) break; if (_sp > XB_SPIN_CAP) { atomicAdd(&(bar)[XB_TMO], 1u); break; } } } } while (0)
struct XcdBarrier { unsigned* bar; unsigned x; volatile LAS unsigned* st; };
__device__ __forceinline__ XcdBarrier xcd_barrier_post(unsigned* bar, volatile LAS unsigned* st) {
    XcdBarrier b; b.bar = bar; b.x = xb_xcc_id(); b.st = st;
    if (threadIdx.x == 0) (void)xb_add(&bar[XB_XCNT(b.x)], 1u);
    return b;
}
__device__ __forceinline__ void xcd_barrier_complete(unsigned* bar, unsigned x, unsigned& nloc, unsigned& nx) {
    const unsigned G = gridDim.x * gridDim.y * gridDim.z;
    unsigned sum, cnt, mine, sp = 0u;
    for (;;) {
        sum = 0u; cnt = 0u; mine = 0u;
#pragma unroll
        for (unsigned j = 0; j < 16; ++j) { const unsigned c = xb_ld(&bar[XB_XCNT(j)]); sum += c; cnt += (c > 0u) ? 1u : 0u; mine = (j == x) ? c : mine; }
        if (sum == G) break;
        __builtin_amdgcn_s_sleep(1);
        if ((++sp & 255u) == 0u) { if (xb_ld(&bar[XB_TMO])) break; if (sp > XB_SPIN_CAP) { atomicAdd(&bar[XB_TMO], 1u); break; } }
    }
    nloc = mine > 0u ? mine : 1u; nx = cnt > 0u ? cnt : 1u;
}
__device__ __forceinline__ void xcd_barrier(const XcdBarrier& b) {
    asm volatile("s_waitcnt vmcnt(0)" ::: "memory");
    __syncthreads();
    if (threadIdx.x == 0) {
        unsigned* bar = b.bar;
        __builtin_amdgcn_s_waitcnt(0);
        unsigned nloc = b.st[0], nx = b.st[1];
        if (nloc == 0u) { xcd_barrier_complete(bar, b.x, nloc, nx); b.st[0] = nloc; b.st[1] = nx; }
        const unsigned old = xb_add(&bar[XB_XSUB(b.x)], 1u);
        const unsigned gen = old / nloc;
        if (old + 1u == (gen + 1u) * nloc) {
            __builtin_amdgcn_fence(__ATOMIC_RELEASE, "agent");
            asm volatile("s_waitcnt vmcnt(0)" ::: "memory");
            const unsigned og = xb_add(&bar[XB_TOP], 1u);
            const unsigned tg = og / nx;
            if (og + 1u == (tg + 1u) * nx) xb_add(&bar[XB_TOPGEN], 1u);
            else XB_SPIN(xb_ld(&bar[XB_TOPGEN]) == tg, bar);
            __builtin_amdgcn_fence(__ATOMIC_ACQUIRE, "agent");
            xb_add(&bar[XB_XGEN(b.x)], 1u);
            asm volatile("s_waitcnt vmcnt(0)" ::: "memory");
        } else {
            XB_SPIN(xb_ld(&bar[XB_XGEN(b.x)]) == gen, bar);
            __builtin_amdgcn_fence(__ATOMIC_ACQUIRE, "agent");
            asm volatile("s_waitcnt vmcnt(0)" ::: "memory");
        }
    }
    __syncthreads();
}

enum { PH_PREP = 0, PH_NORM1, PH_INPROJ, PH_MIX1, PH_CARRY, PH_MIX3, PH_GLU, PH_MERGE, PH_WOUT, PH_NORM2, PH_FFNUP, PH_FFNDN, PH_COUNT };

__device__ __forceinline__ void run_phase(const int l, const int ph, float* lds, const bool rep = false) {
    KParams* pp = (KParams*)__builtin_amdgcn_kernarg_segment_ptr();
    asm volatile("" : "+s"(pp));
    Ctx c(pp, l, lds);
    switch (ph) {
    case PH_PREP: phase_prep(c); break;
    case PH_NORM1: phase_norm(c, 0); break;
    case PH_INPROJ: { EpiInproj e{c.W<bf16>(WS_Z), c.W<float>(WS_ZA)}; gemm_lin(c.W<bf16>(WS_HN), D, c.W<bf16>(WS_WINT), 0, ROWS, NZP, D, e, lds); } break;
    case PH_MIX1: s5_mfma(c, false); lru_mfma(c, false); gla_mfma(c, false); break;
    case PH_CARRY: phase_carry(c);
        if (blockIdx.x >= 40) { if (!rep) da_prep(c, (int)blockIdx.x - 40, (int)gridDim.x - 40); v_transpose(c, (int)blockIdx.x - 40, (int)gridDim.x - 40); } break;
    #ifndef PROBE_SUB
#define PROBE_SUB 15
#endif
    case PH_MIX3: if (!rep || (PROBE_SUB & 1)) attn_mfma(c); if (!rep || (PROBE_SUB & 2)) s5_mfma(c, true); if (!rep || (PROBE_SUB & 4)) lru_mfma(c, true); if (!rep || (PROBE_SUB & 8)) gla_mfma(c, true); break;
    case PH_GLU: { EpiGlu e{c.W<bf16>(WS_YS5), c.W<bf16>(WS_Y)}; const int r0 = c.row_begin(); gemm_lin(c.W<bf16>(WS_YS5), 256, c.W<bf16>(WS_WGLUT), r0, ROWS - r0, 256, 256, e, lds);
        if (c.l != DEPTH - 1) phase_merge_pg(c, 2); } break;
    case PH_MERGE: phase_merge_pg(c, c.l == DEPTH - 1 ? 0 : 1); break;
    case PH_WOUT: { const EpiResid e = make_resid(c, 2 * D, true);
        if (c.l == 0) gemm_res_l0(c.W<bf16>(WS_MERGED), D, c.W<bf16>(WS_WOUTT), D, 4, e, c.W<float>(WS_SLABW), lds);
        else gemm_lin(c.W<bf16>(WS_MERGED), D, c.W<bf16>(WS_WOUTT), CTX, ROWS - CTX, D, D, e, lds); } break;
    case PH_NORM2: phase_norm(c, 1); break;
    case PH_FFNUP: phase_ffn_up_pg(c); break;
    case PH_FFNDN: { const EpiResid e = make_resid(c, 5 * D, false);
        if (c.l == 0) gemm_res_l0(c.W<bf16>(WS_Z), DFF, c.W<bf16>(WS_WDNT), DFF, 11, e, c.W<float>(WS_SLABF), lds);
        else gemm_lin(c.W<bf16>(WS_Z), DFF, c.W<bf16>(WS_WDNT), CTX, ROWS - CTX, D, DFF, e, lds); } break;
    default: break;
    }
}

__global__ void __launch_bounds__(NT) k_mega(Params p) {
    extern __shared__ __attribute__((aligned(16))) float lds[];
    cooperative_groups::grid_group grid = cooperative_groups::this_grid();
    volatile LAS unsigned* st = (volatile LAS unsigned*)((LAS unsigned char*)lds + LDS_TOTAL - 16);
    if (threadIdx.x == 0) { st[0] = 0u; st[1] = 0u; st[2] = 0u; st[3] = 0u; }
    __syncthreads();
    const XcdBarrier bar = xcd_barrier_post((unsigned*)(p.ws + WS_CTL), st);
#ifndef PROBE_PH
#define PROBE_PH -1
#endif
#define PHASE(l, ph) do { run_phase(l, ph, lds); xcd_barrier(bar); if (PROBE_PH == (ph)) { run_phase(l, ph, lds, true); xcd_barrier(bar); } } while (0)
#define LAYER(l) PHASE(l, PH_NORM1); PHASE(l, PH_INPROJ); PHASE(l, PH_MIX1); PHASE(l, PH_CARRY); PHASE(l, PH_MIX3); PHASE(l, PH_GLU); \
    PHASE(l, PH_MERGE); PHASE(l, PH_WOUT); PHASE(l, PH_NORM2); PHASE(l, PH_FFNUP)
    grid.sync();
    run_phase(0, PH_PREP, lds); xcd_barrier(bar);
    LAYER(0); PHASE(0, PH_FFNDN);
    run_phase(1, PH_PREP, lds); LAYER(1); run_phase(1, PH_FFNDN, lds);
#undef LAYER
#undef PHASE
}


extern "C" void kernel_launch(void* const* d_in, const int* in_sizes, int n_in, void* d_out, int out_size, void* d_ws, size_t ws_size, hipStream_t stream) {
    static int grid_blocks = 0;
    if (!grid_blocks) {
        if (n_in != N_IN || ws_size < WS_END) { fprintf(stderr, "kernel_launch: unexpected n_in %d or ws_size %zu (need %zu)\n", n_in, ws_size, (size_t)WS_END); grid_blocks = -1; return; }
        if (hipFuncSetAttribute((const void*)k_mega, hipFuncAttributeMaxDynamicSharedMemorySize, LDS_BYTES) != hipSuccess) { fprintf(stderr, "kernel_launch: hipFuncSetAttribute failed\n"); grid_blocks = -1; return; }
        int dev = 0, cus = 0, per_cu = 0;
        hipGetDevice(&dev);
        hipDeviceGetAttribute(&cus, hipDeviceAttributeMultiprocessorCount, dev);
        if (hipOccupancyMaxActiveBlocksPerMultiprocessor(&per_cu, (const void*)k_mega, NT, LDS_BYTES) != hipSuccess || per_cu < 1) { fprintf(stderr, "kernel_launch: occupancy query failed (%d)\n", per_cu); grid_blocks = -1; return; }
        grid_blocks = cus;
    }
    if (grid_blocks < 0) return;
    Params p{};
    for (int i = 0; i < N_IN; ++i) p.in[i] = (const float*)d_in[i];
    p.out = (float*)d_out; p.ws = (unsigned char*)d_ws;
    if (hipMemsetAsync((char*)d_ws + WS_CTL, 0, XCD_BAR_WORDS * 4, stream) != hipSuccess) { fprintf(stderr, "kernel_launch: memset of the barrier words failed\n"); return; }
    void* args[] = {&p};
    hipError_t e = hipLaunchCooperativeKernel((const void*)k_mega, dim3(grid_blocks), dim3(NT), args, LDS_BYTES, stream);
    if (e != hipSuccess) fprintf(stderr, "cooperative launch failed: %s (grid %d)\n", hipGetErrorString(e), grid_blocks);
}
```

```cpp
#include <hip/hip_runtime.h>
#include <hip/hip_cooperative_groups.h>
#include <cstdio>
#include <cstdint>

typedef unsigned short bf16;
typedef float f32x4 __attribute__((ext_vector_type(4)));
typedef unsigned u32x4 __attribute__((ext_vector_type(4)));
typedef unsigned u32x2 __attribute__((ext_vector_type(2)));
typedef short bf16x8 __attribute__((ext_vector_type(8)));
typedef float f32x16 __attribute__((ext_vector_type(16)));
typedef float f32x8 __attribute__((ext_vector_type(8)));
typedef __bf16 bf16v8 __attribute__((ext_vector_type(8)));
#define MFMA32(a, b, c) __builtin_amdgcn_mfma_f32_32x32x16_bf16((a), (b), (c), 0, 0, 0)

constexpr int D = 1024, SEQ = 16384, CTX = 256, ROWS = SEQ + CTX, DEPTH = 2;
constexpr int IN_TOTAL = 6432, NZ = 2304, NZP = 2560, GATE0 = 2336, DFF = 2816;
constexpr int NCHUNK = ROWS / 64;
constexpr int NT = 512;
constexpr int ZC_SSM = 0, ZC_LRUX = 256, ZC_LRUY = 512, ZC_DAQ = 768, ZC_DAK = 1024, ZC_DAV = 1280, ZC_GQ = 1536, ZC_GK = 1664, ZC_GV = 1792, ZC_GG = 2048;

enum { I_X = 0, I_C, I_CTX, I_CCTX, I_WADA, I_BADA, I_N1G, I_N2G, I_WIN, I_SLRE, I_SLIM, I_SLOG, I_SBRE, I_SBIM, I_SCRE, I_SCIM, I_SD, I_SWGLU,
       I_LCW, I_LCB, I_LWR, I_LBR, I_LWI, I_LBI, I_LLAM, I_DQN, I_DKN, I_DLAM, I_DON, I_GWA2, I_GBA, I_GON, I_WBR, I_WOUT, I_WUP, I_FCW, I_FCB, I_WDN, N_IN };

constexpr size_t al256(size_t x) { return (x + 255) & ~(size_t)255; }
constexpr size_t WS_CTL = 0;
constexpr size_t WS_ROPE = 32768;
constexpr size_t WS_MODS = 65536;
constexpr size_t WS_S5LB = WS_MODS + al256((size_t)2 * 2 * 6144 * 4);
constexpr size_t WS_S5BB = WS_S5LB + al256((size_t)4096 * 2 * 4);
constexpr size_t WS_HCTX = WS_S5BB + al256((size_t)4096 * 32 * 4);
constexpr size_t WS_WINT = WS_HCTX + al256((size_t)CTX * D * 4);
constexpr size_t WS_WGT = WS_WINT + al256((size_t)NZP * D * 2);
constexpr size_t WS_WBRT = WS_WGT + al256((size_t)4096 * D * 2);
constexpr size_t WS_WOUTT = WS_WBRT + al256((size_t)4 * D * 256 * 2);
constexpr size_t WS_WUPT = WS_WOUTT + al256((size_t)D * D * 2);
constexpr size_t WS_WDNT = WS_WUPT + al256((size_t)2 * DFF * D * 2);
constexpr size_t WS_WGLUT = WS_WDNT + al256((size_t)D * DFF * 2);
constexpr size_t WS_HN = WS_WGLUT + al256((size_t)256 * 256 * 2);
constexpr size_t WS_Z = WS_HN + al256((size_t)(ROWS + 256) * D * 2);
constexpr size_t WS_ZA = WS_Z + al256((size_t)ROWS * DFF * 2);
constexpr size_t WS_Y = WS_ZA + al256((size_t)ROWS * 32 * 4);
constexpr size_t WS_YS5 = WS_Y + al256((size_t)ROWS * D * 2);
constexpr size_t WS_S5END = WS_YS5 + al256((size_t)ROWS * 256 * 2);
constexpr size_t WS_S5START = WS_S5END + al256((size_t)NCHUNK * 2 * 16 * 64 * 2 * 4);
constexpr size_t WS_LRUEND = WS_S5START + al256((size_t)NCHUNK * 2 * 16 * 64 * 2 * 4);
constexpr size_t WS_LRUSTART = WS_LRUEND + al256((size_t)NCHUNK * 2 * 256 * 2 * 4);
constexpr size_t WS_GLAKV = WS_LRUSTART + al256((size_t)NCHUNK * 2 * 256 * 4);
constexpr size_t WS_GLAS0 = WS_GLAKV + al256((size_t)NCHUNK * 2 * 4 * 32 * 64 * 4);
constexpr size_t WS_GLADEC = WS_GLAS0 + al256((size_t)NCHUNK * 2 * 4 * 32 * 64 * 4);
constexpr size_t WS_VT = WS_GLADEC + al256((size_t)NCHUNK * 2 * 4 * 32 * 4);
constexpr size_t WS_END = WS_VT + al256((size_t)256 * ROWS * 2);
constexpr size_t WS_SLABW = WS_Z + (size_t)48 * 1024 * 1024;
constexpr size_t WS_SLABF = WS_Y;
static_assert(WS_END <= (size_t)256 * 1024 * 1024, "workspace map exceeds 256 MiB");

constexpr int LDS_TOTAL = 144 * 1024;
constexpr int LDS_BYTES = LDS_TOTAL;
struct Params { const float* in[N_IN]; float* out; unsigned char* ws; int phase; int layer; };

__device__ __forceinline__ int tidx() { int t = threadIdx.x; asm volatile("" : "+v"(t)); return t; }
__device__ __forceinline__ float bf2f(bf16 b) { return __uint_as_float(((unsigned)b) << 16); }
__device__ __forceinline__ bf16 f2bf(float f) { unsigned u = __float_as_uint(f); u += 0x7FFFu + ((u >> 16) & 1u); return (bf16)(u >> 16); }
typedef __bf16 bf16v2 __attribute__((ext_vector_type(2)));
typedef float f32x2 __attribute__((ext_vector_type(2)));
__device__ __forceinline__ unsigned pack2(float lo, float hi) { return __builtin_bit_cast(unsigned, __builtin_convertvector((f32x2){lo, hi}, bf16v2)); }
__device__ __forceinline__ float lo2f(unsigned w) { return __uint_as_float(w << 16); }
__device__ __forceinline__ float hi2f(unsigned w) { return __uint_as_float(w & 0xFFFF0000u); }
__device__ __forceinline__ float sigmoidf_(float x) { return __builtin_amdgcn_rcpf(1.0f + __expf(-x)); }
__device__ __forceinline__ float siluf_(float x) { return x * sigmoidf_(x); }
__device__ __forceinline__ float gelu_tanh(float x) { const float u = 0.7978845608028654f * (x + 0.044715f * x * x * x); return x * sigmoidf_(2.0f * u); }
__device__ __forceinline__ float logsigmoidf_(float x) { return x >= 0.f ? -log1pf(expf(-x)) : x - log1pf(expf(x)); }
__device__ __forceinline__ int rot_bid(int k) { return (int)((blockIdx.x + gridDim.x - k) % gridDim.x); }
__device__ __forceinline__ int chunk_of(int s, int d) { return d == 0 ? s : (s < 4 ? 3 - s : 263 - s); }
__device__ __forceinline__ float lam_init_of(int l) { return 0.8f - 0.6f * expf(-0.3f * (float)l); }

typedef const __attribute__((address_space(4))) Params KParams;
struct Ctx {
    const KParams* pp; int l; unsigned char* ws; float* lds; float* out;
    __device__ Ctx(const KParams* p_, int l_, float* lds_) : pp(p_), l(l_), ws(p_->ws), lds(lds_), out(p_->out) {}
    template <class T> __device__ __forceinline__ T* W(size_t off) const { return (T*)(ws + off); }
    __device__ __forceinline__ const float* in(int i) const { return pp->in[i]; }
    __device__ __forceinline__ const float* xin_row(int row) const {
        if (l == 0) return row < CTX ? pp->in[I_CTX] + (size_t)row * D : pp->in[I_X] + (size_t)(row - CTX) * D;
        return row < CTX ? W<float>(WS_HCTX) + (size_t)row * D : out + (size_t)(row - CTX) * D; }
    __device__ __forceinline__ float* xout_row(int row) const { return row < CTX ? W<float>(WS_HCTX) + (size_t)row * D : out + (size_t)(row - CTX) * D; }
    __device__ __forceinline__ const float* mods(int row) const { return W<float>(WS_MODS) + ((size_t)l * 2 + (row < CTX ? 1 : 0)) * 6144; }
    __device__ __forceinline__ int row_begin() const { return l == DEPTH - 1 ? CTX : 0; }
};

struct ConvDesc { const float* src; bf16* dst; int ld, col0, nvalid, K, drow0, k0; };
__device__ __forceinline__ ConvDesc conv_decode(const Ctx& c, int ti) {
    const int l = c.l; ConvDesc d;
    constexpr int T0 = 640, T1 = T0 + 1024, T2 = T1 + 256, T3 = T2 + 256, T4 = T3 + 1408, T5 = T4 + 704;
    if (ti < T0) { const int jt = ti >> 4, kt = ti & 15; int nv = GATE0 - jt * 64; nv = nv < 0 ? 0 : (nv > 64 ? 64 : nv);
        d = ConvDesc{c.in(I_WIN) + (size_t)l * D * IN_TOTAL, c.W<bf16>(WS_WINT), IN_TOTAL, jt * 64, nv, D, jt * 64, kt * 64}; }
    else if (ti < T1) { const int u = ti - T0, jt = u >> 4, kt = u & 15;
        d = ConvDesc{c.in(I_WIN) + (size_t)l * D * IN_TOTAL, c.W<bf16>(WS_WGT), IN_TOTAL, GATE0 + jt * 64, 64, D, jt * 64, kt * 64}; }
    else if (ti < T2) { const int u = ti - T1, n = u >> 6, jt = (u >> 2) & 15, kt = u & 3;
        d = ConvDesc{c.in(I_WBR) + ((size_t)l * 4 + n) * 256 * D, c.W<bf16>(WS_WBRT) + (size_t)n * D * 256, D, jt * 64, 64, 256, jt * 64, kt * 64}; }
    else if (ti < T3) { const int u = ti - T2, jt = u >> 4, kt = u & 15;
        d = ConvDesc{c.in(I_WOUT) + (size_t)l * D * D, c.W<bf16>(WS_WOUTT), D, jt * 64, 64, D, jt * 64, kt * 64}; }
    else if (ti < T4) { const int u = ti - T3, jt = u >> 4, kt = u & 15; const int r0 = jt * 64, pn = r0 >> 8, bj = (r0 >> 7) & 1, cc = r0 & 127;
        d = ConvDesc{c.in(I_WUP) + (size_t)l * D * 2 * DFF, c.W<bf16>(WS_WUPT), 2 * DFF, bj * DFF + 128 * pn + cc, 64, D, r0, kt * 64}; }
    else if (ti < T5) { const int u = ti - T4, jt = u / 44, kt = u % 44;
        d = ConvDesc{c.in(I_WDN) + (size_t)l * DFF * D, c.W<bf16>(WS_WDNT), D, jt * 64, 64, DFF, jt * 64, kt * 64}; }
    else { const int u = ti - T5, jt = u >> 2, kt = u & 3;
        d = ConvDesc{c.in(I_SWGLU) + (size_t)l * 256 * 256, c.W<bf16>(WS_WGLUT), 256, jt * 64, 64, 256, jt * 64, kt * 64}; }
    return d;
}
__device__ __forceinline__ void phase_prep(const Ctx& c) {
    const int l = c.l, t = tidx();
    constexpr int T6 = 640 + 1024 + 256 + 256 + 1408 + 704 + 16;
    { int ti = blockIdx.x; float v[8]; ConvDesc d;
      if (ti < T6) { d = conv_decode(c, ti);
#pragma unroll
          for (int q = 0; q < 8; ++q) { const int i = t + q * NT, kk = i >> 6, j = i & 63; v[q] = (j < d.nvalid) ? d.src[(size_t)(d.k0 + kk) * d.ld + d.col0 + j] : 0.f; } }
      while (ti < T6) {
          const int nti = ti + gridDim.x; float nv[8]; ConvDesc nd = d;
          if (nti < T6) { nd = conv_decode(c, nti);
#pragma unroll
              for (int q = 0; q < 8; ++q) { const int i = t + q * NT, kk = i >> 6, j = i & 63; nv[q] = (j < nd.nvalid) ? nd.src[(size_t)(nd.k0 + kk) * nd.ld + nd.col0 + j] : 0.f; } }
          else {
#pragma unroll
              for (int q = 0; q < 8; ++q) nv[q] = 0.f; }
          __syncthreads();
#pragma unroll
          for (int q = 0; q < 8; ++q) { const int i = t + q * NT; c.lds[(i >> 6) * 65 + (i & 63)] = v[q]; }
          __syncthreads();
          { const int j = t >> 3, kq = t & 7;
            const int js = (j & 32) | (((j >> 2) & 3) << 3) | (((j >> 4) & 1) << 2) | (j & 3);
            const float* lp = c.lds + (kq * 8) * 65 + js; u32x4 w;
            w.x = pack2(lp[0], lp[65]); w.y = pack2(lp[130], lp[195]); w.z = pack2(lp[260], lp[325]); w.w = pack2(lp[390], lp[455]);
            *(u32x4*)(d.dst + (size_t)(d.drow0 + j) * d.K + d.k0 + kq * 8) = w; }
          d = nd; ti = nti;
#pragma unroll
          for (int q = 0; q < 8; ++q) v[q] = nv[q];
      } }
    __syncthreads();
    if (l != 0) return;
    for (int task = blockIdx.x; task < 192; task += gridDim.x) {
        const int ll = task / 96, cb = task % 96, t = tidx(), kq = t >> 6, j = t & 63;
        const float* w = c.in(I_WADA) + (size_t)ll * D * 6144 + cb * 64 + j;
        float a0 = 0.f, a1 = 0.f;
#pragma unroll 16
        for (int k = kq * 128; k < kq * 128 + 128; ++k) { const float wv = w[(size_t)k * 6144]; a0 += siluf_(c.in(I_C)[k]) * wv; a1 += siluf_(c.in(I_CCTX)[k]) * wv; }
        c.lds[t] = a0; c.lds[512 + t] = a1;
        __syncthreads();
        if (t < 128) { const int s = t >> 6, jj = t & 63; float v = 0.f; for (int q = 0; q < 8; ++q) v += c.lds[s * 512 + q * 64 + jj];
            c.W<float>(WS_MODS)[((size_t)ll * 2 + s) * 6144 + cb * 64 + jj] = v + c.in(I_BADA)[(size_t)ll * 6144 + cb * 64 + jj]; }
        __syncthreads();
    }
    for (int i = blockIdx.x * NT + tidx(); i < 2048; i += gridDim.x * NT) { const int pos = i >> 3, e = i & 7; const float ang = (float)pos * (1.0f / powf(10000.0f, (float)(2 * e) / 16.0f));
        c.W<float>(WS_ROPE)[i * 2] = cosf(ang); c.W<float>(WS_ROPE)[i * 2 + 1] = sinf(ang); }
    for (int i = blockIdx.x * NT + tidx(); i < 4096; i += gridDim.x * NT) {
        const int g = (i >> 6) & 15;
        const float lre = c.in(I_SLRE)[i], lim = c.in(I_SLIM)[i], dt = expf(c.in(I_SLOG)[(i >> 6)]);
        (void)g;
        const float mag = expf(lre * dt), lbr = mag * cosf(lim * dt), lbi = mag * sinf(lim * dt);
        const float nr = lbr - 1.0f, ni = lbi, den = lre * lre + lim * lim;
        const float kr = (nr * lre + ni * lim) / den, ki = (ni * lre - nr * lim) / den;
        c.W<float>(WS_S5LB)[i * 2] = lbr; c.W<float>(WS_S5LB)[i * 2 + 1] = lbi;
        for (int cc = 0; cc < 16; ++cc) { const float br = c.in(I_SBRE)[(size_t)i * 16 + cc], bi = c.in(I_SBIM)[(size_t)i * 16 + cc];
            c.W<float>(WS_S5BB)[(size_t)i * 32 + cc] = kr * br - ki * bi; c.W<float>(WS_S5BB)[(size_t)i * 32 + 16 + cc] = kr * bi + ki * br; }
    }
}

__device__ __forceinline__ u32x4 pack8(f32x4 a, f32x4 b) { u32x4 w; w.x = pack2(a.x, a.y); w.y = pack2(a.z, a.w); w.z = pack2(b.x, b.y); w.w = pack2(b.z, b.w); return w; }
__device__ __forceinline__ void phase_norm(const Ctx& c, int which) {
    const int wave = tidx() >> 6, lane = tidx() & 63;
    const float* g = c.in(which == 0 ? I_N1G : I_N2G) + (size_t)c.l * D;
    const int r0 = which == 0 ? 0 : c.row_begin();
    for (int row = r0 + blockIdx.x * 8 + wave; row < ROWS; row += gridDim.x * 8) {
        const float* x = which == 0 ? c.xin_row(row) : c.xout_row(row);
        const float* m = c.mods(row) + (which == 0 ? 0 : 3 * D);
        f32x4 v[4]; float ss = 0.f;
        const int nsl = (row >= CTX) ? 0 : ((c.l == 0 && which == 1) ? 4 : ((c.l == 1 && which == 0) ? 11 : 0));
        if (nsl) { const float* slab = (c.l == 0) ? c.W<float>(WS_SLABW) : c.W<float>(WS_SLABF); const float* gate = c.W<float>(WS_MODS) + 6144 + (c.l == 0 ? 2 : 5) * D;
            const float* xb = (c.l == 0) ? c.in(I_CTX) + (size_t)row * D : c.W<float>(WS_HCTX) + (size_t)row * D;
#pragma unroll
            for (int i = 0; i < 4; ++i) { const int col = (i >> 1) * 512 + lane * 8 + (i & 1) * 4; f32x4 a = (f32x4){0.f, 0.f, 0.f, 0.f};
                for (int k = 0; k < nsl; ++k) a += *(const f32x4*)(slab + ((size_t)k * CTX + row) * D + col);
                v[i] = *(const f32x4*)(xb + col) + *(const f32x4*)(gate + col) * a;
                if (c.l == 0) *(f32x4*)(c.W<float>(WS_HCTX) + (size_t)row * D + col) = v[i];
                ss += v[i].x * v[i].x + v[i].y * v[i].y + v[i].z * v[i].z + v[i].w * v[i].w; } }
        else {
#pragma unroll
            for (int i = 0; i < 4; ++i) { v[i] = *(const f32x4*)(x + (i >> 1) * 512 + lane * 8 + (i & 1) * 4); ss += v[i].x * v[i].x + v[i].y * v[i].y + v[i].z * v[i].z + v[i].w * v[i].w; } }
#pragma unroll
        for (int o = 32; o >= 1; o >>= 1) ss += __shfl_xor(ss, o);
        const float rstd = rsqrtf(ss * (1.0f / D) + 1e-6f);
        bf16* o = c.W<bf16>(WS_HN) + (size_t)row * D;
#pragma unroll
        for (int h = 0; h < 2; ++h) { f32x4 y[2];
#pragma unroll
            for (int e = 0; e < 2; ++e) { const int col = h * 512 + lane * 8 + e * 4; const f32x4 gg = *(const f32x4*)(g + col), sh = *(const f32x4*)(m + col), sc = *(const f32x4*)(m + D + col);
                y[e] = (v[h * 2 + e] * rstd * gg) * (1.0f + sc) + sh; }
            *(u32x4*)(o + h * 512 + lane * 8) = pack8(y[0], y[1]); }
    }
}

__device__ __forceinline__ u32x2 pack4(f32x4 v) { u32x2 w; w.x = pack2(v.x, v.y); w.y = pack2(v.z, v.w); return w; }
struct EpiInproj { static constexpr bool BATCH4 = false, SIGNAL = false; bf16* z; float* za;
    __device__ __forceinline__ void store_row(int row, int col0, f32x4 v00, f32x4 v01, f32x4 v10, f32x4 v11) const {
        if (col0 < NZ) { bf16* p = z + (size_t)row * NZ + col0; *(u32x4*)p = pack8(v00, v01); *(u32x4*)(p + 128) = pack8(v10, v11); }
        else if (col0 < NZ + 32) { float* p = za + (size_t)row * 32 + (col0 - NZ); *(f32x4*)p = v00; *(f32x4*)(p + 4) = v01; } } };
struct EpiGlu { static constexpr bool BATCH4 = false, SIGNAL = true; const bf16* ys5; bf16* y; unsigned* flag;
    __device__ __forceinline__ void signal(int row_tile0) const {
        if (flag != nullptr && row_tile0 == 0) { asm volatile("s_waitcnt vmcnt(0)" ::: "memory");
            if ((tidx() & 63) == 0) { __builtin_amdgcn_fence(__ATOMIC_RELEASE, "agent"); asm volatile("s_waitcnt vmcnt(0)" ::: "memory"); (void)__hip_atomic_fetch_add(flag, 1u, __ATOMIC_RELAXED, __HIP_MEMORY_SCOPE_AGENT); } } }
    __device__ __forceinline__ u32x4 one(const bf16* pz, f32x4 v, f32x4 u) const { const u32x4 zz = *(const u32x4*)pz; f32x4 o, q;
        o.x = lo2f(zz.x) * sigmoidf_(v.x); o.y = hi2f(zz.x) * sigmoidf_(v.y); o.z = lo2f(zz.y) * sigmoidf_(v.z); o.w = hi2f(zz.y) * sigmoidf_(v.w);
        q.x = lo2f(zz.z) * sigmoidf_(u.x); q.y = hi2f(zz.z) * sigmoidf_(u.y); q.z = lo2f(zz.w) * sigmoidf_(u.z); q.w = hi2f(zz.w) * sigmoidf_(u.w); return pack8(o, q); }
    __device__ __forceinline__ void store_row(int row, int col0, f32x4 v00, f32x4 v01, f32x4 v10, f32x4 v11) const {
        const bf16* pz = ys5 + (size_t)row * 256 + col0; bf16* py = y + (size_t)row * D + col0;
        *(u32x4*)py = one(pz, v00, v01); *(u32x4*)(py + 128) = one(pz + 128, v10, v11); } };
struct EpiResid { static constexpr bool BATCH4 = true, SIGNAL = false; const float* xs_ctx; const float* xs_lat; float* xo_ctx; float* xo_lat; const float* g_ctx; const float* g_lat;
    __device__ __forceinline__ void store_rows4(int row, int col0, const f32x4 (&a)[2][4][2]) const {
        const bool ic = row < CTX; const size_t off = (size_t)(ic ? row : row - CTX) * D + col0;
        const float* xs = (ic ? xs_ctx : xs_lat) + off; float* xo = (ic ? xo_ctx : xo_lat) + off; const float* g = (ic ? g_ctx : g_lat) + col0;
        f32x4 xv[4][2][2];
#pragma unroll
        for (int m = 0; m < 4; ++m)
#pragma unroll
            for (int bj = 0; bj < 2; ++bj)
#pragma unroll
                for (int n = 0; n < 2; ++n) xv[m][bj][n] = *(const f32x4*)(xs + (size_t)m * 16 * D + bj * 128 + n * 4);
#pragma unroll
        for (int bj = 0; bj < 2; ++bj)
#pragma unroll
            for (int n = 0; n < 2; ++n) { const f32x4 gg = *(const f32x4*)(g + bj * 128 + n * 4);
#pragma unroll
                for (int m = 0; m < 4; ++m) *(f32x4*)(xo + (size_t)m * 16 * D + bj * 128 + n * 4) = xv[m][bj][n] + gg * a[bj][m][n]; } }
    __device__ __forceinline__ void store_row(int row, int col0, f32x4 v00, f32x4 v01, f32x4 v10, f32x4 v11) const {
        const bool ic = row < CTX; const size_t off = (size_t)(ic ? row : row - CTX) * D + col0;
        const float* xs = (ic ? xs_ctx : xs_lat) + off; float* xo = (ic ? xo_ctx : xo_lat) + off; const float* g = (ic ? g_ctx : g_lat) + col0;
        *(f32x4*)xo = *(const f32x4*)xs + *(const f32x4*)g * v00; *(f32x4*)(xo + 4) = *(const f32x4*)(xs + 4) + *(const f32x4*)(g + 4) * v01;
        *(f32x4*)(xo + 128) = *(const f32x4*)(xs + 128) + *(const f32x4*)(g + 128) * v10; *(f32x4*)(xo + 132) = *(const f32x4*)(xs + 132) + *(const f32x4*)(g + 132) * v11; } };
__device__ __forceinline__ EpiResid make_resid(const Ctx& c, int gate_off, bool from_in) {
    EpiResid e; float* hc = c.W<float>(WS_HCTX);
    e.xs_ctx = (from_in && c.l == 0) ? c.in(I_CTX) : hc; e.xs_lat = (from_in && c.l == 0) ? c.in(I_X) : c.out;
    e.xo_ctx = hc; e.xo_lat = c.out;
    e.g_ctx = c.W<float>(WS_MODS) + ((size_t)c.l * 2 + 1) * 6144 + gate_off; e.g_lat = c.W<float>(WS_MODS) + ((size_t)c.l * 2) * 6144 + gate_off; return e; }

namespace pg8 {
#define PG8_LAS __attribute__((address_space(3)))
constexpr int BM = 256, BK = 64, HALF = 128, HTB = HALF * BK * 2, STAGE_BYTES = 8 * HTB, NXCD = 8, WGM = 8;
__device__ __forceinline__ int lds_byte(int r, int c) { const int st = (r >> 4) * 2 + (c >> 5), rr = r & 15, cc = c & 31, ob = rr * 64 + cc * 2; return st * 1024 + (ob ^ (((ob >> 9) & 1) << 5)); }
__device__ __forceinline__ void stage_rc(int b, int& R, int& C) { const int st = b / 1024, sb = b % 1024, swz = sb ^ (((sb >> 9) & 1) << 5); R = (st >> 1) * 16 + swz / 64; C = (st & 1) * 32 + (swz % 64) / 2; }
struct Unit { int pm, pn; };
__device__ __forceinline__ bool static_next(int i, int G, int c, int nM, int nN, Unit& u) {
    const int nwg = nM * nN; const long L = (long)i * G + c; if (L >= nwg) return false;
    int wgid = (int)L; { const int q = nwg / NXCD, r = nwg % NXCD, xcd = wgid % NXCD, off = wgid / NXCD; wgid = (xcd < r ? xcd * (q + 1) : r * (q + 1) + (xcd - r) * q) + off; }
    const int nig = WGM * nN, gid = wgid / nig, fm = gid * WGM, gsz = (nM - fm) < WGM ? (nM - fm) : WGM;
    u.pm = fm + ((wgid % nig) % gsz); u.pn = (wgid % nig) / gsz; return true;
}
template <class Epi, class Sched>
__device__ __forceinline__ void gemm_phase(PG8_LAS unsigned char* lds, const int K, const Sched& S, const Epi& E) {
    const int tid = tidx(), wid = __builtin_amdgcn_readfirstlane(tid >> 6), lane = tid & 63, wr = wid >> 2, wc = wid & 3, fr = lane & 15, fq = lane >> 4;
    int sR[2], sC[2];
#pragma unroll
    for (int i = 0; i < 2; ++i) { int R, C; stage_rc(tid * 16 + i * 8192, R, C); sR[i] = R; sC[i] = C; }
    const size_t kstep = (size_t)(BK * 2);
    const unsigned ldsw = (unsigned)wid * 1024u;
    const int aoff = lds_byte(wr * 64 + fr, fq * 8), boff = lds_byte(wc * 32 + fr, fq * 8);
#define PG8_SA(b, h) (((b) * 2 + (h)) * HTB)
#define PG8_SB(b, h) ((4 + (b) * 2 + (h)) * HTB)
#define PG8_STAGE(bufoff, gbase, voff) do { _Pragma("unroll") for (int _i = 0; _i < 2; ++_i) \
        __builtin_amdgcn_global_load_lds((const unsigned*)((const char*)(gbase) + (voff)[_i]), (PG8_LAS unsigned*)(lds + (bufoff) + ldsw + _i * 8192), 16, 0, 0); } while (0)
#define PG8_LDA(dst, b, h) do { _Pragma("unroll") for (int m = 0; m < 4; ++m) _Pragma("unroll") for (int k = 0; k < 2; ++k) dst[m][k] = *(const PG8_LAS bf16x8*)(lds + PG8_SA(b, h) + aoff + m * 2048 + k * 1024); } while (0)
#define PG8_LDB(dst, b, h) do { _Pragma("unroll") for (int n = 0; n < 2; ++n) _Pragma("unroll") for (int k = 0; k < 2; ++k) dst[n][k] = *(const PG8_LAS bf16x8*)(lds + PG8_SB(b, h) + boff + n * 2048 + k * 1024); } while (0)
#define PG8_MMA(ai, bj, At, Bt) do { __builtin_amdgcn_s_setprio(1); _Pragma("unroll") for (int m = 0; m < 4; ++m) _Pragma("unroll") for (int n = 0; n < 2; ++n) _Pragma("unroll") for (int k = 0; k < 2; ++k) \
        acc[ai][bj][m][n] = __builtin_amdgcn_mfma_f32_16x16x32_bf16(Bt[n][k], At[m][k], acc[ai][bj][m][n], 0, 0, 0); __builtin_amdgcn_s_setprio(0); } while (0)
#define PG8_WAIT_V(n) asm volatile("s_waitcnt vmcnt(" #n ")" ::: "memory")
#define PG8_WAIT_L(n) asm volatile("s_waitcnt lgkmcnt(" #n ")" ::: "memory")
#define PG8_BAR __builtin_amdgcn_s_barrier()
#define PG8_SCHED __builtin_amdgcn_sched_barrier(0)
    Unit cur, nxt; int ui = 0;
    if (!S.next(0, cur)) return;
    int Kc = Sched::HETERO ? S.Kof(cur) : K, nt = Kc / BK; const int ldb0 = Sched::HETERO ? S.ldbof(cur) : K;
    unsigned voffB[2], voffBn[2]; size_t hstepB = (size_t)HALF * ldb0 * 2, hstepBn = hstepB;
#pragma unroll
    for (int i = 0; i < 2; ++i) { voffB[i] = (unsigned)(sR[i] * ldb0 + sC[i]) * 2u; voffBn[i] = voffB[i]; }
    f32x4 acc[2][2][4][2];
#pragma unroll
    for (int a = 0; a < 2; ++a)
#pragma unroll
        for (int b = 0; b < 2; ++b)
#pragma unroll
            for (int m = 0; m < 4; ++m)
#pragma unroll
                for (int n = 0; n < 2; ++n) acc[a][b][m][n] = (f32x4){0.f, 0.f, 0.f, 0.f};
    bf16x8 At[4][2], B0[2][2], B1[2][2];
    unsigned oc0[2], oc1[2], on0[2], on1[2];
#pragma unroll
    for (int i = 0; i < 2; ++i) { oc0[i] = S.aoff(cur, 0, sR[i], sC[i]); oc1[i] = S.aoff(cur, 1, sR[i], sC[i]); }
    const char* cA = S.abase(cur); const char* cB = S.bbase(cur);
    PG8_STAGE(PG8_SB(0, 0), cB, voffB); PG8_STAGE(PG8_SB(0, 1), cB + hstepB, voffB); PG8_STAGE(PG8_SA(0, 0), cA, oc0); PG8_STAGE(PG8_SA(0, 1), cA, oc1);
    if (wr == 1) PG8_BAR;
    PG8_WAIT_V(2); PG8_BAR;
    PG8_STAGE(PG8_SB(1, 0), cB + kstep, voffB); PG8_STAGE(PG8_SA(1, 0), cA + kstep, oc0); PG8_STAGE(PG8_SB(1, 1), cB + hstepB + kstep, voffB);
    PG8_WAIT_V(6); PG8_BAR;
    for (;;) {
        const bool has_next = S.next(ui + 1, nxt);
        const char* nA = has_next ? S.abase(nxt) : cA; const char* nB = has_next ? S.bbase(nxt) : cB;
        int Kn = Kc;
        if (Sched::HETERO) { Kn = has_next ? S.Kof(nxt) : Kc; const int ldbn = has_next ? S.ldbof(nxt) : (int)(hstepB / (HALF * 2)); hstepBn = (size_t)HALF * ldbn * 2;
#pragma unroll
            for (int i = 0; i < 2; ++i) voffBn[i] = (unsigned)(sR[i] * ldbn + sC[i]) * 2u; }
#pragma unroll
        for (int i = 0; i < 2; ++i) { if (Sched::AMAP) { on0[i] = has_next ? S.aoff(nxt, 0, sR[i], sC[i]) : oc0[i]; on1[i] = has_next ? S.aoff(nxt, 1, sR[i], sC[i]) : oc1[i]; } else { on0[i] = oc0[i]; on1[i] = oc1[i]; } }
        for (int t = 0; t < nt; t += 2) {
            const bool last = (t == nt - 2);
            const char* a1 = cA + (size_t)(t + 1) * kstep;
            const char* a2 = last ? nA : cA + (size_t)(t + 2) * kstep; const char* b2 = last ? nB : cB + (size_t)(t + 2) * kstep;
            const char* a3 = a2 + kstep; const char* b3 = b2 + kstep;
            unsigned o20[2], o21[2];
#pragma unroll
            for (int i = 0; i < 2; ++i) { o20[i] = last ? on0[i] : oc0[i]; o21[i] = last ? on1[i] : oc1[i]; }
            unsigned vb2[2]; size_t hs2 = hstepB;
#pragma unroll
            for (int i = 0; i < 2; ++i) vb2[i] = (Sched::HETERO && last) ? voffBn[i] : voffB[i];
            if (Sched::HETERO && last) hs2 = hstepBn;
            PG8_LDB(B0, 0, 0); PG8_LDB(B1, 0, 1); PG8_SCHED; PG8_LDA(At, 0, 0); PG8_STAGE(PG8_SA(1, 1), a1, oc1);
            PG8_WAIT_V(8); PG8_WAIT_L(0); PG8_BAR; PG8_MMA(0, 0, At, B0); PG8_MMA(0, 1, At, B1); PG8_BAR; PG8_SCHED;
            PG8_LDA(At, 0, 1); PG8_STAGE(PG8_SB(0, 0), b2, vb2); PG8_STAGE(PG8_SB(0, 1), b2 + hs2, vb2); PG8_STAGE(PG8_SA(0, 0), a2, o20);
            PG8_WAIT_V(8); PG8_WAIT_L(0); PG8_BAR; PG8_MMA(1, 0, At, B0); PG8_MMA(1, 1, At, B1); PG8_BAR; PG8_SCHED;
            PG8_LDB(B0, 1, 0); PG8_LDB(B1, 1, 1); PG8_SCHED; PG8_LDA(At, 1, 0); PG8_STAGE(PG8_SA(0, 1), a2, o21);
            PG8_WAIT_V(8); PG8_WAIT_L(0); PG8_BAR; PG8_MMA(0, 0, At, B0); PG8_MMA(0, 1, At, B1); PG8_BAR; PG8_SCHED;
            PG8_LDA(At, 1, 1); PG8_STAGE(PG8_SB(1, 0), b3, vb2); PG8_STAGE(PG8_SB(1, 1), b3 + hs2, vb2); PG8_STAGE(PG8_SA(1, 0), a3, o20);
            PG8_WAIT_V(8); PG8_WAIT_L(0); PG8_BAR; PG8_MMA(1, 0, At, B0); PG8_MMA(1, 1, At, B1); PG8_BAR; PG8_SCHED;
        }
        if (wr == 0) PG8_BAR;
        E(acc, cur, wr, wc, fr, fq);
        if (!has_next) break;
#pragma unroll
        for (int a = 0; a < 2; ++a)
#pragma unroll
            for (int b = 0; b < 2; ++b)
#pragma unroll
                for (int m = 0; m < 4; ++m)
#pragma unroll
                    for (int n = 0; n < 2; ++n) acc[a][b][m][n] = (f32x4){0.f, 0.f, 0.f, 0.f};
        cur = nxt; cA = nA; cB = nB; ++ui;
        if (Sched::HETERO) { Kc = Kn; nt = Kc / BK; hstepB = hstepBn;
#pragma unroll
            for (int i = 0; i < 2; ++i) voffB[i] = voffBn[i]; }
        if (wr == 1) PG8_BAR;
#pragma unroll
        for (int i = 0; i < 2; ++i) { oc0[i] = on0[i]; oc1[i] = on1[i]; }
    }
    PG8_WAIT_V(0);
    PG8_BAR;
#undef PG8_SA
#undef PG8_SB
#undef PG8_STAGE
#undef PG8_LDA
#undef PG8_LDB
#undef PG8_MMA
#undef PG8_WAIT_V
#undef PG8_WAIT_L
#undef PG8_BAR
#undef PG8_SCHED
}
struct SchedLin { static constexpr bool AMAP = false, HETERO = false; __device__ __forceinline__ int Kof(const Unit&) const { return K; } __device__ __forceinline__ int ldbof(const Unit&) const { return K; }
    const bf16* A; const bf16* Bt; int lda, K, row0, nM, nN, G, c;
    __device__ __forceinline__ bool next(int i, Unit& u) const { return static_next(i, G, c, nM, nN, u); }
    __device__ __forceinline__ const char* abase(const Unit& u) const { return (const char*)(A + (size_t)(row0 + BM * u.pm) * lda); }
    __device__ __forceinline__ const char* bbase(const Unit& u) const { return (const char*)(Bt + (size_t)BM * u.pn * K); }
    __device__ __forceinline__ unsigned aoff(const Unit&, int h, int R, int C) const { return (unsigned)((h * HALF + R) * lda + C) * 2u; }
};
template <class F> struct EpiLin { F f; int row0;
    __device__ __forceinline__ void operator()(const f32x4 (&acc)[2][2][4][2], const Unit& u, int wr, int wc, int fr, int fq) const {
        const int col0 = u.pn * BM + wc * 32 + 8 * fq;
#pragma unroll
        for (int ai = 0; ai < 2; ++ai) {
            if constexpr (F::BATCH4) {
                f.store_rows4(row0 + u.pm * BM + ai * HALF + wr * 64 + fr, col0, acc[ai]);
                asm volatile("" ::: "memory");
            } else {
#pragma unroll
                for (int m = 0; m < 4; ++m) { const int row = row0 + u.pm * BM + ai * HALF + wr * 64 + m * 16 + fr;
                    f.store_row(row, col0, acc[ai][0][m][0], acc[ai][0][m][1], acc[ai][1][m][0], acc[ai][1][m][1]);
                    asm volatile("" ::: "memory"); }
            } }
        if constexpr (F::SIGNAL) f.signal(row0 + u.pm * BM);
    } };
struct SchedRes { static constexpr bool AMAP = false, HETERO = true; const bf16* A; const bf16* Bt; int lda, K, nks, G, c;
    __device__ __forceinline__ bool next(int i, Unit& u) const {
        if (i == 0) { Unit v; if (!static_next(0, G, c, 64, 4, v)) return false; u.pm = v.pm + 1; u.pn = v.pn; return true; }
        if (i == 1 && c < 4 * nks) { u.pm = 0; u.pn = (c & 3) | ((c >> 2) << 2) | 64; return true; }
        return false; }
    __device__ __forceinline__ int Kof(const Unit& u) const { return (u.pn & 64) ? 256 : K; }
    __device__ __forceinline__ int ldbof(const Unit&) const { return K; }
    __device__ __forceinline__ const char* abase(const Unit& u) const { return (u.pn & 64) ? (const char*)(A + ((u.pn >> 2) & 15) * 256) : (const char*)(A + (size_t)(BM * u.pm) * lda); }
    __device__ __forceinline__ const char* bbase(const Unit& u) const { return (u.pn & 64) ? (const char*)(Bt + (size_t)BM * (u.pn & 3) * K + ((u.pn >> 2) & 15) * 256) : (const char*)(Bt + (size_t)BM * u.pn * K); }
    __device__ __forceinline__ unsigned aoff(const Unit&, int h, int R, int C) const { return (unsigned)((h * HALF + R) * lda + C) * 2u; } };
template <class F> struct EpiRes { F f; float* slab;
    __device__ __forceinline__ void operator()(const f32x4 (&acc)[2][2][4][2], const Unit& u, int wr, int wc, int fr, int fq) const {
        if (u.pn & 64) { float* sp = slab + ((size_t)((u.pn >> 2) & 15) * CTX + wr * 64 + fr) * D + (u.pn & 3) * BM + wc * 32 + 8 * fq;
#pragma unroll
            for (int ai = 0; ai < 2; ++ai)
#pragma unroll
                for (int m = 0; m < 4; ++m)
#pragma unroll
                    for (int bj = 0; bj < 2; ++bj)
#pragma unroll
                        for (int n = 0; n < 2; ++n) *(f32x4*)(sp + (size_t)(ai * HALF + m * 16) * D + bj * HALF + n * 4) = acc[ai][bj][m][n];
        } else { const int col0 = u.pn * BM + wc * 32 + 8 * fq;
#pragma unroll
            for (int ai = 0; ai < 2; ++ai) { f.store_rows4(u.pm * BM + ai * HALF + wr * 64 + fr, col0, acc[ai]); asm volatile("" ::: "memory"); } }
    } };
}
template <class F>
__device__ __forceinline__ void gemm_lin(const bf16* A, int lda, const bf16* Bt, int row0, int nrows, int N, int K, const F& f, float* lds) {
    pg8::SchedLin S{A, Bt, lda, K, row0, nrows / 256, N / 256, (int)gridDim.x, (int)blockIdx.x};
    pg8::EpiLin<F> E{f, row0};
    pg8::gemm_phase(( __attribute__((address_space(3))) unsigned char*)lds, K, S, E);
}

template <class F>
__device__ __forceinline__ void gemm_res_l0(const bf16* A, int lda, const bf16* Bt, int K, int nks, const F& f, float* slab, float* lds) {
    pg8::SchedRes S{A, Bt, lda, K, nks, (int)gridDim.x, (int)blockIdx.x};
    pg8::EpiRes<F> E{f, slab};
    pg8::gemm_phase((__attribute__((address_space(3))) unsigned char*)lds, K, S, E);
}
namespace pg8 {
struct MergeGeo { int mode, G, c;
    __device__ __forceinline__ bool decode(int i, Unit& u) const {
        if (mode == 2) { const int idx = c - 64; if (idx < 0 || idx >= 12 || i >= 2) return false; u.pm = 0; u.pn = (idx / 3) | ((1 + idx % 3) << 2) | (i << 4) | (1 << 5); return true; }
        if (mode == 3 || mode == 4) { const int idx = c - 76; if (idx < 0 || idx >= 4 || i >= 1) return false; u.pm = 0; u.pn = idx | (0 << 2) | ((mode == 3 ? 1 : 0) << 4) | (3 << 5); return true; }
        if (i < 8) { const int s = c; if (s >= 256) return false; const int sp = (s & 7) * 32 + (s >> 3); u.pm = CTX + (sp >> 2) * 256; u.pn = (sp & 3) | ((i >> 1) << 2) | ((i & 1) << 4); return true; }
        return false; } };
struct SchedPG { static constexpr bool AMAP = false, HETERO = true; const bf16* hn; const bf16* y; const bf16* wg; const bf16* wb; MergeGeo geo;
    __device__ __forceinline__ bool next(int i, Unit& u) const { return geo.decode(i, u); }
    __device__ __forceinline__ int Kof(const Unit& u) const { return (u.pn & 16) ? D : 256; }
    __device__ __forceinline__ int ldbof(const Unit& u) const { return (u.pn & 16) ? D : 256; }
    __device__ __forceinline__ const char* abase(const Unit& u) const { const int n = (u.pn >> 2) & 3;
        return (u.pn & 16) ? (const char*)(hn + (size_t)u.pm * D) : (const char*)(y + (size_t)u.pm * D + n * 256); }
    __device__ __forceinline__ const char* bbase(const Unit& u) const { const int n = (u.pn >> 2) & 3, dt = u.pn & 3;
        return (u.pn & 16) ? (const char*)(wg + ((size_t)n * D + (size_t)dt * BM) * D) : (const char*)(wb + ((size_t)n * D + (size_t)dt * BM) * 256); }
    __device__ __forceinline__ unsigned aoff(const Unit&, int h, int R, int C) const { return (unsigned)((h * HALF + R) * D + C) * 2u; } };
struct EpiPG { unsigned char* scr; unsigned char* parts; bf16* merged;
    __device__ __forceinline__ void operator()(const f32x4 (&acc)[2][2][4][2], const Unit& u, int wr, int wc, int fr, int fq) const {
        const size_t lo = (size_t)tidx() * 16; unsigned char* p = scr + lo;
        const int dt = u.pn & 3, n = (u.pn >> 2) & 3, kind = u.pn >> 5;
        if (kind == 3) {
            unsigned char* q0 = parts + (size_t)(12 + dt) * 131072 + lo;
#pragma unroll
            for (int ai = 0; ai < 2; ++ai)
#pragma unroll
                for (int bj = 0; bj < 2; ++bj)
#pragma unroll
                    for (int m = 0; m < 4; ++m) { const f32x4 a = acc[ai][bj][m][0], b = acc[ai][bj][m][1]; f32x4 v, u2;
                        if (u.pn & 16) { v.x = sigmoidf_(a.x); v.y = sigmoidf_(a.y); v.z = sigmoidf_(a.z); v.w = sigmoidf_(a.w); u2.x = sigmoidf_(b.x); u2.y = sigmoidf_(b.y); u2.z = sigmoidf_(b.z); u2.w = sigmoidf_(b.w);
                            *(u32x4*)(p + ((ai * 2 + bj) * 4 + m) * 8192) = pack8(v, u2); }
                        else { const u32x4 w = *(const u32x4*)(p + ((ai * 2 + bj) * 4 + m) * 8192);
                            v.x = a.x * lo2f(w.x); v.y = a.y * hi2f(w.x); v.z = a.z * lo2f(w.y); v.w = a.w * hi2f(w.y); u2.x = b.x * lo2f(w.z); u2.y = b.y * hi2f(w.z); u2.z = b.z * lo2f(w.w); u2.w = b.w * hi2f(w.w);
                            *(u32x4*)(q0 + ((ai * 2 + bj) * 4 + m) * 8192) = pack8(v, u2); } }
        } else if (!(u.pn & 16)) {
#pragma unroll
            for (int ai = 0; ai < 2; ++ai)
#pragma unroll
                for (int bj = 0; bj < 2; ++bj)
#pragma unroll
                    for (int m = 0; m < 4; ++m) { const u32x2 w0 = pack4(acc[ai][bj][m][0]), w1 = pack4(acc[ai][bj][m][1]);
                        *(u32x4*)(p + ((ai * 2 + bj) * 4 + m) * 8192) = (u32x4){w0.x, w0.y, w1.x, w1.y}; }
        } else {
            const int row0 = u.pm; const bool part = (kind == 1), first = (n == 0) || part;
            unsigned char* q = parts + (size_t)(dt * 3 + (part ? n - 1 : 0)) * 131072 + lo;
            {
#pragma unroll
                for (int ai = 0; ai < 2; ++ai) {
                    u32x4 pw[2][4], ow[2][4];
                    bf16* mp = merged + (size_t)(row0 + ai * HALF + wr * 64 + fr) * D + dt * BM + wc * 32 + 8 * fq;
#pragma unroll
                    for (int bj = 0; bj < 2; ++bj)
#pragma unroll
                        for (int m = 0; m < 4; ++m) { pw[bj][m] = *(const u32x4*)(p + ((ai * 2 + bj) * 4 + m) * 8192);
                            ow[bj][m] = first ? (u32x4){0u, 0u, 0u, 0u} : *(const u32x4*)(mp + (size_t)m * 16 * D + bj * HALF); }
#pragma unroll
                    for (int bj = 0; bj < 2; ++bj)
#pragma unroll
                        for (int m = 0; m < 4; ++m) { const f32x4 a = acc[ai][bj][m][0], b = acc[ai][bj][m][1]; const u32x4 w = pw[bj][m], o = ow[bj][m]; f32x4 v, u2;
                            v.x = sigmoidf_(a.x) * lo2f(w.x) + lo2f(o.x); v.y = sigmoidf_(a.y) * hi2f(w.x) + hi2f(o.x); v.z = sigmoidf_(a.z) * lo2f(w.y) + lo2f(o.y); v.w = sigmoidf_(a.w) * hi2f(w.y) + hi2f(o.y);
                            u2.x = sigmoidf_(b.x) * lo2f(w.z) + lo2f(o.z); u2.y = sigmoidf_(b.y) * hi2f(w.z) + hi2f(o.z); u2.z = sigmoidf_(b.z) * lo2f(w.w) + lo2f(o.w); u2.w = sigmoidf_(b.w) * hi2f(w.w) + hi2f(o.w);
                            if (part) *(u32x4*)(q + ((ai * 2 + bj) * 4 + m) * 8192) = pack8(v, u2);
                            else *(u32x4*)(mp + (size_t)m * 16 * D + bj * HALF) = pack8(v, u2); }
                    asm volatile("" ::: "memory"); }
            }
        }
    } };
struct SchedUp { static constexpr bool AMAP = true, HETERO = false; __device__ __forceinline__ int Kof(const Unit&) const { return D; } __device__ __forceinline__ int ldbof(const Unit&) const { return D; } const bf16* hn; const bf16* Bt; int nctxu, nM, nN, G, c;
    __device__ __forceinline__ bool next(int i, Unit& u) const { return static_next(i, G, c, nM, nN, u); }
    __device__ __forceinline__ const char* abase(const Unit&) const { return (const char*)hn; }
    __device__ __forceinline__ const char* bbase(const Unit& u) const { return (const char*)(Bt + (size_t)BM * u.pn * D); }
    __device__ __forceinline__ unsigned aoff(const Unit& u, int h, int R, int C) const {
        const int wr = R >> 6, m = (R >> 4) & 3, fr = R & 15, i = 8 * fr + 4 * h + m; const bool ic = u.pm < nctxu;
        const int run = 2 * (ic ? u.pm : u.pm - nctxu) + wr, seglen = ic ? CTX : SEQ; int t = 126 * run - 1 + i; t = t < 0 ? 0 : (t >= seglen ? seglen - 1 : t);
        return (unsigned)(((ic ? 0 : CTX) + t) * D + C) * 2u; } };
struct EpiUp { bf16* act; const float* cw; const float* cb; int nctxu;
    __device__ __forceinline__ void operator()(const f32x4 (&acc)[2][2][4][2], const Unit& u, int wr, int wc, int fr, int fq) const {
        const bool ic = u.pm < nctxu; const int run = 2 * (ic ? u.pm : u.pm - nctxu) + wr, seglen = ic ? CTX : SEQ, seg0 = ic ? 0 : CTX;
        const int t0 = 126 * run - 1 + 8 * fr;
        const int lane = tidx() & 63;
        u32x2 held[8];
#pragma unroll
        for (int n = 0; n < 2; ++n) {
            const int ch = 128 * u.pn + 32 * wc + 8 * fq + 4 * n;
            const f32x4 w0 = *(const f32x4*)(cw + ch), w1 = *(const f32x4*)(cw + DFF + ch), w2 = *(const f32x4*)(cw + 2 * DFF + ch), bb = *(const f32x4*)(cb + ch);
            f32x4 g[8];
#pragma unroll
            for (int j = 0; j < 8; ++j) { const int t = t0 + j; const bool ok = t >= 0 && t < seglen; g[j] = ok ? acc[j >> 2][1][j & 3][n] : (f32x4){0.f, 0.f, 0.f, 0.f}; }
            f32x4 prev, next;
            prev.x = __shfl(g[7].x, lane - 1); prev.y = __shfl(g[7].y, lane - 1); prev.z = __shfl(g[7].z, lane - 1); prev.w = __shfl(g[7].w, lane - 1);
            next.x = __shfl(g[0].x, lane + 1); next.y = __shfl(g[0].y, lane + 1); next.z = __shfl(g[0].z, lane + 1); next.w = __shfl(g[0].w, lane + 1);
#pragma unroll
            for (int j = 0; j < 8; ++j) { const int i = 8 * fr + j, t = t0 + j;
                const f32x4 gm = (j == 0) ? prev : g[j == 0 ? 0 : j - 1], gp = (j == 7) ? next : g[j == 7 ? 7 : j + 1];
                const f32x4 cv = w0 * gm + w1 * g[j] + w2 * gp + bb; const f32x4 a = acc[j >> 2][0][j & 3][n]; f32x4 o;
                o.x = gelu_tanh(cv.x) * a.x; o.y = gelu_tanh(cv.y) * a.y; o.z = gelu_tanh(cv.z) * a.z; o.w = gelu_tanh(cv.w) * a.w;
                const u32x2 pk = pack4(o);
                if (n == 0) held[j] = pk;
                else if (i >= 1 && i <= 126 && t >= 0 && t < seglen) *(u32x4*)(act + (size_t)(seg0 + t) * DFF + ch - 4) = (u32x4){held[j].x, held[j].y, pk.x, pk.y}; }
        }
    } };
}
constexpr size_t WS_MERGED = WS_S5END;
static_assert(WS_END - WS_S5END >= (size_t)ROWS * D * 2, "merged alias does not fit");
__device__ __forceinline__ void phase_merge_pg(const Ctx& c, const int mode) {
    pg8::MergeGeo geo{mode, (int)gridDim.x, (int)blockIdx.x};
    pg8::SchedPG S{c.W<bf16>(WS_HN), c.W<bf16>(WS_Y), c.W<bf16>(WS_WGT), c.W<bf16>(WS_WBRT), geo};
    pg8::EpiPG E{c.W<unsigned char>(WS_Z) + (size_t)blockIdx.x * 131072, c.W<unsigned char>(WS_Z) + (size_t)256 * 131072, c.W<bf16>(WS_MERGED)};
    pg8::gemm_phase((__attribute__((address_space(3))) unsigned char*)c.lds, D, S, E);
}
__device__ __forceinline__ void ctx_slab_sum(const Ctx& c) {
    const int dt = blockIdx.x, tid = tidx(), wid = tid >> 6, lane = tid & 63, wr = wid >> 2, wc = wid & 3, fr = lane & 15, fq = lane >> 4;
    const unsigned char* parts = c.W<unsigned char>(WS_Z) + (size_t)256 * 131072 + (size_t)tid * 16;
    bf16* mp = c.W<bf16>(WS_MERGED) + (size_t)(wr * 64 + fr) * D + dt * 256 + wc * 32 + 8 * fq;
#pragma unroll 4
    for (int f = 0; f < 16; ++f) { const int ai = f >> 3, bj = (f >> 2) & 1, m = f & 3;
        const u32x4 a = *(const u32x4*)(parts + (size_t)(12 + dt) * 131072 + f * 8192), b = *(const u32x4*)(parts + (size_t)(dt * 3) * 131072 + f * 8192),
                    e = *(const u32x4*)(parts + (size_t)(dt * 3 + 1) * 131072 + f * 8192), g = *(const u32x4*)(parts + (size_t)(dt * 3 + 2) * 131072 + f * 8192);
        f32x4 v, u2;
        v.x = (lo2f(a.x) + lo2f(b.x)) + (lo2f(e.x) + lo2f(g.x)); v.y = (hi2f(a.x) + hi2f(b.x)) + (hi2f(e.x) + hi2f(g.x)); v.z = (lo2f(a.y) + lo2f(b.y)) + (lo2f(e.y) + lo2f(g.y)); v.w = (hi2f(a.y) + hi2f(b.y)) + (hi2f(e.y) + hi2f(g.y));
        u2.x = (lo2f(a.z) + lo2f(b.z)) + (lo2f(e.z) + lo2f(g.z)); u2.y = (hi2f(a.z) + hi2f(b.z)) + (hi2f(e.z) + hi2f(g.z)); u2.z = (lo2f(a.w) + lo2f(b.w)) + (lo2f(e.w) + lo2f(g.w)); u2.w = (hi2f(a.w) + hi2f(b.w)) + (hi2f(e.w) + hi2f(g.w));
        *(u32x4*)(mp + (size_t)(ai * 128 + m * 16) * D + bj * 128) = pack8(v, u2); }
}
__device__ __forceinline__ void phase_ffn_up_pg(const Ctx& c) {
    const int nctxu = (c.l == DEPTH - 1) ? 0 : 2, nM = nctxu + 66;
    pg8::SchedUp S{c.W<bf16>(WS_HN), c.W<bf16>(WS_WUPT), nctxu, nM, DFF * 2 / 256, (int)gridDim.x, (int)blockIdx.x};
    pg8::EpiUp E{c.W<bf16>(WS_Z), c.in(I_FCW) + (size_t)c.l * 3 * DFF, c.in(I_FCB) + (size_t)c.l * DFF, nctxu};
    pg8::gemm_phase((__attribute__((address_space(3))) unsigned char*)c.lds, D, S, E);
}

__device__ __forceinline__ void da_prep(const Ctx& c, const int bid, const int nb) {
    const int wave = tidx() >> 6, lane = tidx() & 63, vec = lane >> 2, sub = lane & 3;
    const bool isq = vec < 8;
    const float* gain = c.in(isq ? I_DQN : I_DKN) + (size_t)c.l * 32 + sub * 8;
    const float qscale = 0.17677669529663687f * 1.4426950408889634f;
    bf16* z = c.W<bf16>(WS_Z);
    for (int row = bid * 8 + wave; row < ROWS; row += nb * 8) {
        bf16* pz = z + (size_t)row * NZ + (isq ? ZC_DAQ : ZC_DAK) + (vec & 7) * 32 + sub * 8;
        const u32x4 raw = *(const u32x4*)pz;
        float x[8] = {lo2f(raw.x), hi2f(raw.x), lo2f(raw.y), hi2f(raw.y), lo2f(raw.z), hi2f(raw.z), lo2f(raw.w), hi2f(raw.w)};
        float ss = 0.f;
#pragma unroll
        for (int e = 0; e < 8; ++e) ss += x[e] * x[e];
        ss += __shfl_xor(ss, 1); ss += __shfl_xor(ss, 2);
        const float rstd = rsqrtf(ss * (1.0f / 32.0f) + 1e-6f);
#pragma unroll
        for (int e = 0; e < 8; ++e) x[e] = x[e] * rstd * gain[e];
        if (row >= CTX) {
            const int tok = row - CTX; const float* rt = c.W<float>(WS_ROPE) + ((sub < 2) ? (tok >> 6) : (tok & 63)) * 16;
#pragma unroll
            for (int e = 0; e < 8; ++e) { const float cs = rt[e * 2], sn = rt[e * 2 + 1]; const float other = __shfl_xor(x[e], 1);
                x[e] = (sub & 1) ? (other * sn + x[e] * cs) : (x[e] * cs - other * sn); }
        }
        if (isq) {
#pragma unroll
            for (int e = 0; e < 8; ++e) x[e] *= qscale; }
        u32x4 w; w.x = pack2(x[0], x[1]); w.y = pack2(x[2], x[3]); w.z = pack2(x[4], x[5]); w.w = pack2(x[6], x[7]);
        *(u32x4*)pz = w;
    }
}

__device__ __forceinline__ void s5_mfma(const Ctx& c, const bool final_pass) {
    const int tid = tidx(), wave = tid >> 6, lane = tid & 63, r = lane & 31, hh = lane >> 5, cq = lane & 15, q4 = lane >> 4;
    unsigned char* hb = (unsigned char*)c.lds + wave * 8704;
    const bf16* z = c.W<bf16>(WS_Z);
    const int c0 = (final_pass && c.l == DEPTH - 1) ? 4 : 0;
    const int g = wave + 8 * ((int)blockIdx.x & 1);
    float lbr2[2][2], lbi2[2][2]; bf16x8 cmB2[2][4];
#pragma unroll
    for (int d = 0; d < 2; ++d) { const int sib = ((c.l * 2 + d) * 16 + g) * 64;
#pragma unroll
        for (int j = 0; j < 2; ++j) { const int si = sib + j * 32 + r; lbr2[d][j] = c.W<float>(WS_S5LB)[si * 2]; lbi2[d][j] = c.W<float>(WS_S5LB)[si * 2 + 1]; }
        if (final_pass) { const size_t cix = ((size_t)((c.l * 2 + d) * 16 + g) * 16 + cq) * 64;
#pragma unroll
            for (int s4 = 0; s4 < 4; ++s4) { const f32x4 re = *(const f32x4*)(c.in(I_SCRE) + cix + 16 * s4 + 4 * q4), im = *(const f32x4*)(c.in(I_SCIM) + cix + 16 * s4 + 4 * q4);
                cmB2[d][s4] = __builtin_bit_cast(bf16x8, __builtin_convertvector((f32x8){re.x, -im.x, re.y, -im.y, re.z, -im.z, re.w, -im.w}, bf16v8)); } } }
    for (int task = c0 * 2 + blockIdx.x; task < NCHUNK * 2; task += gridDim.x) {
        const int ch = task >> 1;
        f32x4 yacc[4];
        if (final_pass) { const float dsk = c.in(I_SD)[(size_t)c.l * 256 + g * 16 + cq];
#pragma unroll
            for (int tb = 0; tb < 4; ++tb)
#pragma unroll
                for (int rg = 0; rg < 4; ++rg) yacc[tb][rg] = bf2f(z[(size_t)(ch * 64 + tb * 16 + 4 * q4 + rg) * NZ + ZC_SSM + g * 16 + cq]) * dsk; }
#pragma unroll
        for (int d = 0; d < 2; ++d) {
            const int sib = ((c.l * 2 + d) * 16 + g) * 64;
            float lbr[2], lbi[2], hr[2], hi[2]; bf16x8 cmB[4];
#pragma unroll
            for (int j = 0; j < 2; ++j) { lbr[j] = lbr2[d][j]; lbi[j] = lbi2[d][j];
                if (final_pass) { const float* st = c.W<float>(WS_S5START) + ((size_t)(ch * 2 + d) * 16 + g) * 128 + (j * 32 + r) * 2; hr[j] = st[0]; hi[j] = st[1]; } else { hr[j] = 0.f; hi[j] = 0.f; } }
            if (final_pass) {
#pragma unroll
                for (int s4 = 0; s4 < 4; ++s4) cmB[s4] = cmB2[d][s4]; }
#pragma unroll
            for (int mbi = 0; mbi < 2; ++mbi) { const int mb = d ? 1 - mbi : mbi;
                f32x16 X0, X1, X2, X3;
#pragma unroll
                for (int i = 0; i < 16; ++i) { X0[i] = 0.f; X1[i] = 0.f; X2[i] = 0.f; X3[i] = 0.f; }
                { int zo = 0; asm volatile("" : "+v"(zo));
                  const bf16x8 afm = *(const bf16x8*)(z + (size_t)(ch * 64 + mb * 32 + r) * NZ + ZC_SSM + g * 16 + 8 * hh + zo); bf16x8 bfr[4];
#pragma unroll
                  for (int nb = 0; nb < 4; ++nb) { const float* pb = c.W<float>(WS_S5BB) + (size_t)(sib + (nb & 1) * 32 + r) * 32 + (nb >> 1) * 16 + 8 * hh + zo; const f32x4 b0 = *(const f32x4*)pb, b1 = *(const f32x4*)(pb + 4);
                      bfr[nb] = __builtin_bit_cast(bf16x8, __builtin_convertvector((f32x8){b0.x, b0.y, b0.z, b0.w, b1.x, b1.y, b1.z, b1.w}, bf16v8)); }
                  X0 = MFMA32(afm, bfr[0], X0); X1 = MFMA32(afm, bfr[1], X1); X2 = MFMA32(afm, bfr[2], X2); X3 = MFMA32(afm, bfr[3], X3); }
#define S5_SEG(XR, XI, J, G, FIRST_HH, K0, K1, K2, K3) do { \
                    const float ar = lbr[J], ai = lbi[J]; \
                    const float tr0 = ar * hr[J] - ai * hi[J] + XR[4 * (G) + K0], ti0 = ar * hi[J] + ai * hr[J] + XI[4 * (G) + K0]; \
                    const float tr1 = ar * tr0 - ai * ti0 + XR[4 * (G) + K1], ti1 = ar * ti0 + ai * tr0 + XI[4 * (G) + K1]; \
                    const float tr2 = ar * tr1 - ai * ti1 + XR[4 * (G) + K2], ti2 = ar * ti1 + ai * tr1 + XI[4 * (G) + K2]; \
                    const float tr3 = ar * tr2 - ai * ti2 + XR[4 * (G) + K3], ti3 = ar * ti2 + ai * tr2 + XI[4 * (G) + K3]; \
                    const float pr_ = __shfl_xor(tr3, 32), pi_ = __shfl_xor(ti3, 32); \
                    const float ur0 = ar * pr_ - ai * pi_ + XR[4 * (G) + K0], ui0 = ar * pi_ + ai * pr_ + XI[4 * (G) + K0]; \
                    const float ur1 = ar * ur0 - ai * ui0 + XR[4 * (G) + K1], ui1 = ar * ui0 + ai * ur0 + XI[4 * (G) + K1]; \
                    const float ur2 = ar * ur1 - ai * ui1 + XR[4 * (G) + K2], ui2 = ar * ui1 + ai * ur1 + XI[4 * (G) + K2]; \
                    const float ur3 = ar * ur2 - ai * ui2 + XR[4 * (G) + K3], ui3 = ar * ui2 + ai * ur2 + XI[4 * (G) + K3]; \
                    const bool fst = (hh == (FIRST_HH)); \
                    XR[4 * (G) + K0] = fst ? tr0 : ur0; XI[4 * (G) + K0] = fst ? ti0 : ui0; XR[4 * (G) + K1] = fst ? tr1 : ur1; XI[4 * (G) + K1] = fst ? ti1 : ui1; \
                    XR[4 * (G) + K2] = fst ? tr2 : ur2; XI[4 * (G) + K2] = fst ? ti2 : ui2; XR[4 * (G) + K3] = fst ? tr3 : ur3; XI[4 * (G) + K3] = fst ? ti3 : ui3; \
                    const float qr_ = __shfl_xor(ur3, 32), qi_ = __shfl_xor(ui3, 32); hr[J] = fst ? qr_ : ur3; hi[J] = fst ? qi_ : ui3; } while (0)
                if (d == 0) { S5_SEG(X0, X2, 0, 0, 0, 0, 1, 2, 3); S5_SEG(X1, X3, 1, 0, 0, 0, 1, 2, 3); S5_SEG(X0, X2, 0, 1, 0, 0, 1, 2, 3); S5_SEG(X1, X3, 1, 1, 0, 0, 1, 2, 3);
                              S5_SEG(X0, X2, 0, 2, 0, 0, 1, 2, 3); S5_SEG(X1, X3, 1, 2, 0, 0, 1, 2, 3); S5_SEG(X0, X2, 0, 3, 0, 0, 1, 2, 3); S5_SEG(X1, X3, 1, 3, 0, 0, 1, 2, 3); }
                else        { S5_SEG(X0, X2, 0, 3, 1, 3, 2, 1, 0); S5_SEG(X1, X3, 1, 3, 1, 3, 2, 1, 0); S5_SEG(X0, X2, 0, 2, 1, 3, 2, 1, 0); S5_SEG(X1, X3, 1, 2, 1, 3, 2, 1, 0);
                              S5_SEG(X0, X2, 0, 1, 1, 3, 2, 1, 0); S5_SEG(X1, X3, 1, 1, 1, 3, 2, 1, 0); S5_SEG(X0, X2, 0, 0, 1, 3, 2, 1, 0); S5_SEG(X1, X3, 1, 0, 1, 3, 2, 1, 0); }
#undef S5_SEG
                if (final_pass) {
#pragma unroll
                    for (int i = 0; i < 16; ++i) { const int tl = (i & 3) + 8 * (i >> 2) + 4 * hh;
                        *(unsigned*)(hb + tl * 272 + r * 4) = pack2(X0[i], X2[i]); *(unsigned*)(hb + tl * 272 + (32 + r) * 4) = pack2(X1[i], X3[i]); }
#pragma unroll
                    for (int tb2 = 0; tb2 < 2; ++tb2)
#pragma unroll
                        for (int s4 = 0; s4 < 4; ++s4) { const bf16x8 a16 = *(const bf16x8*)(hb + (tb2 * 16 + cq) * 272 + (32 * s4 + 8 * q4) * 2);
                            if (mb == 0) yacc[tb2] = __builtin_amdgcn_mfma_f32_16x16x32_bf16(a16, cmB[s4], yacc[tb2], 0, 0, 0);
                            else yacc[2 + tb2] = __builtin_amdgcn_mfma_f32_16x16x32_bf16(a16, cmB[s4], yacc[2 + tb2], 0, 0, 0); } } }
            if (!final_pass) {
#pragma unroll
                for (int j = 0; j < 2; ++j) if (hh == 0) { float* e = c.W<float>(WS_S5END) + ((size_t)(ch * 2 + d) * 16 + g) * 128 + (j * 32 + r) * 2; e[0] = hr[j]; e[1] = hi[j]; } }
        }
        if (final_pass) { int q4o = q4; asm volatile("" : "+v"(q4o));
#pragma unroll
            for (int tb = 0; tb < 4; ++tb)
#pragma unroll
                for (int rg = 0; rg < 4; ++rg) c.W<bf16>(WS_YS5)[(size_t)(ch * 64 + tb * 16 + 4 * q4o + rg) * 256 + g * 16 + cq] = f2bf(gelu_tanh(yacc[tb][rg])); }
    }
}

__device__ __forceinline__ void lru_mfma(const Ctx& c, const bool final_pass) {
    const int tid = tidx(), wave = tid >> 6, lane = tid & 63, r = lane & 31, hh = lane >> 5, chn = wave * 32 + r;
    unsigned char* L = (unsigned char*)c.lds;
    bf16* xt = (bf16*)L;
    unsigned char* xcb = L + 34816;
    float* xcf = (float*)(L + 68608);
    const bf16* z = c.W<bf16>(WS_Z);
    const int sg = tid & 31;
    const int c0 = (final_pass && c.l == DEPTH - 1) ? 4 : 0;
    for (int ch = c0 + rot_bid(8); ch < NCHUNK; ch += gridDim.x) {
        const int segb = ch < 4 ? 0 : CTX, sege = ch < 4 ? CTX : ROWS;
        __syncthreads();
        { u32x4 v[5];
#pragma unroll
          for (int q = 0; q < 5; ++q) { const int pc = tid + q * NT, rr = pc >> 5, row = ch * 64 - 2 + rr;
              v[q] = (pc < 67 * 32 && row >= segb && row < sege) ? *(const u32x4*)(z + (size_t)row * NZ + ZC_LRUX + (pc & 31) * 8) : (u32x4){0u, 0u, 0u, 0u}; }
#pragma unroll
          for (int q = 0; q < 5; ++q) { const int pc = tid + q * NT; if (pc < 67 * 32) *(u32x4*)(xt + (size_t)pc * 8) = v[q]; } }
        __syncthreads();
        { int zo = 0; asm volatile("" : "+v"(zo));
          float cwv[4][8], cbv8[8];
#pragma unroll
          for (int e = 0; e < 8; ++e) { cbv8[e] = c.in(I_LCB)[(size_t)c.l * 256 + sg * 8 + e + zo];
#pragma unroll
              for (int k = 0; k < 4; ++k) cwv[k][e] = c.in(I_LCW)[(size_t)c.l * 1024 + k * 256 + sg * 8 + e + zo]; }
#pragma unroll
        for (int q = 0; q < 4; ++q) { const int i = (tid >> 5) + q * 16; float o[8];
#pragma unroll
            for (int e = 0; e < 8; ++e) o[e] = cbv8[e];
#pragma unroll
            for (int k = 0; k < 4; ++k) { const u32x4 xv = *(const u32x4*)(xt + (size_t)(i + k) * 256 + sg * 8);
                o[0] += cwv[k][0] * lo2f(xv.x); o[1] += cwv[k][1] * hi2f(xv.x); o[2] += cwv[k][2] * lo2f(xv.y); o[3] += cwv[k][3] * hi2f(xv.y);
                o[4] += cwv[k][4] * lo2f(xv.z); o[5] += cwv[k][5] * hi2f(xv.z); o[6] += cwv[k][6] * lo2f(xv.w); o[7] += cwv[k][7] * hi2f(xv.w); }
            *(f32x4*)(xcf + i * 256 + sg * 8) = (f32x4){o[0], o[1], o[2], o[3]}; *(f32x4*)(xcf + i * 256 + sg * 8 + 4) = (f32x4){o[4], o[5], o[6], o[7]};
            u32x4 w; w.x = pack2(o[0], o[1]); w.y = pack2(o[2], o[3]); w.z = pack2(o[4], o[5]); w.w = pack2(o[6], o[7]); *(u32x4*)(xcb + i * 528 + sg * 16) = w; } }
        __syncthreads();
        bf16x8 af[2][2]; float xv[2][16], hs[2][16];
#pragma unroll
        for (int mb = 0; mb < 2; ++mb) {
#pragma unroll
            for (int s2 = 0; s2 < 2; ++s2) af[mb][s2] = *(const bf16x8*)(xcb + (mb * 32 + r) * 528 + (wave * 32 + 16 * s2 + 8 * hh) * 2);
#pragma unroll
            for (int i = 0; i < 16; ++i) xv[mb][i] = xcf[(mb * 32 + (i & 3) + 8 * (i >> 2) + 4 * hh) * 256 + chn]; }
#pragma unroll
        for (int d = 0; d < 2; ++d) {
            int zo = 0; asm volatile("" : "+v"(zo));
            bf16x8 wrf[2], wif[2]; const size_t base = ((size_t)(c.l * 2 + d) * 8 + wave) * 1024 + r + zo;
            const float brv = c.in(I_LBR)[(size_t)(c.l * 2 + d) * 256 + chn + zo], biv = c.in(I_LBI)[(size_t)(c.l * 2 + d) * 256 + chn + zo], lsv = 8.0f * logsigmoidf_(c.in(I_LLAM)[(size_t)(c.l * 2 + d) * 256 + chn + zo]);
#pragma unroll
            for (int s2 = 0; s2 < 2; ++s2) { const float* pr_ = c.in(I_LWR) + base + (size_t)(16 * s2 + 8 * hh) * 32; const float* pi_ = c.in(I_LWI) + base + (size_t)(16 * s2 + 8 * hh) * 32;
                wrf[s2] = __builtin_bit_cast(bf16x8, __builtin_convertvector((f32x8){pr_[0], pr_[32], pr_[64], pr_[96], pr_[128], pr_[160], pr_[192], pr_[224]}, bf16v8));
                wif[s2] = __builtin_bit_cast(bf16x8, __builtin_convertvector((f32x8){pi_[0], pi_[32], pi_[64], pi_[96], pi_[128], pi_[160], pi_[192], pi_[224]}, bf16v8)); }
            float av[2][16], bv[2][16];
#pragma unroll
            for (int mb = 0; mb < 2; ++mb) { f32x16 ra, ia;
#pragma unroll
                for (int i = 0; i < 16; ++i) { ra[i] = brv; ia[i] = biv; }
#pragma unroll
                for (int s2 = 0; s2 < 2; ++s2) { ra = MFMA32(af[mb][s2], wrf[s2], ra); ia = MFMA32(af[mb][s2], wif[s2], ia); }
#pragma unroll
                for (int i = 0; i < 16; ++i) { const float rg = sigmoidf_(ra[i]), ig = sigmoidf_(ia[i]), a = __expf(rg * lsv);
                    av[mb][i] = a; bv[mb][i] = sqrtf(fmaxf(1.0f - a * a, 0.f)) * (ig * xv[mb][i]); } }
            float h = final_pass ? c.W<float>(WS_LRUSTART)[(size_t)(ch * 2 + d) * 256 + chn] : 0.f;
#define LRU_SEG(MB, G, FIRST_HH, K0, K1, K2, K3) do { \
                float t0 = av[MB][4 * (G) + K0] * h + bv[MB][4 * (G) + K0], t1 = av[MB][4 * (G) + K1] * t0 + bv[MB][4 * (G) + K1], t2 = av[MB][4 * (G) + K2] * t1 + bv[MB][4 * (G) + K2], t3 = av[MB][4 * (G) + K3] * t2 + bv[MB][4 * (G) + K3]; \
                const float hin = __shfl_xor(t3, 32); \
                const float u0 = av[MB][4 * (G) + K0] * hin + bv[MB][4 * (G) + K0], u1 = av[MB][4 * (G) + K1] * u0 + bv[MB][4 * (G) + K1], u2 = av[MB][4 * (G) + K2] * u1 + bv[MB][4 * (G) + K2], u3 = av[MB][4 * (G) + K3] * u2 + bv[MB][4 * (G) + K3]; \
                const bool fst = (hh == (FIRST_HH)); \
                bv[MB][4 * (G) + K0] = fst ? t0 : u0; bv[MB][4 * (G) + K1] = fst ? t1 : u1; bv[MB][4 * (G) + K2] = fst ? t2 : u2; bv[MB][4 * (G) + K3] = fst ? t3 : u3; \
                const float ho = __shfl_xor(u3, 32); h = fst ? ho : u3; } while (0)
            if (d == 0) { LRU_SEG(0, 0, 0, 0, 1, 2, 3); LRU_SEG(0, 1, 0, 0, 1, 2, 3); LRU_SEG(0, 2, 0, 0, 1, 2, 3); LRU_SEG(0, 3, 0, 0, 1, 2, 3);
                          LRU_SEG(1, 0, 0, 0, 1, 2, 3); LRU_SEG(1, 1, 0, 0, 1, 2, 3); LRU_SEG(1, 2, 0, 0, 1, 2, 3); LRU_SEG(1, 3, 0, 0, 1, 2, 3); }
            else        { LRU_SEG(1, 3, 1, 3, 2, 1, 0); LRU_SEG(1, 2, 1, 3, 2, 1, 0); LRU_SEG(1, 1, 1, 3, 2, 1, 0); LRU_SEG(1, 0, 1, 3, 2, 1, 0);
                          LRU_SEG(0, 3, 1, 3, 2, 1, 0); LRU_SEG(0, 2, 1, 3, 2, 1, 0); LRU_SEG(0, 1, 1, 3, 2, 1, 0); LRU_SEG(0, 0, 1, 3, 2, 1, 0); }
#undef LRU_SEG
            if (!final_pass) { float A = 1.f;
#pragma unroll
                for (int mb = 0; mb < 2; ++mb)
#pragma unroll
                    for (int i = 0; i < 16; ++i) A *= av[mb][i];
                A *= __shfl_xor(A, 32);
                if (hh == 0) { float* e = c.W<float>(WS_LRUEND) + ((size_t)(ch * 2 + d) * 256 + chn) * 2; e[0] = A; e[1] = h; } }
            else {
#pragma unroll
                for (int mb = 0; mb < 2; ++mb)
#pragma unroll
                    for (int i = 0; i < 16; ++i) hs[mb][i] = d == 0 ? bv[mb][i] : hs[mb][i] + bv[mb][i]; }
        }
        if (final_pass) {
#pragma unroll
            for (int mb = 0; mb < 2; ++mb)
#pragma unroll
                for (int i = 0; i < 16; ++i) xcf[(mb * 32 + (i & 3) + 8 * (i >> 2) + 4 * hh) * 256 + chn] = hs[mb][i];
            __syncthreads();
            u32x4 yv[4];
#pragma unroll
            for (int q = 0; q < 4; ++q) { const int pc = tid + q * NT; yv[q] = *(const u32x4*)(z + (size_t)(ch * 64 + (pc >> 5)) * NZ + ZC_LRUY + (pc & 31) * 8); }
#pragma unroll
            for (int q = 0; q < 4; ++q) { const int pc = tid + q * NT, rr = pc >> 5; const float* hp = xcf + rr * 256 + (pc & 31) * 8; u32x4 w;
                w.x = pack2(hp[0] * gelu_tanh(lo2f(yv[q].x)), hp[1] * gelu_tanh(hi2f(yv[q].x))); w.y = pack2(hp[2] * gelu_tanh(lo2f(yv[q].y)), hp[3] * gelu_tanh(hi2f(yv[q].y)));
                w.z = pack2(hp[4] * gelu_tanh(lo2f(yv[q].z)), hp[5] * gelu_tanh(hi2f(yv[q].z))); w.w = pack2(hp[6] * gelu_tanh(lo2f(yv[q].w)), hp[7] * gelu_tanh(hi2f(yv[q].w)));
                *(u32x4*)(c.W<bf16>(WS_Y) + (size_t)(ch * 64 + rr) * D + 256 + (pc & 31) * 8) = w; } }
    }
}

__device__ __forceinline__ float logsig_fast(float x) { return fminf(x, 0.f) - __logf(1.0f + __expf(-fabsf(x))); }
__device__ __forceinline__ void gla_mfma(const Ctx& c, const bool final_pass) {
    const int tid = tidx(), wave = tid >> 6, lane = tid & 63, r = lane & 31, hh = lane >> 5, hd = wave >> 1, d = wave & 1;
    unsigned char* L = (unsigned char*)c.lds;
    unsigned char* QE = L + wave * 10240; unsigned char* KE = QE + 5120;
    unsigned char* VT = L + 81920 + hd * 9216;
    float* zt = (float*)(L + 118784);
    float* ex = (float*)(L + (wave & ~1) * 10240);
    const bf16* z = c.W<bf16>(WS_Z); const float* za = c.W<float>(WS_ZA);
    const int pr = (r & 19) | ((r & 4) << 1) | ((r & 8) >> 1);
    const int c0 = (final_pass && c.l == DEPTH - 1) ? 4 : 0;
    for (int ch = c0 + rot_bid(12); ch < NCHUNK; ch += gridDim.x) {
        __syncthreads();
        { const f32x4 zv = *(const f32x4*)(za + (size_t)(ch * 64 + (tid >> 3)) * 32 + (tid & 7) * 4); u32x4 vv[4];
#pragma unroll
          for (int q = 0; q < 4; ++q) { const int pc = tid + q * NT; vv[q] = *(const u32x4*)(z + (size_t)(ch * 64 + (pc >> 5)) * NZ + ZC_GV + (pc & 31) * 8); }
          *(f32x4*)(zt + (tid >> 3) * 32 + (tid & 7) * 4) = zv;
#pragma unroll
          for (int q = 0; q < 4; ++q) { const int pc = tid + q * NT, j = pc >> 5, sg = pc & 31; bf16* dst = (bf16*)(L + 81920 + (sg >> 3) * 9216 + ((sg & 7) * 8) * 144 + j * 2);
              dst[0] = (bf16)(vv[q].x & 0xffff); dst[72] = (bf16)(vv[q].x >> 16); dst[144] = (bf16)(vv[q].y & 0xffff); dst[216] = (bf16)(vv[q].y >> 16);
              dst[288] = (bf16)(vv[q].z & 0xffff); dst[360] = (bf16)(vv[q].z >> 16); dst[432] = (bf16)(vv[q].w & 0xffff); dst[504] = (bf16)(vv[q].w >> 16); } }
        __syncthreads();
        int zo = 0; asm volatile("" : "+v"(zo));
        float w2[16];
#pragma unroll
        for (int k = 0; k < 16; ++k) w2[k] = c.in(I_GWA2)[(size_t)(c.l * 2 + d) * 16 * 128 + k * 128 + hd * 32 + r + zo];
        const float bav = c.in(I_GBA)[(size_t)(c.l * 2 + d) * 128 + hd * 32 + r + zo];
        float lav[32]; float run = 0.f;
#pragma unroll
        for (int i = 0; i < 32; ++i) { const int tok = hh * 32 + (d ? 31 - i : i); const float* a = zt + tok * 32 + d * 16; float zz = bav;
            const f32x4 a0 = *(const f32x4*)a, a1 = *(const f32x4*)(a + 4), a2 = *(const f32x4*)(a + 8), a3 = *(const f32x4*)(a + 12);
            zz += (a0.x * w2[0] + a0.y * w2[1]) + (a0.z * w2[2] + a0.w * w2[3]) + (a1.x * w2[4] + a1.y * w2[5]) + (a1.z * w2[6] + a1.w * w2[7])
                + (a2.x * w2[8] + a2.y * w2[9]) + (a2.z * w2[10] + a2.w * w2[11]) + (a3.x * w2[12] + a3.y * w2[13]) + (a3.z * w2[14] + a3.w * w2[15]);
            run += logsig_fast(zz) * (1.0f / 16.0f); lav[i] = run; }
        const float other = __shfl_xor(run, 32), tot = run + other, add = ((d == 0) == (hh == 1)) ? other : 0.f;
        int koff = 0, hq = hh; asm volatile("" : "+v"(hq));
        const bf16* pq = z + (size_t)(ch * 64) * NZ + ZC_GQ + hd * 32 + r; const bf16* pk = z + (size_t)(ch * 64) * NZ + ZC_GK + hd * 32 + r;
        if (final_pass) {
#pragma unroll
            for (int i = 0; i < 32; ++i) { if ((i & 7) == 0) asm volatile("" : "+v"(koff) :: "memory");
                const int tok = hq * 32 + (d ? 31 - i : i); const float b = lav[i] + add;
                const float qv = bf2f(pq[(size_t)tok * NZ + koff]) * 0.17677669529663687f, kv = bf2f(pk[(size_t)tok * NZ + koff]);
                *(bf16*)(QE + tok * 80 + r * 2) = f2bf(qv * __expf(b)); *(bf16*)(KE + tok * 80 + r * 2) = f2bf(kv * __expf(-b));
                }
        } else {
#pragma unroll
            for (int i = 0; i < 32; ++i) { if ((i & 7) == 0) asm volatile("" : "+v"(koff) :: "memory");
                const int tok = hq * 32 + (d ? 31 - i : i); const float b = lav[i] + add; const float kv = bf2f(pk[(size_t)tok * NZ + koff]);
                *(bf16*)(QE + r * 144 + tok * 2) = f2bf(kv * __expf(tot - b));
                }
            if (hh == 0) c.W<float>(WS_GLADEC)[((size_t)(ch * 2 + d) * 4 + hd) * 32 + r] = __expf(tot);
        }
        if (!final_pass) {
            f32x16 kvt[2];
#pragma unroll
            for (int db = 0; db < 2; ++db)
#pragma unroll
                for (int i = 0; i < 16; ++i) kvt[db][i] = 0.f;
#pragma unroll
            for (int s4 = 0; s4 < 4; ++s4) { const bf16x8 bf = *(const bf16x8*)(QE + r * 144 + (16 * s4 + 8 * hh) * 2);
#pragma unroll
                for (int db = 0; db < 2; ++db) { const bf16x8 af = *(const bf16x8*)(VT + (db * 32 + r) * 144 + (16 * s4 + 8 * hh) * 2); kvt[db] = MFMA32(af, bf, kvt[db]); } }
            float* kvp = c.W<float>(WS_GLAKV) + ((size_t)(ch * 2 + d) * 4 + hd) * 2048 + r;
#pragma unroll
            for (int db = 0; db < 2; ++db)
#pragma unroll
                for (int i = 0; i < 16; ++i) kvp[(db * 32 + (i & 3) + 8 * (i >> 2) + 4 * hh) * 32] = kvt[db][i];
            continue;
        }
        f32x16 o[2][2];
#pragma unroll
        for (int db = 0; db < 2; ++db)
#pragma unroll
            for (int ib = 0; ib < 2; ++ib)
#pragma unroll
                for (int i = 0; i < 16; ++i) o[db][ib][i] = 0.f;
        bf16x8 qb[2][2];
#pragma unroll
        for (int ib = 0; ib < 2; ++ib)
#pragma unroll
            for (int s2 = 0; s2 < 2; ++s2) qb[ib][s2] = *(const bf16x8*)(QE + (ib * 32 + r) * 80 + s2 * 32 + hh * 16);
        { const bf16* s0t = c.W<bf16>(WS_GLAS0) + ((size_t)(ch * 2 + d) * 4 + hd) * 2048;
#pragma unroll
          for (int db = 0; db < 2; ++db)
#pragma unroll
              for (int s2 = 0; s2 < 2; ++s2) { const bf16x8 sf = *(const bf16x8*)(s0t + (db * 32 + r) * 32 + 16 * s2 + 8 * hh);
#pragma unroll
                  for (int ib = 0; ib < 2; ++ib) o[db][ib] = MFMA32(sf, qb[ib][s2], o[db][ib]); } }
#define GLA_BLOCK(JB, IB, MASKED) do { f32x16 x; _Pragma("unroll") for (int i = 0; i < 16; ++i) x[i] = 0.f; \
        _Pragma("unroll") for (int s2 = 0; s2 < 2; ++s2) { const bf16x8 kf = *(const bf16x8*)(KE + ((JB) * 32 + pr) * 80 + s2 * 32 + hh * 16); x = MFMA32(kf, qb[IB][s2], x); } \
        if (MASKED) { _Pragma("unroll") for (int i = 0; i < 16; ++i) { const int jl = (i & 3) + 4 * ((i >> 2) & 1) + 8 * hh + 16 * (i >> 3); const bool keep = d ? (jl >= r) : (jl <= r); x[i] = keep ? x[i] : 0.f; } } \
        _Pragma("unroll") for (int s2 = 0; s2 < 2; ++s2) { \
            const bf16x8 pb = __builtin_bit_cast(bf16x8, __builtin_convertvector((f32x8){x[8 * s2], x[8 * s2 + 1], x[8 * s2 + 2], x[8 * s2 + 3], x[8 * s2 + 4], x[8 * s2 + 5], x[8 * s2 + 6], x[8 * s2 + 7]}, bf16v8)); \
            _Pragma("unroll") for (int db = 0; db < 2; ++db) { const bf16x8 vf = *(const bf16x8*)(VT + (db * 32 + r) * 144 + ((JB) * 32 + s2 * 16 + hh * 8) * 2); o[db][IB] = MFMA32(vf, pb, o[db][IB]); } } } while (0)
        GLA_BLOCK(0, 0, true); GLA_BLOCK(1, 1, true);
        if (d == 0) GLA_BLOCK(0, 1, false); else GLA_BLOCK(1, 0, false);
#undef GLA_BLOCK
        __syncthreads();
        if (d == 1) {
#pragma unroll
            for (int db = 0; db < 2; ++db)
#pragma unroll
                for (int ib = 0; ib < 2; ++ib)
#pragma unroll
                    for (int i = 0; i < 16; ++i) ex[((db * 2 + ib) * 16 + i) * 64 + lane] = o[db][ib][i]; }
        __syncthreads();
        if (d == 0) {
            const float* gon = c.in(I_GON) + (size_t)c.l * 64;
#pragma unroll
            for (int ib = 0; ib < 2; ++ib) { float ss = 0.f;
#pragma unroll
                for (int db = 0; db < 2; ++db)
#pragma unroll
                    for (int i = 0; i < 16; ++i) { const float v = o[db][ib][i] + ex[((db * 2 + ib) * 16 + i) * 64 + lane]; o[db][ib][i] = v; ss += v * v; }
                ss += __shfl_xor(ss, 32);
                const float rstd = rsqrtf(ss * (1.0f / 64.0f) + 1e-6f); const int row = ch * 64 + ib * 32 + r;
#pragma unroll
                for (int db = 0; db < 2; ++db)
#pragma unroll
                    for (int g4 = 0; g4 < 4; ++g4) { const int dv0 = db * 32 + 8 * g4 + 4 * hh; const u32x2 gw = *(const u32x2*)(z + (size_t)row * NZ + ZC_GG + hd * 64 + dv0); const f32x4 gn = *(const f32x4*)(gon + dv0);
                        u32x2 w; w.x = pack2(o[db][ib][4 * g4] * rstd * gn.x * siluf_(lo2f(gw.x)), o[db][ib][4 * g4 + 1] * rstd * gn.y * siluf_(hi2f(gw.x)));
                        w.y = pack2(o[db][ib][4 * g4 + 2] * rstd * gn.z * siluf_(lo2f(gw.y)), o[db][ib][4 * g4 + 3] * rstd * gn.w * siluf_(hi2f(gw.y)));
                        *(u32x2*)(c.W<bf16>(WS_Y) + (size_t)row * D + 768 + hd * 64 + dv0) = w; } } }
    }
}

__device__ __forceinline__ void phase_carry(const Ctx& c) {
    const int b = blockIdx.x, t = tidx();
    constexpr int NB = 13, NBATCH = NCHUNK / NB;
    if (b < 4) {
        const int i = b * NT + t, d = i >> 10, gp = i & 1023; const int si = (c.l * 2 + d) * 1024 + gp;
        float ar = c.W<float>(WS_S5LB)[si * 2], ai = c.W<float>(WS_S5LB)[si * 2 + 1];
        for (int q = 0; q < 6; ++q) { const float nr = ar * ar - ai * ai, ni = 2.f * ar * ai; ar = nr; ai = ni; }
        float hr = 0.f, hi = 0.f;
        const f32x2* E = c.W<f32x2>(WS_S5END); f32x2* S = c.W<f32x2>(WS_S5START);
        f32x2 ea[NB], eb[NB];
#define S5C_LOAD(dst, s0) _Pragma("unroll") for (int j = 0; j < NB; ++j) dst[j] = E[(size_t)(chunk_of((s0) + j, d) * 2 + d) * 1024 + gp]
#define S5C_USE(src, s0) _Pragma("unroll") for (int j = 0; j < NB; ++j) { S[(size_t)(chunk_of((s0) + j, d) * 2 + d) * 1024 + gp] = (f32x2){hr, hi}; \
            const float nr = ar * hr - ai * hi + src[j].x, ni = ar * hi + ai * hr + src[j].y; hr = nr; hi = ni; }
        S5C_LOAD(ea, 0);
        for (int bt = 0; bt < NBATCH; bt += 2) { S5C_LOAD(eb, (bt + 1) * NB); S5C_USE(ea, bt * NB); if (bt + 2 < NBATCH) S5C_LOAD(ea, (bt + 2) * NB); S5C_USE(eb, (bt + 1) * NB); }
#undef S5C_LOAD
#undef S5C_USE
    } else if (b == 4) {
        const int d = t >> 8, chn = t & 255; float h = 0.f;
        const f32x2* E = c.W<f32x2>(WS_LRUEND); float* S = c.W<float>(WS_LRUSTART);
        f32x2 ea[NB], eb[NB];
#define LRC_LOAD(dst, s0) _Pragma("unroll") for (int j = 0; j < NB; ++j) dst[j] = E[(size_t)(chunk_of((s0) + j, d) * 2 + d) * 256 + chn]
#define LRC_USE(src, s0) _Pragma("unroll") for (int j = 0; j < NB; ++j) { S[(size_t)(chunk_of((s0) + j, d) * 2 + d) * 256 + chn] = h; h = src[j].x * h + src[j].y; }
        LRC_LOAD(ea, 0);
        for (int bt = 0; bt < NBATCH; bt += 2) { LRC_LOAD(eb, (bt + 1) * NB); LRC_USE(ea, bt * NB); if (bt + 2 < NBATCH) LRC_LOAD(ea, (bt + 2) * NB); LRC_USE(eb, (bt + 1) * NB); }
#undef LRC_LOAD
#undef LRC_USE
    } else if (b >= 8 && b < 40) {
        const int i = (b - 8) * NT + t, d = i >> 13, hd = (i >> 11) & 3, e = i & 2047, dk = e & 31; float S = 0.f;
        const float* KV = c.W<float>(WS_GLAKV); const float* DC = c.W<float>(WS_GLADEC); bf16* S0 = c.W<bf16>(WS_GLAS0);
        float ka[NB], da[NB], kb[NB], db[NB];
#define GLC_LOAD(kd, dd, s0) _Pragma("unroll") for (int j = 0; j < NB; ++j) { const size_t cb = (size_t)(chunk_of((s0) + j, d) * 2 + d) * 4 + hd; kd[j] = KV[cb * 2048 + e]; dd[j] = DC[cb * 32 + dk]; }
#define GLC_USE(kd, dd, s0) _Pragma("unroll") for (int j = 0; j < NB; ++j) { const size_t cb = (size_t)(chunk_of((s0) + j, d) * 2 + d) * 4 + hd; S0[cb * 2048 + e] = f2bf(S); S = dd[j] * S + kd[j]; }
        GLC_LOAD(ka, da, 0);
        for (int bt = 0; bt < NBATCH; bt += 2) { GLC_LOAD(kb, db, (bt + 1) * NB); GLC_USE(ka, da, bt * NB); if (bt + 2 < NBATCH) GLC_LOAD(ka, da, (bt + 2) * NB); GLC_USE(kb, db, (bt + 1) * NB); }
#undef GLC_LOAD
#undef GLC_USE
    }
}

__device__ __forceinline__ void v_transpose(const Ctx& c, const int bid, const int nb) {
    const int t = tidx(); bf16* sm = (bf16*)c.lds;
    const bf16* z = c.W<bf16>(WS_Z); bf16* vT = c.W<bf16>(WS_VT);
    for (int task = bid; task < NCHUNK * 4; task += nb) {
        const int kt = task >> 2, hd = task & 3, key = t >> 3, seg = t & 7;
        const u32x4 v = *(const u32x4*)(z + (size_t)(kt * 64 + key) * NZ + ZC_DAV + hd * 64 + seg * 8);
        __syncthreads();
        bf16* d = sm + (seg * 8) * 72 + key;
        d[0] = (bf16)(v.x & 0xffff); d[72] = (bf16)(v.x >> 16); d[144] = (bf16)(v.y & 0xffff); d[216] = (bf16)(v.y >> 16);
        d[288] = (bf16)(v.z & 0xffff); d[360] = (bf16)(v.z >> 16); d[432] = (bf16)(v.w & 0xffff); d[504] = (bf16)(v.w >> 16);
        __syncthreads();
        *(u32x4*)(vT + (size_t)(hd * 64 + key) * ROWS + kt * 64 + seg * 8) = *(const u32x4*)(sm + key * 72 + seg * 8);
    }
}
template <bool SHIFT>
__device__ __forceinline__ void attn_mfma_body(const Ctx& c) {
    const int tid = tidx(), wave = tid >> 6, lane = tid & 63, r = lane & 31, hh = lane >> 5;
    constexpr int KS = 144, VOFF = 64 * KS, BUF = 2 * 64 * KS;
    unsigned char* L = (unsigned char*)c.lds;
    const bf16* z = c.W<bf16>(WS_Z); const bf16* vT = c.W<bf16>(WS_VT);
    const float li = lam_init_of(c.l);
    float lam; { const float* lp = c.in(I_DLAM) + (size_t)c.l * 128; float s0 = 0.f, s1 = 0.f; for (int k = 0; k < 32; ++k) { s0 += lp[k] * lp[32 + k]; s1 += lp[64 + k] * lp[96 + k]; } lam = expf(s0) - expf(s1) + li; }
    float gq = 0.f, gk = 0.f; for (int k = 0; k < 32; ++k) { gq = fmaxf(gq, fabsf(c.in(I_DQN)[(size_t)c.l * 32 + k])); gk = fmaxf(gk, fabsf(c.in(I_DKN)[(size_t)c.l * 32 + k])); }
    const float mb = 32.0f * gq * gk * (0.17677669529663687f * 1.4426950408889634f) * 1.02f;
    const int pr = (r & 19) | ((r & 4) << 1) | ((r & 8) >> 1);
    const int skey = tid >> 3, sseg = tid & 7, lw = skey * KS + sseg * 16;
    const int qb0 = (c.l == DEPTH - 1) ? 1 : 0;
    for (int task = qb0 * 4 + blockIdx.x; task < 65 * 4; task += gridDim.x) {
        const int qb = task >> 2, hd = task & 3, nt = (qb == 0 ? CTX : ROWS) / 64; const int row = qb * 256 + wave * 32 + r;
        bf16x8 qf[2][2];
        { const bf16* pq = z + (size_t)row * NZ + ZC_DAQ + hd * 64 + hh * 8;
#pragma unroll
          for (int cc = 0; cc < 2; ++cc)
#pragma unroll
              for (int s2 = 0; s2 < 2; ++s2) qf[cc][s2] = *(const bf16x8*)(pq + cc * 32 + s2 * 16); }
        f32x16 o[2][2];
#pragma unroll
        for (int cc = 0; cc < 2; ++cc)
#pragma unroll
            for (int db = 0; db < 2; ++db)
#pragma unroll
                for (int i = 0; i < 16; ++i) o[cc][db][i] = 0.f;
        float ls0 = 0.f, ls1 = 0.f;
        const bf16* gk_ = z + (size_t)skey * NZ + ZC_DAK + hd * 64 + sseg * 8;
        const bf16* gv_ = vT + (size_t)(hd * 64 + skey) * ROWS + sseg * 8;
        u32x4 kr = *(const u32x4*)gk_, vr = *(const u32x4*)gv_;
        __syncthreads();
        *(u32x4*)(L + lw) = kr; *(u32x4*)(L + VOFF + lw) = vr;
        __syncthreads();
        for (int t = 0; t < nt; ++t) {
            const unsigned char* cur = L + (t & 1) * BUF;
            if (t + 1 < nt) { kr = *(const u32x4*)(gk_ + (size_t)(t + 1) * 64 * NZ); vr = *(const u32x4*)(gv_ + (t + 1) * 64); }
#pragma unroll
            for (int kb = 0; kb < 2; ++kb) {
                bf16x8 vf[2][2];
#pragma unroll
                for (int db = 0; db < 2; ++db)
#pragma unroll
                    for (int s2 = 0; s2 < 2; ++s2) vf[db][s2] = *(const bf16x8*)(cur + VOFF + (db * 32 + r) * KS + (kb * 32 + s2 * 16 + hh * 8) * 2);
#pragma unroll
                for (int cc = 0; cc < 2; ++cc) {
                    f32x16 sa;
#pragma unroll
                    for (int i = 0; i < 16; ++i) sa[i] = SHIFT ? -mb : 0.f;
#pragma unroll
                    for (int s2 = 0; s2 < 2; ++s2) { const bf16x8 kf = *(const bf16x8*)(cur + (kb * 32 + pr) * KS + cc * 64 + s2 * 32 + hh * 16); sa = MFMA32(kf, qf[cc][s2], sa); }
                    float p[16];
#pragma unroll
                    for (int i = 0; i < 16; ++i) p[i] = __builtin_amdgcn_exp2f(sa[i]);
                    const float ps = ((p[0] + p[1]) + (p[2] + p[3])) + ((p[4] + p[5]) + (p[6] + p[7])) + (((p[8] + p[9]) + (p[10] + p[11])) + ((p[12] + p[13]) + (p[14] + p[15])));
                    if (cc == 0) ls0 += ps; else ls1 += ps;
#pragma unroll
                    for (int s2 = 0; s2 < 2; ++s2) {
                        const bf16x8 pb = __builtin_bit_cast(bf16x8, __builtin_convertvector((f32x8){p[8 * s2], p[8 * s2 + 1], p[8 * s2 + 2], p[8 * s2 + 3], p[8 * s2 + 4], p[8 * s2 + 5], p[8 * s2 + 6], p[8 * s2 + 7]}, bf16v8));
#pragma unroll
                        for (int db = 0; db < 2; ++db) o[cc][db] = MFMA32(vf[db][s2], pb, o[cc][db]);
                    }
                }
            }
            if (t + 1 < nt) { unsigned char* nb = L + ((t + 1) & 1) * BUF; *(u32x4*)(nb + lw) = kr; *(u32x4*)(nb + VOFF + lw) = vr; }
            __syncthreads();
        }
        ls0 += __shfl_xor(ls0, 32); ls1 += __shfl_xor(ls1, 32);
        const float il0 = 1.0f / ls0, il1 = lam / ls1; float ss = 0.f;
#pragma unroll
        for (int db = 0; db < 2; ++db)
#pragma unroll
            for (int i = 0; i < 16; ++i) { const float v = o[0][db][i] * il0 - o[1][db][i] * il1; o[0][db][i] = v; ss += v * v; }
        ss += __shfl_xor(ss, 32);
        const float rstd = rsqrtf(ss * (1.0f / 64.0f) + 1e-6f) * (1.0f - li);
        bf16* po = c.W<bf16>(WS_Y) + (size_t)row * D + 512 + hd * 64 + 4 * hh; const float* gn = c.in(I_DON) + (size_t)c.l * 64 + 4 * hh;
#pragma unroll
        for (int db = 0; db < 2; ++db)
#pragma unroll
            for (int g = 0; g < 4; ++g) { const int dv0 = db * 32 + 8 * g; const f32x4 gg = *(const f32x4*)(gn + dv0);
                u32x2 w; w.x = pack2(o[0][db][4 * g] * rstd * gg.x, o[0][db][4 * g + 1] * rstd * gg.y); w.y = pack2(o[0][db][4 * g + 2] * rstd * gg.z, o[0][db][4 * g + 3] * rstd * gg.w);
                *(u32x2*)(po + dv0) = w; }
    }
}


__device__ __forceinline__ void attn_mfma(const Ctx& c) {
    float gq = 0.f, gk = 0.f; for (int k = 0; k < 32; ++k) { gq = fmaxf(gq, fabsf(c.in(I_DQN)[(size_t)c.l * 32 + k])); gk = fmaxf(gk, fabsf(c.in(I_DKN)[(size_t)c.l * 32 + k])); }
    const float mb = 32.0f * gq * gk * (0.17677669529663687f * 1.4426950408889634f) * 1.02f;
    if (mb > 64.0f) attn_mfma_body<true>(c); else attn_mfma_body<false>(c);
}

#define XB_TMO      128
#define XB_XCNT(j)  (256  + 64 * (j))
#define XB_XSUB(j)  (1280 + 64 * (j))
#define XB_XGEN(j)  (2304 + 64 * (j))
#define XB_TOP      3328
#define XB_TOPGEN   3392
#define XCD_BAR_WORDS 3456
#define XB_SPIN_CAP (1u << 18)
#define LAS __attribute__((address_space(3)))
__device__ __forceinline__ unsigned xb_ld(unsigned* p)              { return __hip_atomic_load(p, __ATOMIC_RELAXED, __HIP_MEMORY_SCOPE_AGENT); }
__device__ __forceinline__ unsigned xb_add(unsigned* p, unsigned v) { return __hip_atomic_fetch_add(p, v, __ATOMIC_RELAXED, __HIP_MEMORY_SCOPE_AGENT); }
__device__ __forceinline__ unsigned xb_xcc_id() { return (unsigned)__builtin_amdgcn_s_getreg((3 << 11) | 20) & 0xFu; }
#define XB_SPIN(cond, bar) do { unsigned _sp = 0; while (cond) { __builtin_amdgcn_s_sleep(1); \
    if ((++_sp & 255u) == 0u) { if (xb_ld(&(bar)[XB_TMO])) break; if (_sp > XB_SPIN_CAP) { atomicAdd(&(bar)[XB_TMO], 1u); break; } } } } while (0)
struct XcdBarrier { unsigned* bar; unsigned x; volatile LAS unsigned* st; };
__device__ __forceinline__ XcdBarrier xcd_barrier_post(unsigned* bar, volatile LAS unsigned* st) {
    XcdBarrier b; b.bar = bar; b.x = xb_xcc_id(); b.st = st;
    if (threadIdx.x == 0) (void)xb_add(&bar[XB_XCNT(b.x)], 1u);
    return b;
}
__device__ __forceinline__ void xcd_barrier_complete(unsigned* bar, unsigned x, unsigned& nloc, unsigned& nx) {
    const unsigned G = gridDim.x * gridDim.y * gridDim.z;
    unsigned sum, cnt, mine, sp = 0u;
    for (;;) {
        sum = 0u; cnt = 0u; mine = 0u;
#pragma unroll
        for (unsigned j = 0; j < 16; ++j) { const unsigned c = xb_ld(&bar[XB_XCNT(j)]); sum += c; cnt += (c > 0u) ? 1u : 0u; mine = (j == x) ? c : mine; }
        if (sum == G) break;
        __builtin_amdgcn_s_sleep(1);
        if ((++sp & 255u) == 0u) { if (xb_ld(&bar[XB_TMO])) break; if (sp > XB_SPIN_CAP) { atomicAdd(&bar[XB_TMO], 1u); break; } }
    }
    nloc = mine > 0u ? mine : 1u; nx = cnt > 0u ? cnt : 1u;
}
__device__ __forceinline__ void xcd_barrier(const XcdBarrier& b) {
    asm volatile("s_waitcnt vmcnt(0)" ::: "memory");
    __syncthreads();
    if (threadIdx.x == 0) {
        unsigned* bar = b.bar;
        __builtin_amdgcn_s_waitcnt(0);
        unsigned nloc = b.st[0], nx = b.st[1];
        if (nloc == 0u) { xcd_barrier_complete(bar, b.x, nloc, nx); b.st[0] = nloc; b.st[1] = nx; }
        const unsigned old = xb_add(&bar[XB_XSUB(b.x)], 1u);
        const unsigned gen = old / nloc;
        if (old + 1u == (gen + 1u) * nloc) {
            __builtin_amdgcn_fence(__ATOMIC_RELEASE, "agent");
            asm volatile("s_waitcnt vmcnt(0)" ::: "memory");
            const unsigned og = xb_add(&bar[XB_TOP], 1u);
            const unsigned tg = og / nx;
            if (og + 1u == (tg + 1u) * nx) xb_add(&bar[XB_TOPGEN], 1u);
            else XB_SPIN(xb_ld(&bar[XB_TOPGEN]) == tg, bar);
            __builtin_amdgcn_fence(__ATOMIC_ACQUIRE, "agent");
            xb_add(&bar[XB_XGEN(b.x)], 1u);
            asm volatile("s_waitcnt vmcnt(0)" ::: "memory");
        } else {
            XB_SPIN(xb_ld(&bar[XB_XGEN(b.x)]) == gen, bar);
            __builtin_amdgcn_fence(__ATOMIC_ACQUIRE, "agent");
            asm volatile("s_waitcnt vmcnt(0)" ::: "memory");
        }
    }
    __syncthreads();
}

enum { PH_PREP = 0, PH_NORM1, PH_INPROJ, PH_MIX1, PH_CARRY, PH_MIX3, PH_GLU, PH_MERGE, PH_WOUT, PH_NORM2, PH_FFNUP, PH_FFNDN, PH_COUNT };

__device__ __forceinline__ void run_phase(const int l, const int ph, float* lds, const bool rep = false) {
    KParams* pp = (KParams*)__builtin_amdgcn_kernarg_segment_ptr();
    asm volatile("" : "+s"(pp));
    Ctx c(pp, l, lds);
    switch (ph) {
    case PH_PREP: phase_prep(c); break;
    case PH_NORM1: phase_norm(c, 0); break;
    case PH_INPROJ: { EpiInproj e{c.W<bf16>(WS_Z), c.W<float>(WS_ZA)}; gemm_lin(c.W<bf16>(WS_HN), D, c.W<bf16>(WS_WINT), 0, ROWS, NZP, D, e, lds); } break;
    case PH_MIX1: s5_mfma(c, false); lru_mfma(c, false); gla_mfma(c, false); break;
    case PH_CARRY: phase_carry(c);
        if (blockIdx.x >= 40) { if (!rep) da_prep(c, (int)blockIdx.x - 40, (int)gridDim.x - 40); v_transpose(c, (int)blockIdx.x - 40, (int)gridDim.x - 40); } break;
    #ifndef PROBE_SUB
#define PROBE_SUB 15
#endif
    case PH_MIX3: if (!rep || (PROBE_SUB & 1)) attn_mfma(c); if (!rep || (PROBE_SUB & 2)) s5_mfma(c, true); if (!rep || (PROBE_SUB & 4)) lru_mfma(c, true); if (!rep || (PROBE_SUB & 8)) gla_mfma(c, true); break;
    case PH_GLU: { unsigned* cflag = (c.l != DEPTH - 1) ? (unsigned*)(c.ws + WS_CTL) + XCD_BAR_WORDS : nullptr;
        EpiGlu e{c.W<bf16>(WS_YS5), c.W<bf16>(WS_Y), cflag}; const int r0 = c.row_begin(); gemm_lin(c.W<bf16>(WS_YS5), 256, c.W<bf16>(WS_WGLUT), r0, ROWS - r0, 256, 256, e, lds);
        if (c.l != DEPTH - 1) { phase_merge_pg(c, 2);
            if (blockIdx.x >= 76 && blockIdx.x < 80) {
                phase_merge_pg(c, 3);
                if (tidx() < 64) { unsigned sp = 0; while (__hip_atomic_load(cflag, __ATOMIC_RELAXED, __HIP_MEMORY_SCOPE_AGENT) < 8u) { __builtin_amdgcn_s_sleep(1); if (++sp > (1u << 22)) break; }
                    __builtin_amdgcn_fence(__ATOMIC_ACQUIRE, "agent"); asm volatile("s_waitcnt vmcnt(0)" ::: "memory"); }
                __syncthreads();
                phase_merge_pg(c, 4); } } } break;
    case PH_MERGE: phase_merge_pg(c, c.l == DEPTH - 1 ? 0 : 1); if (c.l != DEPTH - 1 && blockIdx.x < 4) ctx_slab_sum(c); break;
    case PH_WOUT: { const EpiResid e = make_resid(c, 2 * D, true);
        if (c.l == 0) gemm_res_l0(c.W<bf16>(WS_MERGED), D, c.W<bf16>(WS_WOUTT), D, 4, e, c.W<float>(WS_SLABW), lds);
        else gemm_lin(c.W<bf16>(WS_MERGED), D, c.W<bf16>(WS_WOUTT), CTX, ROWS - CTX, D, D, e, lds); } break;
    case PH_NORM2: phase_norm(c, 1); break;
    case PH_FFNUP: phase_ffn_up_pg(c); break;
    case PH_FFNDN: { const EpiResid e = make_resid(c, 5 * D, false);
        if (c.l == 0) gemm_res_l0(c.W<bf16>(WS_Z), DFF, c.W<bf16>(WS_WDNT), DFF, 11, e, c.W<float>(WS_SLABF), lds);
        else gemm_lin(c.W<bf16>(WS_Z), DFF, c.W<bf16>(WS_WDNT), CTX, ROWS - CTX, D, DFF, e, lds); } break;
    default: break;
    }
}

__global__ void __launch_bounds__(NT) k_mega(Params p) {
    extern __shared__ __attribute__((aligned(16))) float lds[];
    cooperative_groups::grid_group grid = cooperative_groups::this_grid();
    volatile LAS unsigned* st = (volatile LAS unsigned*)((LAS unsigned char*)lds + LDS_TOTAL - 16);
    if (threadIdx.x == 0) { st[0] = 0u; st[1] = 0u; st[2] = 0u; st[3] = 0u; }
    __syncthreads();
    const XcdBarrier bar = xcd_barrier_post((unsigned*)(p.ws + WS_CTL), st);
#ifndef PROBE_PH
#define PROBE_PH -1
#endif
#define PHASE(l, ph) do { run_phase(l, ph, lds); xcd_barrier(bar); if (PROBE_PH == (ph)) { run_phase(l, ph, lds, true); xcd_barrier(bar); } } while (0)
#define LAYER(l) PHASE(l, PH_NORM1); PHASE(l, PH_INPROJ); PHASE(l, PH_MIX1); PHASE(l, PH_CARRY); PHASE(l, PH_MIX3); PHASE(l, PH_GLU); \
    PHASE(l, PH_MERGE); PHASE(l, PH_WOUT); PHASE(l, PH_NORM2); PHASE(l, PH_FFNUP)
    grid.sync();
    run_phase(0, PH_PREP, lds); xcd_barrier(bar);
    LAYER(0); PHASE(0, PH_FFNDN);
    run_phase(1, PH_PREP, lds); LAYER(1); run_phase(1, PH_FFNDN, lds);
#undef LAYER
#undef PHASE
}


extern "C" void kernel_launch(void* const* d_in, const int* in_sizes, int n_in, void* d_out, int out_size, void* d_ws, size_t ws_size, hipStream_t stream) {
    static int grid_blocks = 0;
    if (!grid_blocks) {
        if (n_in != N_IN || ws_size < WS_END) { fprintf(stderr, "kernel_launch: unexpected n_in %d or ws_size %zu (need %zu)\n", n_in, ws_size, (size_t)WS_END); grid_blocks = -1; return; }
        if (hipFuncSetAttribute((const void*)k_mega, hipFuncAttributeMaxDynamicSharedMemorySize, LDS_BYTES) != hipSuccess) { fprintf(stderr, "kernel_launch: hipFuncSetAttribute failed\n"); grid_blocks = -1; return; }
        int dev = 0, cus = 0, per_cu = 0;
        hipGetDevice(&dev);
        hipDeviceGetAttribute(&cus, hipDeviceAttributeMultiprocessorCount, dev);
        if (hipOccupancyMaxActiveBlocksPerMultiprocessor(&per_cu, (const void*)k_mega, NT, LDS_BYTES) != hipSuccess || per_cu < 1) { fprintf(stderr, "kernel_launch: occupancy query failed (%d)\n", per_cu); grid_blocks = -1; return; }
        grid_blocks = cus;
    }
    if (grid_blocks < 0) return;
    Params p{};
    for (int i = 0; i < N_IN; ++i) p.in[i] = (const float*)d_in[i];
    p.out = (float*)d_out; p.ws = (unsigned char*)d_ws;
    if (hipMemsetAsync((char*)d_ws + WS_CTL, 0, (XCD_BAR_WORDS + 64) * 4, stream) != hipSuccess) { fprintf(stderr, "kernel_launch: memset of the barrier words failed\n"); return; }
    void* args[] = {&p};
    hipError_t e = hipLaunchCooperativeKernel((const void*)k_mega, dim3(grid_blocks), dim3(NT), args, LDS_BYTES, stream);
    if (e != hipSuccess) fprintf(stderr, "cooperative launch failed: %s (grid %d)\n", hipGetErrorString(e), grid_blocks);
}
```
